# Optimizing an MI355X kernel written in HIP

```python
import jax
import jax.numpy as jnp
from jax import lax
import numpy as np

D_MODEL = 2048
BATCH = 4
SEQ = 4096
DEPTH = 2

CTX_LEN = 256
GRID_W = 64
W_BRANCH = D_MODEL // 2
N_BRANCH = 3
NA_HEADS = 16
NA_HEAD_DIM = W_BRANCH // NA_HEADS
NA_WIN_H = 8
NA_WIN_W = 16
POOL_WINDOWS = (2, 4, 8, 16)
POOL_GROUPS = len(POOL_WINDOWS)
POOL_GROUP_DIM = W_BRANCH // POOL_GROUPS
RWKV_HEAD_DIM = 64
RWKV_HEADS = W_BRANCH // RWKV_HEAD_DIM
RWKV_LORA = 64
RMS_EPS = 1e-6
LNX_EPS = 64e-5
NEG_INF = -1e30
IN_SIZES = (W_BRANCH,) * 10 + (RWKV_LORA, RWKV_LORA, N_BRANCH * D_MODEL)
IN_SPLIT_POINTS = tuple(int(s) for s in np.cumsum(IN_SIZES)[:-1])
D_IN = int(sum(IN_SIZES))

kernel_name = "hybrid_natten_pool_rwkv7_prefix_block"


def rms_norm(x, g):
    xf = x.astype(jnp.float32)
    y = xf * lax.rsqrt(jnp.mean(xf * xf, axis=-1, keepdims=True) + RMS_EPS)
    return (y * g).astype(x.dtype)


def adaln_modulation(cond, w_mod, b_mod):
    m = jax.nn.silu(cond) @ w_mod + b_mod
    return jnp.split(m, 3, axis=-1)


def to_heads(z, n_heads):
    return z.reshape(z.shape[:-1] + (n_heads, z.shape[-1] // n_heads))


def neighbourhood_attention(q, k, v, k_ctx, v_ctx, rpb):
    B, T, H, Dh = q.shape
    rows = T // GRID_W
    win_h = min(NA_WIN_H, rows)
    scale = Dh ** -0.5
    qg = q.reshape(B, rows, GRID_W, H, Dh)
    kg = k.reshape(B, rows, GRID_W, H, Dh)
    vg = v.reshape(B, rows, GRID_W, H, Dh)
    col = jnp.arange(GRID_W)
    col_start = jnp.clip(col - NA_WIN_W // 2, 0, GRID_W - NA_WIN_W)
    col_mask = (col[None, :] >= col_start[:, None]) & (col[None, :] < col_start[:, None] + NA_WIN_W)
    col_off = jnp.clip(col[None, :] - col[:, None] + NA_WIN_W - 1, 0, 2 * NA_WIN_W - 2)
    n_loc = win_h * GRID_W

    def one_row(r):
        r0 = jnp.clip(r - win_h // 2, 0, rows - win_h)
        kb = lax.dynamic_slice_in_dim(kg, r0, win_h, axis=1)
        vb = lax.dynamic_slice_in_dim(vg, r0, win_h, axis=1)
        qr = lax.dynamic_index_in_dim(qg, r, axis=1, keepdims=False)
        row_off = r0 + jnp.arange(win_h) - r + NA_WIN_H - 1
        bias = jnp.take(jnp.take(rpb, row_off, axis=1), col_off, axis=2)
        bias = bias.transpose(0, 2, 1, 3).astype(jnp.float32)
        s_loc = jnp.einsum('bqhd,bkwhd->bhqkw', qr, kb, preferred_element_type=jnp.float32) * scale + bias[None]
        s_loc = jnp.where(col_mask[None, None, :, None, :], s_loc, NEG_INF)
        s_ctx = jnp.einsum('bqhd,bchd->bhqc', qr, k_ctx, preferred_element_type=jnp.float32) * scale
        s = jnp.concatenate([s_loc.reshape(B, H, GRID_W, n_loc), s_ctx], axis=-1)
        p = jax.nn.softmax(s, axis=-1).astype(v.dtype)
        p_loc = p[..., :n_loc].reshape(B, H, GRID_W, win_h, GRID_W)
        return (jnp.einsum('bhqkw,bkwhd->bqhd', p_loc, vb)
                + jnp.einsum('bhqc,bchd->bqhd', p[..., n_loc:], v_ctx))

    out = lax.map(one_row, jnp.arange(rows))
    return out.transpose(1, 0, 2, 3, 4).reshape(B, T, H * Dh)


def context_attention(q, k, v):
    s = jnp.einsum('bqhd,bkhd->bhqk', q, k, preferred_element_type=jnp.float32) * q.shape[-1] ** -0.5
    p = jax.nn.softmax(s, axis=-1).astype(v.dtype)
    o = jnp.einsum('bhqk,bkhd->bqhd', p, v)
    return o.reshape(o.shape[:2] + (-1,))


def multiscale_pool(u, pool_w, pool_scale):
    B, T, _ = u.shape
    uf = u.astype(jnp.float32).reshape(B, T, POOL_GROUPS, POOL_GROUP_DIM)
    csum = jnp.concatenate([jnp.zeros_like(uf[:, :1]), jnp.cumsum(uf, axis=1)], axis=1)
    t = jnp.arange(T)
    pooled = []
    for g, win in enumerate(POOL_WINDOWS):
        lo = jnp.maximum(t - win // 2, 0)
        hi = jnp.minimum(t + win // 2, T)
        cg = csum[:, :, g]
        pooled.append((cg[:, hi] - cg[:, lo]) / (hi - lo).astype(jnp.float32)[None, :, None])
    diff = (jnp.stack(pooled, axis=2) - uf).astype(u.dtype)
    y = jnp.einsum('btgc,gcd->btgd', diff, pool_w)
    return y.reshape(B, T, -1) * pool_scale


def centred_neighbour_mean(z):
    zp = jnp.pad(z, ((0, 0), (1, 1), (0, 0)))
    return 0.5 * (zp[:, :-2] + zp[:, 2:])


def rwkv_features(r0, k0, v0, lw, la, mu, w0, w2, a0, a2, k_k, k_a):
    f32 = jnp.float32
    r, k, v = (z + m * (centred_neighbour_mean(z) - z)
               for z, m in ((r0.astype(f32), mu[0]), (k0.astype(f32), mu[1]), (v0.astype(f32), mu[2])))
    kk = to_heads(k * k_k, RWKV_HEADS)
    kk = kk / jnp.maximum(jnp.sqrt(jnp.sum(kk * kk, axis=-1, keepdims=True)), 1e-12)
    lw_t = jnp.tanh(lw.astype(f32))
    la_f = la.astype(f32)
    dirs = []
    for d in range(2):
        w_log = -jax.nn.softplus(-(w0[d] + lw_t @ w2[d])) - 0.5
        decay = jnp.exp(-jnp.exp(w_log))
        a = jax.nn.sigmoid(a0[d] + la_f @ a2[d])
        k_d = k * (1 + (a - 1) * k_a)
        dirs.append((to_heads(decay, RWKV_HEADS), to_heads(k_d, RWKV_HEADS), -kk, kk * to_heads(a, RWKV_HEADS)))
    return to_heads(r, RWKV_HEADS), to_heads(v, RWKV_HEADS), dirs


def wkv_scan(r, v, decay, k, a_in, b_in, s0, reverse):
    def step(S, inp):
        rt, vt, wt, kt, at, bt = inp
        sa = jnp.einsum('bhij,bhj->bhi', S, at)
        S = S * wt[:, :, None, :] + sa[..., None] * bt[:, :, None, :] + vt[..., None] * kt[:, :, None, :]
        return S, jnp.einsum('bhij,bhj->bhi', S, rt)
    xs = tuple(jnp.moveaxis(z, 1, 0) for z in (r, v, decay, k, a_in, b_in))
    s_end, ys = lax.scan(step, s0, xs, reverse=reverse)
    return jnp.moveaxis(ys, 0, 1), s_end


def rwkv_readout(r, v, ys, dirs, r_k, g, b):
    y = ys[0] + ys[1]
    mu = jnp.mean(y, axis=-1, keepdims=True)
    var = jnp.mean(jnp.square(y - mu), axis=-1, keepdims=True)
    y = (y - mu) * lax.rsqrt(var + LNX_EPS) * to_heads(g, RWKV_HEADS) + to_heads(b, RWKV_HEADS)
    bonus = (jnp.sum(r * dirs[0][1] * r_k, axis=-1, keepdims=True)
             + jnp.sum(r * dirs[1][1] * r_k, axis=-1, keepdims=True)) * v
    out = y + bonus
    return out.reshape(out.shape[:2] + (-1,))


def hybrid_layer(x_lat, x_ctx, c, c_ctx, norm_g, w_mod, b_mod, w_in, na_rpb, pool_w, pool_scale,
                 rw_mu, rw_w0, rw_w2, rw_a0, rw_a2, rw_k_k, rw_k_a, rw_r_k, rw_lnx_g, rw_lnx_b,
                 w_branch, w_out, compute_ctx):
    n_ctx = x_ctx.shape[1]
    shift_l, scale_l, gate_l = adaln_modulation(c, w_mod, b_mod)
    shift_c, scale_c, gate_c = adaln_modulation(c_ctx, w_mod, b_mod)
    h_lat = rms_norm(x_lat, norm_g) * (1 + scale_l[:, None]) + shift_l[:, None]
    h_ctx = rms_norm(x_ctx, norm_g) * (1 + scale_c) + shift_c
    h = jnp.concatenate([h_ctx, h_lat], axis=1)
    (na_q, na_k, na_v, na_gate, pool_u, pool_gate, rw_r, rw_k, rw_v, rw_gate,
     rw_lw, rw_la, merge_logits) = jnp.split(h @ w_in, IN_SPLIT_POINTS, axis=-1)

    def cpart(z):
        return z[:, :n_ctx]

    def lpart(z):
        return z[:, n_ctx:]

    keep = (lambda z: z) if compute_ctx else lpart

    q, k, v = (to_heads(z, NA_HEADS) for z in (na_q, na_k, na_v))
    y_na = neighbourhood_attention(lpart(q), lpart(k), lpart(v), cpart(k), cpart(v), na_rpb)
    if compute_ctx:
        y_na = jnp.concatenate([context_attention(cpart(q), cpart(k), cpart(v)), y_na], axis=1)

    y_pool = multiscale_pool(lpart(pool_u), pool_w, pool_scale)
    if compute_ctx:
        y_pool = jnp.concatenate([multiscale_pool(cpart(pool_u), pool_w, pool_scale), y_pool], axis=1)

    rw_params = (rw_mu, rw_w0, rw_w2, rw_a0, rw_a2, rw_k_k, rw_k_a)
    r_c, v_c, dirs_c = rwkv_features(*(cpart(z) for z in (rw_r, rw_k, rw_v, rw_lw, rw_la)), *rw_params)
    r_l, v_l, dirs_l = rwkv_features(*(lpart(z) for z in (rw_r, rw_k, rw_v, rw_lw, rw_la)), *rw_params)
    ys_c, ys_l = [], []
    for d in range(2):
        s0 = jnp.zeros((h.shape[0], RWKV_HEADS, RWKV_HEAD_DIM, RWKV_HEAD_DIM), jnp.float32)
        y_c, s_ctx_end = wkv_scan(r_c, v_c, *dirs_c[d], s0, reverse=(d == 1))
        y_l, _ = wkv_scan(r_l, v_l, *dirs_l[d], s_ctx_end, reverse=(d == 1))
        ys_c.append(y_c)
        ys_l.append(y_l)
    y_rw = rwkv_readout(r_l, v_l, ys_l, dirs_l, rw_r_k, rw_lnx_g, rw_lnx_b)
    if compute_ctx:
        y_rw = jnp.concatenate([rwkv_readout(r_c, v_c, ys_c, dirs_c, rw_r_k, rw_lnx_g, rw_lnx_b), y_rw], axis=1)

    dt = h.dtype
    b_na = y_na.astype(dt) * jax.nn.silu(keep(na_gate))
    b_pool = y_pool.astype(dt) * jax.nn.silu(keep(pool_gate))
    b_rw = y_rw.astype(dt) * jax.nn.silu(keep(rw_gate))
    g_na, g_pool, g_rw = jnp.split(jax.nn.sigmoid(keep(merge_logits)), N_BRANCH, axis=-1)
    merged = g_na * (b_na @ w_branch[0]) + g_pool * (b_pool @ w_branch[1]) + g_rw * (b_rw @ w_branch[2])
    out = merged @ w_out
    if compute_ctx:
        return x_lat + gate_l[:, None] * lpart(out), x_ctx + gate_c * cpart(out)
    return x_lat + gate_l[:, None] * out, None


def setup_inputs(seed: int = 0) -> dict:
    key = jax.random.key(seed)
    ks = jax.random.split(key, 24)
    f32 = jnp.float32
    D, L, W, R = D_MODEL, DEPTH, W_BRANCH, RWKV_LORA

    def nrm(k, shape, std):
        return jax.random.normal(k, shape, f32) * std

    return {
        "x": nrm(ks[0], (BATCH, SEQ, D), 1.0),
        "c": nrm(ks[1], (BATCH, D), 1.0),
        "ctx": nrm(ks[2], (BATCH, CTX_LEN, D), 1.0),
        "c_ctx": nrm(ks[3], (D,), 1.0),
        "norm_g": 1.0 + nrm(ks[4], (L, D), 0.05),
        "w_mod": nrm(ks[5], (L, D, 3 * D), 0.5 * D ** -0.5),
        "b_mod": nrm(ks[6], (L, 3 * D), 0.02),
        "w_in": nrm(ks[7], (L, D, D_IN), D ** -0.5),
        "na_rpb": nrm(ks[8], (L, NA_HEADS, 2 * NA_WIN_H - 1, 2 * NA_WIN_W - 1), 0.1),
        "pool_w": nrm(ks[9], (L, POOL_GROUPS, POOL_GROUP_DIM, POOL_GROUP_DIM), POOL_GROUP_DIM ** -0.5),
        "pool_scale": 1.0 + nrm(ks[10], (L, W), 0.1),
        "rw_mu": jax.random.uniform(ks[11], (L, 3, W), f32),
        "rw_w0": jax.random.uniform(ks[12], (L, 2, W), f32, -6.0, -1.0),
        "rw_w2": nrm(ks[13], (L, 2, R, W), 0.5 * R ** -0.5),
        "rw_a0": nrm(ks[14], (L, 2, W), 0.5),
        "rw_a2": nrm(ks[15], (L, 2, R, W), 0.5 * R ** -0.5),
        "rw_k_k": 0.85 + nrm(ks[16], (L, W), 0.05),
        "rw_k_a": 1.0 + nrm(ks[17], (L, W), 0.05),
        "rw_r_k": nrm(ks[18], (L, RWKV_HEADS, RWKV_HEAD_DIM), 0.1),
        "rw_lnx_g": 1.0 + nrm(ks[19], (L, W), 0.05),
        "rw_lnx_b": nrm(ks[20], (L, W), 0.02),
        "w_branch": nrm(ks[21], (L, N_BRANCH, W, D), W ** -0.5),
        "w_out": nrm(ks[22], (L, D, D), D ** -0.5),
        "final_g": 1.0 + nrm(ks[23], (D,), 0.05),
    }


def reference(x, c, ctx, c_ctx, norm_g, w_mod, b_mod, w_in, na_rpb, pool_w, pool_scale,
              rw_mu, rw_w0, rw_w2, rw_a0, rw_a2, rw_k_k, rw_k_a, rw_r_k, rw_lnx_g, rw_lnx_b,
              w_branch, w_out, final_g):
    x_lat, x_ctx = x, ctx
    for layer in range(DEPTH):
        x_lat, x_ctx = hybrid_layer(
            x_lat, x_ctx, c, c_ctx, norm_g[layer], w_mod[layer], b_mod[layer], w_in[layer],
            na_rpb[layer], pool_w[layer], pool_scale[layer], rw_mu[layer], rw_w0[layer], rw_w2[layer],
            rw_a0[layer], rw_a2[layer], rw_k_k[layer], rw_k_a[layer], rw_r_k[layer], rw_lnx_g[layer],
            rw_lnx_b[layer], w_branch[layer], w_out[layer], compute_ctx=(layer < DEPTH - 1))
    return rms_norm(x_lat, final_g)
```

```cpp
#include <hip/hip_runtime.h>
#include <hip/hip_cooperative_groups.h>
#include <cstdio>
namespace cg = cooperative_groups;

#ifndef N_LAUNCH_PER_PHASE
#define N_LAUNCH_PER_PHASE 0
#endif

#ifndef PH_MASK
#define PH_MASK 0xffff
#endif
#define LAS __attribute__((address_space(3)))
typedef unsigned short bf16_t;
typedef short bf16x8 __attribute__((ext_vector_type(8)));
typedef float f32x4 __attribute__((ext_vector_type(4)));
typedef unsigned u32x4 __attribute__((ext_vector_type(4)));
typedef unsigned u32x2 __attribute__((ext_vector_type(2)));

constexpr int D = 2048, NB = 4, T = 4096, LC = 256, TT = 4352, M = 17408, W = 1024, NP = 16640;
constexpr int C_Q = 0, C_K = 1024, C_V = 2048, C_NAG = 3072, C_PU = 4096, C_PG = 5120, C_RR = 6144, C_RK = 7168, C_RV = 8192, C_RG = 9216,
              C_MG = 10240, C_LW = 16384, C_LA = 16448;
constexpr int NPHASE = 14;
constexpr int LDS_BYTES = 131072;

constexpr size_t WS_MOD = 0, WS_MOD_BYTES = 262144;
constexpr size_t WS_BONUS = WS_MOD + WS_MOD_BYTES;
constexpr size_t WS_XCTX = WS_BONUS + 2359296;
constexpr size_t WS_WTIN = WS_XCTX + (size_t)NB * LC * D * 4;
constexpr size_t WS_WTBR = WS_WTIN + (size_t)NP * D * 2;
constexpr size_t WS_WTOUT = WS_WTBR + (size_t)3 * D * W * 2;
constexpr size_t WS_WTPL = WS_WTOUT + (size_t)D * D * 2;
constexpr size_t WS_H = WS_WTPL + (size_t)4 * 256 * 256 * 2;
constexpr size_t WS_Y = WS_H + (size_t)M * D * 2;
constexpr size_t WS_BB = WS_Y + (size_t)2 * M * W * 4;
constexpr size_t WS_DIFF = WS_BB + (size_t)3 * M * W * 2;
constexpr size_t WS_P = WS_DIFF + (size_t)M * W * 2;
constexpr size_t WS_END = WS_P + (size_t)M * NP * 2;

struct Args {
    const float *x, *c, *ctx, *c_ctx, *norm_g, *w_mod, *b_mod, *w_in, *na_rpb, *pool_w, *pool_scale, *rw_mu, *rw_w0, *rw_w2, *rw_a0, *rw_a2, *rw_k_k,
        *rw_k_a, *rw_r_k, *rw_lnx_g, *rw_lnx_b, *w_branch, *w_out, *final_g;
    float* out;
    unsigned char* ws;
    int ph_lo, ph_hi;
};

__device__ __forceinline__ float bf2f(bf16_t v) { return __uint_as_float(((unsigned)v) << 16); }
__device__ __forceinline__ float bflo(unsigned u) { return __uint_as_float(u << 16); }
__device__ __forceinline__ float bfhi(unsigned u) { return __uint_as_float(u & 0xffff0000u); }
__device__ __forceinline__ unsigned pk2(float lo, float hi) { unsigned r; asm("v_cvt_pk_bf16_f32 %0, %1, %2" : "=v"(r) : "v"(lo), "v"(hi)); return r; }
__device__ __forceinline__ float wave_sum(float v) {
#pragma unroll
    for (int o = 1; o < 64; o <<= 1) v += __shfl_xor(v, o);
    return v;
}
template <int CTRL> __device__ __forceinline__ float dppmov(float v) { return __int_as_float(__builtin_amdgcn_update_dpp(0, __float_as_int(v), CTRL, 0xF, 0xF, true)); }
__device__ __forceinline__ float sum8(float v) { v += dppmov<0xB1>(v); v += dppmov<0x4E>(v); v += dppmov<0x141>(v); return v; }
__device__ __forceinline__ float siluf(float x) { return x / (1.f + __expf(-x)); }
__device__ __forceinline__ float sigmf(float x) { return 1.f / (1.f + __expf(-x)); }
__device__ __forceinline__ int otid() { int t = threadIdx.x; asm volatile("" : "+v"(t)); return t; }
__device__ __forceinline__ void lds_wait() { asm volatile("s_waitcnt lgkmcnt(0)" ::: "memory"); }

constexpr int BM = 256, BK = 64, HALF = 128, HTB = HALF * BK * 2, NXCD = 8, WGM = 8;
__device__ __forceinline__ int lds_byte(int r, int c) { const int st = (r >> 4) * 2 + (c >> 5), rr = r & 15, cc = c & 31, ob = rr * 64 + cc * 2; return st * 1024 + (ob ^ (((ob >> 9) & 1) << 5)); }
__device__ __forceinline__ void stage_rc(int b, int& R, int& C) { const int st = b / 1024, sb = b % 1024, swz = sb ^ (((sb >> 9) & 1) << 5); R = (st >> 1) * 16 + swz / 64; C = (st & 1) * 32 + (swz % 64) / 2; }
__device__ __forceinline__ int perm32(int rho) { const int n = rho >> 4, i = rho & 15; return 8 * (i >> 2) + 4 * n + (i & 3); }

struct Unit { int pm, pn, z; };
struct Gemm {
    const bf16_t* A; const bf16_t* Bt; int lda, ldb, K; size_t a_z, b_z;
    int nM, nN, nz, latent_only, G, c;
    __device__ bool next(int i, Unit& u) const {
        const int zi = i % nz, r = i / nz; const long L = (long)r * G + c; const int nwg = nM * nN; if (L >= nwg) return false;
        int wgid = (int)L; { const int q = nwg / NXCD, rr = nwg % NXCD, xcd = wgid % NXCD, off = wgid / NXCD; wgid = (xcd < rr ? xcd * (q + 1) : rr * (q + 1) + (xcd - rr) * q) + off; }
        const int nig = WGM * nN, gid = wgid / nig, fm = gid * WGM, gsz = (nM - fm) < WGM ? (nM - fm) : WGM;
        int pm = fm + ((wgid % nig) % gsz); u.pn = (wgid % nig) / gsz; u.z = zi;
        u.pm = latent_only ? (pm / 16) * 17 + 1 + (pm % 16) : pm; return true;
    }
};

template <class Epi>
__device__ __forceinline__ void gemm_phase(LAS unsigned char* lds, const Gemm g, const Epi& E) {
    const int tid = otid(), wid = __builtin_amdgcn_readfirstlane(tid >> 6), lane = tid & 63, wr = wid >> 2, wc = wid & 3, fr = lane & 15, fq = lane >> 4;
    const int K = g.K, nt = K / BK;
    unsigned voffA[2], voffB[2];
#pragma unroll
    for (int i = 0; i < 2; ++i) { int R, C; stage_rc(tid * 16 + i * 8192, R, C); const int Rb = Epi::PERM ? ((R & ~31) + perm32(R & 31)) : R;
        voffA[i] = (unsigned)(R * g.lda + C) * 2u; voffB[i] = (unsigned)(Rb * g.ldb + C) * 2u; }
    const size_t kstep = (size_t)(BK * 2);
    const size_t hstepA = (size_t)HALF * g.lda * 2, hstepB = (size_t)HALF * g.ldb * 2;
    const unsigned ldsw = (unsigned)wid * 1024u;
    const int aoff = lds_byte(wr * 64 + fr, fq * 8), boff = lds_byte(wc * 32 + fr, fq * 8);
#define PG8_SA(b, h) (((b) * 2 + (h)) * HTB)
#define PG8_SB(b, h) ((4 + (b) * 2 + (h)) * HTB)
#define PG8_STAGE(bufoff, gbase, voff) do { _Pragma("unroll") for (int _i = 0; _i < 2; ++_i) \
        __builtin_amdgcn_global_load_lds((const unsigned*)((const char*)(gbase) + (voff)[_i]), (LAS unsigned*)(lds + (bufoff) + ldsw + _i * 8192), 16, 0, 0); } while (0)
#define PG8_LDA(dst, b, h) do { _Pragma("unroll") for (int m = 0; m < 4; ++m) _Pragma("unroll") for (int k = 0; k < 2; ++k) dst[m][k] = *(const LAS bf16x8*)(lds + PG8_SA(b, h) + aoff + m * 2048 + k * 1024); } while (0)
#define PG8_LDB(dst, b, h) do { _Pragma("unroll") for (int n = 0; n < 2; ++n) _Pragma("unroll") for (int k = 0; k < 2; ++k) dst[n][k] = *(const LAS bf16x8*)(lds + PG8_SB(b, h) + boff + n * 2048 + k * 1024); } while (0)
#define PG8_MMA(ai, bj, At, Bt) do { __builtin_amdgcn_s_setprio(1); _Pragma("unroll") for (int m = 0; m < 4; ++m) _Pragma("unroll") for (int n = 0; n < 2; ++n) _Pragma("unroll") for (int k = 0; k < 2; ++k) \
        acc[ai][bj][m][n] = __builtin_amdgcn_mfma_f32_16x16x32_bf16(Bt[n][k], At[m][k], acc[ai][bj][m][n], 0, 0, 0); __builtin_amdgcn_s_setprio(0); } while (0)
#define PG8_WAIT_V(n) asm volatile("s_waitcnt vmcnt(" #n ")" ::: "memory")
#define PG8_WAIT_L(n) asm volatile("s_waitcnt lgkmcnt(" #n ")" ::: "memory")
#define PG8_BAR __builtin_amdgcn_s_barrier()
#define PG8_SCHED __builtin_amdgcn_sched_barrier(0)
    Unit cur, nxt; int ui = 0;
    if (!g.next(0, cur)) return;
    f32x4 acc[2][2][4][2];
#pragma unroll
    for (int a = 0; a < 2; ++a)
#pragma unroll
        for (int b = 0; b < 2; ++b)
#pragma unroll
            for (int m = 0; m < 4; ++m)
#pragma unroll
                for (int n = 0; n < 2; ++n) acc[a][b][m][n] = (f32x4){0.f, 0.f, 0.f, 0.f};
    bf16x8 At[4][2], B0[2][2], B1[2][2];
    const char* cA = (const char*)(g.A + cur.z * g.a_z + (size_t)cur.pm * BM * g.lda); const char* cB = (const char*)(g.Bt + cur.z * g.b_z + (size_t)cur.pn * BM * g.ldb);
    PG8_STAGE(PG8_SB(0, 0), cB, voffB); PG8_STAGE(PG8_SA(0, 0), cA, voffA); PG8_STAGE(PG8_SB(0, 1), cB + hstepB, voffB); PG8_STAGE(PG8_SA(0, 1), cA + hstepA, voffA);
    if (wr == 1) PG8_BAR;
    PG8_WAIT_V(4); PG8_BAR;
    PG8_STAGE(PG8_SB(1, 0), cB + kstep, voffB); PG8_STAGE(PG8_SA(1, 0), cA + kstep, voffA); PG8_STAGE(PG8_SB(1, 1), cB + hstepB + kstep, voffB);
    PG8_WAIT_V(6); PG8_BAR;
    for (;;) {
        const bool has_next = g.next(ui + 1, nxt);
        const char* nA = has_next ? (const char*)(g.A + nxt.z * g.a_z + (size_t)nxt.pm * BM * g.lda) : cA;
        const char* nB = has_next ? (const char*)(g.Bt + nxt.z * g.b_z + (size_t)nxt.pn * BM * g.ldb) : cB;
        for (int t = 0; t < nt; t += 2) {
            const bool last = (t == nt - 2);
            const char* a1 = cA + (size_t)(t + 1) * kstep;
            const char* a2 = last ? nA : cA + (size_t)(t + 2) * kstep; const char* b2 = last ? nB : cB + (size_t)(t + 2) * kstep;
            const char* a3 = a2 + kstep; const char* b3 = b2 + kstep;
            PG8_LDB(B0, 0, 0); PG8_SCHED; PG8_LDA(At, 0, 0); PG8_STAGE(PG8_SA(1, 1), a1 + hstepA, voffA);
            PG8_WAIT_L(8); PG8_BAR; PG8_WAIT_L(0); PG8_MMA(0, 0, At, B0); PG8_BAR; PG8_SCHED;
            PG8_LDB(B1, 0, 1); PG8_STAGE(PG8_SB(0, 0), b2, voffB);
            PG8_BAR; PG8_WAIT_L(0); PG8_MMA(0, 1, At, B1); PG8_BAR;
            PG8_LDA(At, 0, 1); PG8_STAGE(PG8_SA(0, 0), a2, voffA);
            PG8_BAR; PG8_WAIT_L(0); PG8_MMA(1, 0, At, B0); PG8_BAR; PG8_SCHED;
            PG8_STAGE(PG8_SB(0, 1), b2 + hstepB, voffB);
            PG8_WAIT_V(6); PG8_BAR; PG8_MMA(1, 1, At, B1); PG8_BAR;
            PG8_LDB(B0, 1, 0); PG8_SCHED; PG8_LDA(At, 1, 0); PG8_STAGE(PG8_SA(0, 1), a2 + hstepA, voffA);
            PG8_WAIT_L(8); PG8_BAR; PG8_WAIT_L(0); PG8_MMA(0, 0, At, B0); PG8_BAR; PG8_SCHED;
            PG8_LDB(B1, 1, 1); PG8_STAGE(PG8_SB(1, 0), b3, voffB);
            PG8_BAR; PG8_WAIT_L(0); PG8_MMA(0, 1, At, B1); PG8_BAR;
            PG8_LDA(At, 1, 1); PG8_STAGE(PG8_SA(1, 0), a3, voffA);
            PG8_BAR; PG8_WAIT_L(0); PG8_MMA(1, 0, At, B0); PG8_BAR; PG8_SCHED;
            PG8_STAGE(PG8_SB(1, 1), b3 + hstepB, voffB);
            PG8_WAIT_V(6); PG8_BAR; PG8_MMA(1, 1, At, B1); PG8_BAR;
        }
        E(acc, cur, wr, wc, fr, fq);
        if (!has_next) break;
#pragma unroll
        for (int a = 0; a < 2; ++a)
#pragma unroll
            for (int b = 0; b < 2; ++b)
#pragma unroll
                for (int m = 0; m < 4; ++m)
#pragma unroll
                    for (int n = 0; n < 2; ++n) acc[a][b][m][n] = (f32x4){0.f, 0.f, 0.f, 0.f};
        cur = nxt; cA = nA; cB = nB; ++ui;
    }
    PG8_WAIT_V(0);
    if (wr == 0) PG8_BAR;
    PG8_BAR;
#undef PG8_SA
#undef PG8_SB
#undef PG8_STAGE
#undef PG8_LDA
#undef PG8_LDB
#undef PG8_MMA
#undef PG8_WAIT_V
#undef PG8_WAIT_L
#undef PG8_BAR
#undef PG8_SCHED
}

struct EpiP {
    static constexpr bool PERM = true;
    bf16_t* P;
    __device__ __forceinline__ void operator()(const f32x4 (&acc)[2][2][4][2], const Unit& u, int wr, int wc, int fr, int fq) const {
        const int row0 = u.pm * BM + wr * 64 + fr, col0 = u.pn * BM + wc * 32 + 8 * fq;
#pragma unroll
        for (int ai = 0; ai < 2; ++ai)
#pragma unroll
            for (int m = 0; m < 4; ++m) { bf16_t* rowp = P + (size_t)(row0 + ai * HALF + m * 16) * NP + col0;
#pragma unroll
                for (int bj = 0; bj < 2; ++bj) { const f32x4 v0 = acc[ai][bj][m][0], v1 = acc[ai][bj][m][1];
                    u32x4 o; o.x = pk2(v0[0], v0[1]); o.y = pk2(v0[2], v0[3]); o.z = pk2(v1[0], v1[1]); o.w = pk2(v1[2], v1[3]);
                    *(u32x4*)(rowp + bj * HALF) = o; } }
    }
};
struct EpiPool {
    static constexpr bool PERM = true;
    const bf16_t* P; bf16_t* out; const float* scale;
    __device__ __forceinline__ void operator()(const f32x4 (&acc)[2][2][4][2], const Unit& u, int wr, int wc, int fr, int fq) const {
        const int row0 = u.pm * BM + wr * 64 + fr, col0 = u.z * 256 + wc * 32 + 8 * fq;
#pragma unroll
        for (int ai = 0; ai < 2; ++ai)
#pragma unroll
            for (int m = 0; m < 4; ++m) { const size_t row = (size_t)(row0 + ai * HALF + m * 16);
#pragma unroll
                for (int bj = 0; bj < 2; ++bj) { const int col = col0 + bj * HALF; const f32x4 v0 = acc[ai][bj][m][0], v1 = acc[ai][bj][m][1];
                    const u32x4 gt = *(const u32x4*)(P + row * NP + C_PG + col);
                    const f32x4 s0 = *(const f32x4*)(scale + col), s1 = *(const f32x4*)(scale + col + 4);
                    u32x4 o;
                    o.x = pk2(v0[0] * s0[0] * siluf(bflo(gt.x)), v0[1] * s0[1] * siluf(bfhi(gt.x)));
                    o.y = pk2(v0[2] * s0[2] * siluf(bflo(gt.y)), v0[3] * s0[3] * siluf(bfhi(gt.y)));
                    o.z = pk2(v1[0] * s1[0] * siluf(bflo(gt.z)), v1[1] * s1[1] * siluf(bfhi(gt.z)));
                    o.w = pk2(v1[2] * s1[2] * siluf(bflo(gt.w)), v1[3] * s1[3] * siluf(bfhi(gt.w)));
                    *(u32x4*)(out + row * W + col) = o; } }
    }
};
struct EpiMerge {
    static constexpr bool PERM = false;
    const bf16_t* P; float* mf; bf16_t* mb;
    __device__ __forceinline__ void operator()(const f32x4 (&acc)[2][2][4][2], const Unit& u, int wr, int wc, int fr, int fq) const {
        const int row0 = u.pm * BM + wr * 64 + fr, col0 = u.pn * BM + wc * 32 + 4 * fq;
#pragma unroll
        for (int ai = 0; ai < 2; ++ai)
#pragma unroll
            for (int m = 0; m < 4; ++m) { const size_t row = (size_t)(row0 + ai * HALF + m * 16);
#pragma unroll
                for (int bj = 0; bj < 2; ++bj)
#pragma unroll
                    for (int n = 0; n < 2; ++n) { const int col = col0 + bj * HALF + n * 16; const f32x4 v = acc[ai][bj][m][n];
                        const u32x2 lg = *(const u32x2*)(P + row * NP + C_MG + u.z * D + col);
                        f32x4 r; r[0] = v[0] * sigmf(bflo(lg.x)); r[1] = v[1] * sigmf(bfhi(lg.x)); r[2] = v[2] * sigmf(bflo(lg.y)); r[3] = v[3] * sigmf(bfhi(lg.y));
                        float* mp = mf + row * D + col;
                        if (u.z > 0) { const f32x4 o = *(const f32x4*)mp; r += o; }
                        if (u.z < 2) *(f32x4*)mp = r;
                        else { u32x2 o; o.x = pk2(r[0], r[1]); o.y = pk2(r[2], r[3]); *(u32x2*)(mb + row * D + col) = o; } } }
    }
};
struct EpiOut {
    static constexpr bool PERM = false;
    const float* xl_old; const float* xc_old; float* xl_new; float* xc_new; const float* mod;
    __device__ __forceinline__ void operator()(const f32x4 (&acc)[2][2][4][2], const Unit& u, int wr, int wc, int fr, int fq) const {
        const int b = u.pm / 17, tl = u.pm % 17; const bool isc = (tl == 0);
        const float* xo = isc ? xc_old + (size_t)b * LC * D : xl_old + ((size_t)b * T + (tl - 1) * 256) * D;
        float* xn = isc ? xc_new + (size_t)b * LC * D : xl_new + ((size_t)b * T + (tl - 1) * 256) * D;
        const float* gp = mod + (isc ? 4 : b) * 6144 + 4096;
        const int row0 = wr * 64 + fr, col0 = u.pn * BM + wc * 32 + 4 * fq;
#pragma unroll
        for (int bj = 0; bj < 2; ++bj)
#pragma unroll
            for (int n = 0; n < 2; ++n) { const int col = col0 + bj * HALF + n * 16; const f32x4 gt = *(const f32x4*)(gp + col);
#pragma unroll
                for (int ai = 0; ai < 2; ++ai)
#pragma unroll
                    for (int m = 0; m < 4; ++m) { const size_t off = (size_t)(row0 + ai * HALF + m * 16) * D + col;
                        const f32x4 o = *(const f32x4*)(xo + off); *(f32x4*)(xn + off) = o + gt * acc[ai][bj][m][n]; } }
    }
};

__device__ __forceinline__ void phase_mod(const Args& a, LAS unsigned char* lds) {
    const int tidm = otid();
    LAS float* s = (LAS float*)lds;
    float* modp = (float*)(a.ws + WS_MOD);
    for (int task = blockIdx.x; task < 192; task += gridDim.x) {
        const int l = task / 96, rem = task % 96, cb = rem >> 3, kc = rem & 7, k0 = kc * 256;
        __syncthreads();
        for (int i = tidm; i < 5 * 256; i += 512) { const int r = i >> 8, k = i & 255; const float c = (r < 4) ? a.c[r * D + k0 + k] : a.c_ctx[k0 + k]; s[i] = c / (1.f + expf(-c)); }
        __syncthreads();
        const int n = cb * 512 + tidm;
        const float* w = a.w_mod + (size_t)l * D * 6144 + (size_t)k0 * 6144 + n;
        float a0 = 0.f, a1 = 0.f, a2 = 0.f, a3 = 0.f, a4 = 0.f;
#pragma unroll 8
        for (int k = 0; k < 256; ++k) { const float wv = w[(size_t)k * 6144]; a0 += s[k] * wv; a1 += s[256 + k] * wv; a2 += s[512 + k] * wv; a3 += s[768 + k] * wv; a4 += s[1024 + k] * wv; }
        float* mo = modp + l * 5 * 6144 + n;
        const float bias = (kc == 0) ? a.b_mod[l * 6144 + n] : 0.f;
        atomicAdd(mo, a0 + bias); atomicAdd(mo + 6144, a1 + bias); atomicAdd(mo + 2 * 6144, a2 + bias); atomicAdd(mo + 3 * 6144, a3 + bias); atomicAdd(mo + 4 * 6144, a4 + bias);
    }
}

__device__ __forceinline__ void transpose_item(const float* Wsrc, int ldsrc, int k0, int nsrc0, bf16_t* dst, int ldd, LAS float* scr, int lane) {
    if (nsrc0 >= 0) {
#pragma unroll 8
        for (int i = 0; i < 32; ++i) { const int kk = 2 * i + (lane >> 5); scr[kk * 33 + (lane & 31)] = Wsrc[(size_t)(k0 + kk) * ldsrc + nsrc0 + (lane & 31)]; }
    } else {
#pragma unroll 8
        for (int i = 0; i < 32; ++i) { const int kk = 2 * i + (lane >> 5); scr[kk * 33 + (lane & 31)] = 0.f; }
    }
    lds_wait();
    const int c = lane & 7;
#pragma unroll
    for (int j = 0; j < 4; ++j) { const int n = (lane >> 3) + 8 * j; const LAS float* s = scr + (8 * c) * 33 + n;
        u32x4 o; o.x = pk2(s[0 * 33], s[1 * 33]); o.y = pk2(s[2 * 33], s[3 * 33]); o.z = pk2(s[4 * 33], s[5 * 33]); o.w = pk2(s[6 * 33], s[7 * 33]);
        *(u32x4*)(dst + (size_t)n * ldd + k0 + 8 * c) = o; }
    lds_wait();
}
__device__ __forceinline__ void phase_norm_convert(const Args& a, int layer, LAS unsigned char* lds) {
    const int tid = otid(), lane = tid & 63, wv = tid >> 6;
    const int gw = blockIdx.x * 8 + wv, NGW = gridDim.x * 8;
    {
        LAS float* scr = (LAS float*)(lds + wv * 8448);
        bf16_t* wtin = (bf16_t*)(a.ws + WS_WTIN); bf16_t* wtbr = (bf16_t*)(a.ws + WS_WTBR); bf16_t* wtout = (bf16_t*)(a.ws + WS_WTOUT); bf16_t* wtpl = (bf16_t*)(a.ws + WS_WTPL);
        constexpr int I_IN = 32 * 520, I_BR = 16 * 64, I_OUT = 32 * 64, I_PL = 4 * 8;
        constexpr int NIT = I_IN + 3 * I_BR + I_OUT + 4 * I_PL;
        for (int it = gw; it < NIT; it += NGW) {
            int r = it;
            if (r < I_IN) { const int kb = r / 520, nb = r % 520, n0 = nb * 32; const int ns = n0 < 10240 ? n0 : (n0 < 16384 ? n0 + 128 : (n0 < 16512 ? n0 - 6144 : -1));
                transpose_item(a.w_in + (size_t)layer * D * 16512, 16512, kb * 64, ns, wtin + (size_t)n0 * D, D, scr, lane); continue; }
            r -= I_IN;
            if (r < 3 * I_BR) { const int z = r / I_BR, q = r % I_BR, kb = q / 64, nb = q % 64;
                transpose_item(a.w_branch + ((size_t)layer * 3 + z) * W * D, D, kb * 64, nb * 32, wtbr + (size_t)z * D * W + (size_t)nb * 32 * W, W, scr, lane); continue; }
            r -= 3 * I_BR;
            if (r < I_OUT) { const int kb = r / 64, nb = r % 64;
                transpose_item(a.w_out + (size_t)layer * D * D, D, kb * 64, nb * 32, wtout + (size_t)nb * 32 * D, D, scr, lane); continue; }
            r -= I_OUT;
            { const int z = r / I_PL, q = r % I_PL, kb = q / 8, nb = q % 8;
                transpose_item(a.pool_w + ((size_t)layer * 4 + z) * 65536, 256, kb * 64, nb * 32, wtpl + (size_t)z * 65536 + (size_t)nb * 32 * 256, 256, scr, lane); }
        }
    }
    const float* ng = a.norm_g + layer * D;
    const float* mo = (const float*)(a.ws + WS_MOD) + layer * 5 * 6144;
    const float* xctx = (const float*)(a.ws + WS_XCTX);
    bf16_t* h = (bf16_t*)(a.ws + WS_H);
    for (int row = gw; row < M; row += NGW) {
        const int b = row / TT, t = row % TT; const float* xr; int mr;
        if (t < LC) { xr = (layer == 0 ? a.ctx : xctx) + (size_t)(b * LC + t) * D; mr = 4; }
        else { xr = (layer == 0 ? a.x : (const float*)a.out) + (size_t)(b * T + t - LC) * D; mr = b; }
        f32x4 v[8]; float ss = 0.f;
#pragma unroll
        for (int j = 0; j < 8; ++j) { v[j] = *(const f32x4*)(xr + 4 * lane + 256 * j); ss += (v[j][0] * v[j][0] + v[j][1] * v[j][1]) + (v[j][2] * v[j][2] + v[j][3] * v[j][3]); }
        ss = wave_sum(ss); const float rstd = rsqrtf(ss * (1.f / D) + 1e-6f);
        const float* mrow = mo + mr * 6144;
#pragma unroll
        for (int j = 0; j < 8; ++j) { const int col = 4 * lane + 256 * j; const f32x4 g4 = *(const f32x4*)(ng + col), sh = *(const f32x4*)(mrow + col), sc = *(const f32x4*)(mrow + 2048 + col);
            f32x4 o = (v[j] * rstd) * g4; o = o * (sc + 1.f) + sh;
            u32x2 pk; pk.x = pk2(o[0], o[1]); pk.y = pk2(o[2], o[3]); *(u32x2*)(h + (size_t)row * D + col) = pk; }
    }
}

__device__ __forceinline__ void scan_item(const Args& a, int layer, int item, LAS unsigned char* lds) {
    const int tid = otid(), lane = tid & 63, wv = tid >> 6;
    const int b = item >> 5, h = (item >> 1) & 15, dir = item & 1;
    LAS float* W2s = (LAS float*)lds;
    LAS float* A2s = W2s + 4096;
    LAS float* LWs = A2s + 4096;
    LAS float* LAs = LWs + 2048;
    LAS float* F = LAs + 2048;
    LAS float* Ys = F + 32 * 384;
    const bf16_t* P = (const bf16_t*)(a.ws + WS_P);
    float* ybuf = (float*)(a.ws + WS_Y);
    float* bonus = (float*)(a.ws + WS_BONUS);
    __syncthreads();
    {
        const float* w2 = a.rw_w2 + ((size_t)(layer * 2 + dir) * 64) * W + h * 64;
        const float* a2 = a.rw_a2 + ((size_t)(layer * 2 + dir) * 64) * W + h * 64;
        for (int i = tid; i < 4096; i += 512) { const int l = i >> 6, c = i & 63; W2s[i] = w2[l * W + c]; A2s[i] = a2[l * W + c]; }
    }
    const int ch = h * 64 + lane;
    const float mu_r = a.rw_mu[(layer * 3 + 0) * W + ch], mu_k = a.rw_mu[(layer * 3 + 1) * W + ch], mu_v = a.rw_mu[(layer * 3 + 2) * W + ch];
    const float w0 = a.rw_w0[(layer * 2 + dir) * W + ch], a0 = a.rw_a0[(layer * 2 + dir) * W + ch];
    const float kk_c = a.rw_k_k[layer * W + ch], ka_c = a.rw_k_a[layer * W + ch], rk_c = a.rw_r_k[layer * W + ch];
    float S[8];
#pragma unroll
    for (int j = 0; j < 8; ++j) S[j] = 0.f;
    const int si = tid >> 3, sj = (tid & 7) * 8;
    for (int seg = 0; seg < 2; ++seg) {
        const int slen = seg ? T : LC; const int rowbase = b * TT + (seg ? LC : 0);
        for (int ck = 0; ck < slen / 32; ++ck) {
            __syncthreads();
            float fr_[4], fk_[4], fv_[4], fkk_[4];
#pragma unroll
            for (int q = 0; q < 4; ++q) {
                const int p = wv * 4 + q, pi = ck * 32 + p, t = dir ? (slen - 1 - pi) : pi;
                const bf16_t* pr = P + (size_t)(rowbase + t) * NP;
                LWs[p * 64 + lane] = tanhf(bf2f(pr[C_LW + lane])); LAs[p * 64 + lane] = bf2f(pr[C_LA + lane]);
                const float r0 = bf2f(pr[C_RR + ch]), k0 = bf2f(pr[C_RK + ch]), v0 = bf2f(pr[C_RV + ch]);
                float rs = 0.f, ks = 0.f, vs = 0.f;
                if (t > 0) { rs += bf2f(pr[C_RR + ch - NP]); ks += bf2f(pr[C_RK + ch - NP]); vs += bf2f(pr[C_RV + ch - NP]); }
                if (t < slen - 1) { rs += bf2f(pr[C_RR + ch + NP]); ks += bf2f(pr[C_RK + ch + NP]); vs += bf2f(pr[C_RV + ch + NP]); }
                fr_[q] = r0 + mu_r * (0.5f * rs - r0); fk_[q] = k0 + mu_k * (0.5f * ks - k0); fv_[q] = v0 + mu_v * (0.5f * vs - v0);
                const float kku = fk_[q] * kk_c; const float ss = wave_sum(kku * kku);
                fkk_[q] = kku / fmaxf(sqrtf(ss), 1e-12f);
            }
            lds_wait();
            float wp[4], ap[4];
#pragma unroll
            for (int q = 0; q < 4; ++q) { wp[q] = w0; ap[q] = a0; }
            for (int l = 0; l < 64; l += 4) {
                float w2v[4], a2v[4];
#pragma unroll
                for (int u = 0; u < 4; ++u) { w2v[u] = W2s[(l + u) * 64 + lane]; a2v[u] = A2s[(l + u) * 64 + lane]; }
#pragma unroll
                for (int q = 0; q < 4; ++q) { const f32x4 lw4 = *(const LAS f32x4*)(LWs + (wv * 4 + q) * 64 + l), la4 = *(const LAS f32x4*)(LAs + (wv * 4 + q) * 64 + l);
                    wp[q] += lw4[0] * w2v[0] + lw4[1] * w2v[1] + lw4[2] * w2v[2] + lw4[3] * w2v[3];
                    ap[q] += la4[0] * a2v[0] + la4[1] * a2v[1] + la4[2] * a2v[2] + la4[3] * a2v[3]; }
            }
#pragma unroll
            for (int q = 0; q < 4; ++q) {
                const int p = wv * 4 + q, pi = ck * 32 + p, t = dir ? (slen - 1 - pi) : pi;
                const float e = expf(-wp[q]); const float decay = expf(-0.6065306597f / (1.f + e));
                const float av = 1.f / (1.f + expf(-ap[q]));
                const float kd = fk_[q] * (1.f + (av - 1.f) * ka_c);
                LAS float* f = F + p * 384 + lane;
                f[0] = decay; f[64] = kd; f[128] = -fkk_[q]; f[192] = fkk_[q] * av; f[256] = fr_[q]; f[320] = fv_[q];
                const float bs = wave_sum(fr_[q] * kd * rk_c);
                if (lane == 0) bonus[((size_t)dir * M + rowbase + t) * 16 + h] = bs;
            }
            __syncthreads();
            for (int p = 0; p < 32; ++p) {
                const LAS float* f = F + p * 384;
                const f32x4 w_0 = *(const LAS f32x4*)(f + sj), w_1 = *(const LAS f32x4*)(f + sj + 4);
                const f32x4 k_0 = *(const LAS f32x4*)(f + 64 + sj), k_1 = *(const LAS f32x4*)(f + 64 + sj + 4);
                const f32x4 a_0 = *(const LAS f32x4*)(f + 128 + sj), a_1 = *(const LAS f32x4*)(f + 128 + sj + 4);
                const f32x4 b_0 = *(const LAS f32x4*)(f + 192 + sj), b_1 = *(const LAS f32x4*)(f + 192 + sj + 4);
                const f32x4 r_0 = *(const LAS f32x4*)(f + 256 + sj), r_1 = *(const LAS f32x4*)(f + 256 + sj + 4);
                const float vi = f[320 + si];
                float sa = (S[0] * a_0[0] + S[1] * a_0[1]) + (S[2] * a_0[2] + S[3] * a_0[3]) + (S[4] * a_1[0] + S[5] * a_1[1]) + (S[6] * a_1[2] + S[7] * a_1[3]);
                sa = sum8(sa);
#pragma unroll
                for (int j = 0; j < 4; ++j) { S[j] = S[j] * w_0[j] + (sa * b_0[j] + vi * k_0[j]); S[4 + j] = S[4 + j] * w_1[j] + (sa * b_1[j] + vi * k_1[j]); }
                float y = (S[0] * r_0[0] + S[1] * r_0[1]) + (S[2] * r_0[2] + S[3] * r_0[3]) + (S[4] * r_1[0] + S[5] * r_1[1]) + (S[6] * r_1[2] + S[7] * r_1[3]);
                y = sum8(y);
                if ((tid & 7) == 0) Ys[p * 64 + si] = y;
            }
            __syncthreads();
            { const int p = tid >> 4, pi = ck * 32 + p, t = dir ? (slen - 1 - pi) : pi;
                const f32x4 yv = *(const LAS f32x4*)(Ys + p * 64 + (tid & 15) * 4);
                *(f32x4*)(ybuf + ((size_t)dir * M + rowbase + t) * W + h * 64 + (tid & 15) * 4) = yv; }
        }
    }
}

__device__ __forceinline__ int clampi(int v, int lo, int hi) { return v < lo ? lo : (v > hi ? hi : v); }

__device__ __forceinline__ void attn_unit(const Args& a, int layer, int unit, bool isctx, LAS unsigned char* lds) {
    const int tid = otid(), lane = tid & 63, wv = tid >> 6, fr = lane & 15, fq = lane >> 4;
    constexpr int VS = 840;
    LAS bf16_t* Vt = (LAS bf16_t*)lds;
    LAS float* rpbs = (LAS float*)(lds + 64 * VS * 2);
    const bf16_t* P = (const bf16_t*)(a.ws + WS_P);
    bf16_t* bna = (bf16_t*)(a.ws + WS_BB);
    int b, h, rp = 0, half = 0;
    if (!isctx) { b = unit >> 9; h = (unit >> 5) & 15; rp = unit & 31; } else { b = unit >> 5; h = (unit >> 1) & 15; half = unit & 1; }
    int r0a = 0, nloc = 0;
    if (!isctx) { r0a = clampi(2 * rp - 4, 0, 56); const int r0b = clampi(2 * rp - 3, 0, 56); nloc = (r0b + 8 - r0a) * 64; }
    __syncthreads();
    for (int cidx = tid; cidx < nloc * 8; cidx += 512) { const int key = cidx >> 3, dc = cidx & 7;
        const u32x4 v = *(const u32x4*)(P + (size_t)(b * TT + LC + r0a * 64 + key) * NP + C_V + h * 64 + dc * 8);
        LAS bf16_t* d = Vt + (dc * 8) * VS + key;
        d[0] = (bf16_t)(v.x & 0xffff); d[VS] = (bf16_t)(v.x >> 16); d[2 * VS] = (bf16_t)(v.y & 0xffff); d[3 * VS] = (bf16_t)(v.y >> 16);
        d[4 * VS] = (bf16_t)(v.z & 0xffff); d[5 * VS] = (bf16_t)(v.z >> 16); d[6 * VS] = (bf16_t)(v.w & 0xffff); d[7 * VS] = (bf16_t)(v.w >> 16); }
    for (int cidx = tid; cidx < 256 * 8; cidx += 512) { const int key = cidx >> 3, dc = cidx & 7;
        const u32x4 v = *(const u32x4*)(P + (size_t)(b * TT + key) * NP + C_V + h * 64 + dc * 8);
        LAS bf16_t* d = Vt + (dc * 8) * VS + 576 + key;
        d[0] = (bf16_t)(v.x & 0xffff); d[VS] = (bf16_t)(v.x >> 16); d[2 * VS] = (bf16_t)(v.y & 0xffff); d[3 * VS] = (bf16_t)(v.y >> 16);
        d[4 * VS] = (bf16_t)(v.z & 0xffff); d[5 * VS] = (bf16_t)(v.z >> 16); d[6 * VS] = (bf16_t)(v.w & 0xffff); d[7 * VS] = (bf16_t)(v.w >> 16); }
    if (!isctx) for (int i = tid; i < 465; i += 512) rpbs[i] = a.na_rpb[(size_t)(layer * 16 + h) * 465 + i];
    __syncthreads();

    int qtok, r = 0, qc = 0, cs = 0, r0 = 0;
    if (!isctx) { r = 2 * rp + (wv >> 2); const int g = wv & 3; qc = g * 16 + fr; cs = (g == 0) ? 0 : (g == 1 ? 8 : (g == 2 ? 24 : 32)); r0 = clampi(r - 4, 0, 56); qtok = b * TT + LC + r * 64 + qc; }
    else qtok = b * TT + half * 128 + wv * 16 + fr;
    bf16x8 qf[2];
    qf[0] = *(const bf16x8*)(P + (size_t)qtok * NP + C_Q + h * 64 + fq * 8);
    qf[1] = *(const bf16x8*)(P + (size_t)qtok * NP + C_Q + h * 64 + 32 + fq * 8);
    const int cstart = clampi(qc - 8, 0, 48);
    float mrun = -1e30f, lrun = 0.f;
    f32x4 o[4];
#pragma unroll
    for (int dt = 0; dt < 4; ++dt) o[dt] = (f32x4){0.f, 0.f, 0.f, 0.f};
    const int nblk = isctx ? 8 : 16;
    for (int blk = 0; blk < nblk; ++blk) {
        const bool loc = (!isctx) && (blk < 8);
        const int gr = r0 + blk;
        f32x4 s[2];
#pragma unroll
        for (int ti = 0; ti < 2; ++ti) {
            size_t ktok;
            if (loc) ktok = (size_t)(b * TT + LC + gr * 64 + cs + ti * 16 + fr); else ktok = (size_t)(b * TT + ((blk & 7) * 32) + ti * 16 + fr);
            const bf16_t* kp = P + ktok * NP + C_K + h * 64 + fq * 8;
            const bf16x8 k0 = *(const bf16x8*)kp, k1 = *(const bf16x8*)(kp + 32);
            f32x4 z = (f32x4){0.f, 0.f, 0.f, 0.f};
            z = __builtin_amdgcn_mfma_f32_16x16x32_bf16(k0, qf[0], z, 0, 0, 0);
            s[ti] = __builtin_amdgcn_mfma_f32_16x16x32_bf16(k1, qf[1], z, 0, 0, 0);
        }
        float sv[8];
        if (loc) {
            const LAS float* brow = rpbs + (gr - r + 7) * 31;
#pragma unroll
            for (int ti = 0; ti < 2; ++ti)
#pragma unroll
                for (int rg = 0; rg < 4; ++rg) { const int kc = cs + ti * 16 + fq * 4 + rg; const bool valid = (kc >= cstart) && (kc < cstart + 16);
                    const int co = clampi(kc - qc + 15, 0, 30); sv[ti * 4 + rg] = valid ? (s[ti][rg] * 0.125f + brow[co]) : -1e30f; }
        } else {
#pragma unroll
            for (int ti = 0; ti < 2; ++ti)
#pragma unroll
                for (int rg = 0; rg < 4; ++rg) sv[ti * 4 + rg] = s[ti][rg] * 0.125f;
        }
        float mx = fmaxf(fmaxf(fmaxf(sv[0], sv[1]), fmaxf(sv[2], sv[3])), fmaxf(fmaxf(sv[4], sv[5]), fmaxf(sv[6], sv[7])));
        mx = fmaxf(mx, __shfl_xor(mx, 16)); mx = fmaxf(mx, __shfl_xor(mx, 32));
        const float mnew = fmaxf(mrun, mx); const float alpha = __expf(mrun - mnew); mrun = mnew;
        float ps = 0.f; float pv[8];
#pragma unroll
        for (int i = 0; i < 8; ++i) { pv[i] = __expf(sv[i] - mnew); ps += pv[i]; }
        lrun = lrun * alpha + ps;
#pragma unroll
        for (int dt = 0; dt < 4; ++dt) o[dt] *= alpha;
        u32x4 pp; pp.x = pk2(pv[0], pv[1]); pp.y = pk2(pv[2], pv[3]); pp.z = pk2(pv[4], pv[5]); pp.w = pk2(pv[6], pv[7]);
        const bf16x8 pf = __builtin_bit_cast(bf16x8, pp);
        const int kbase = loc ? ((gr - r0a) * 64 + cs) : (576 + (blk & 7) * 32);
#pragma unroll
        for (int dt = 0; dt < 4; ++dt) { const LAS bf16_t* vp = Vt + (dt * 16 + fr) * VS + kbase + fq * 4;
            const u32x2 lo = *(const LAS u32x2*)vp, hi = *(const LAS u32x2*)(vp + 16);
            u32x4 vv; vv.x = lo.x; vv.y = lo.y; vv.z = hi.x; vv.w = hi.y;
            o[dt] = __builtin_amdgcn_mfma_f32_16x16x32_bf16(__builtin_bit_cast(bf16x8, vv), pf, o[dt], 0, 0, 0); }
    }
    lrun += __shfl_xor(lrun, 16); lrun += __shfl_xor(lrun, 32);
    const float inv = 1.f / lrun;
#pragma unroll
    for (int dt = 0; dt < 4; ++dt) { const int dcol = h * 64 + dt * 16 + fq * 4;
        const u32x2 gt = *(const u32x2*)(P + (size_t)qtok * NP + C_NAG + dcol);
        u32x2 ov; ov.x = pk2(o[dt][0] * inv * siluf(bflo(gt.x)), o[dt][1] * inv * siluf(bfhi(gt.x))); ov.y = pk2(o[dt][2] * inv * siluf(bflo(gt.y)), o[dt][3] * inv * siluf(bfhi(gt.y)));
        *(u32x2*)(bna + (size_t)qtok * W + dcol) = ov; }
}

__device__ __forceinline__ void pool_unit(const Args& a, int unit) {
    const int tid = otid();
    const bf16_t* P = (const bf16_t*)(a.ws + WS_P);
    bf16_t* diff = (bf16_t*)(a.ws + WS_DIFF);
    const int cc = tid & 127, g = cc >> 5, hw = 1 << g;
    for (int pass = 0; pass < 8; ++pass) {
        const int row = unit * 32 + pass * 4 + (tid >> 7); const int b = row / TT, t = row % TT;
        int s0, slen, tl; if (t < LC) { s0 = b * TT; slen = LC; tl = t; } else { s0 = b * TT + LC; slen = T; tl = t - LC; }
        const int lo = max(tl - hw, 0), hi = min(tl + hw, slen);
        float sm[8];
#pragma unroll
        for (int j = 0; j < 8; ++j) sm[j] = 0.f;
        for (int s = lo; s < hi; ++s) { const u32x4 v = *(const u32x4*)(P + (size_t)(s0 + s) * NP + C_PU + cc * 8);
            sm[0] += bflo(v.x); sm[1] += bfhi(v.x); sm[2] += bflo(v.y); sm[3] += bfhi(v.y); sm[4] += bflo(v.z); sm[5] += bfhi(v.z); sm[6] += bflo(v.w); sm[7] += bfhi(v.w); }
        const float inv = 1.f / (float)(hi - lo);
        const u32x4 u = *(const u32x4*)(P + (size_t)row * NP + C_PU + cc * 8);
        u32x4 o; o.x = pk2(sm[0] * inv - bflo(u.x), sm[1] * inv - bfhi(u.x)); o.y = pk2(sm[2] * inv - bflo(u.y), sm[3] * inv - bfhi(u.y));
        o.z = pk2(sm[4] * inv - bflo(u.z), sm[5] * inv - bfhi(u.z)); o.w = pk2(sm[6] * inv - bflo(u.w), sm[7] * inv - bfhi(u.w));
        *(u32x4*)(diff + (size_t)row * W + cc * 8) = o;
    }
}

__device__ __forceinline__ void phase_mixers(const Args& a, int layer, LAS unsigned char* lds) {
    const int G = gridDim.x, bid = blockIdx.x;
    const int nsc = (G >= 192) ? 128 : 0;
    if (PH_MASK & 0x200) { if (nsc) { if (bid < nsc) { scan_item(a, layer, bid, lds); return; } }
    else { for (int it = bid; it < 128; it += G) scan_item(a, layer, it, lds); } }
    const int w = nsc ? bid - nsc : bid, nw = nsc ? G - nsc : G;
    const int n_lat = 2048, n_ctx = (layer == 0) ? 128 : 0, n_pool = 544;
    for (int u = w; u < n_lat + n_ctx + n_pool; u += nw) {
        if (u < n_lat) { if (PH_MASK & 0x400) attn_unit(a, layer, u, false, lds); }
        else if (u < n_lat + n_ctx) { if (PH_MASK & 0x400) attn_unit(a, layer, u - n_lat, true, lds); }
        else if (PH_MASK & 0x800) pool_unit(a, u - n_lat - n_ctx);
    }
}

__device__ __forceinline__ void phase_readout(const Args& a, int layer) {
    const int tid = otid(), lane = tid & 63, wv = tid >> 6;
    const int gw = blockIdx.x * 8 + wv, NGW = gridDim.x * 8;
    const bf16_t* P = (const bf16_t*)(a.ws + WS_P);
    const float* ybuf = (const float*)(a.ws + WS_Y);
    const float* bonus = (const float*)(a.ws + WS_BONUS);
    bf16_t* brw = (bf16_t*)(a.ws + WS_BB) + (size_t)2 * M * W;
    for (int it = gw; it < M * 16; it += NGW) {
        const int row = it >> 4, h = it & 15; const int b = row / TT, t = row % TT;
        if (layer == 1 && t < LC) continue;
        const int ch = h * 64 + lane;
        int tl, slen; if (t < LC) { tl = t; slen = LC; } else { tl = t - LC; slen = T; }
        const float y = ybuf[(size_t)row * W + ch] + ybuf[((size_t)M + row) * W + ch];
        const float mean = wave_sum(y) * (1.f / 64.f); const float dv = y - mean; const float var = wave_sum(dv * dv) * (1.f / 64.f);
        const float yn = dv * rsqrtf(var + 64e-5f) * a.rw_lnx_g[layer * W + ch] + a.rw_lnx_b[layer * W + ch];
        const bf16_t* pr = P + (size_t)row * NP;
        const float v0 = bf2f(pr[C_RV + ch]); float vs = 0.f;
        if (tl > 0) vs += bf2f(pr[C_RV + ch - NP]);
        if (tl < slen - 1) vs += bf2f(pr[C_RV + ch + NP]);
        const float v = v0 + a.rw_mu[(layer * 3 + 2) * W + ch] * (0.5f * vs - v0);
        const float bs = bonus[(size_t)row * 16 + h] + bonus[((size_t)M + row) * 16 + h];
        const float o = (yn + bs * v) * siluf(bf2f(pr[C_RG + ch]));
        const float o2 = __shfl_down(o, 1);
        if ((lane & 1) == 0) *(unsigned*)(brw + (size_t)row * W + ch) = pk2(o, o2);
    }
}

__device__ __forceinline__ void phase_final(const Args& a) {
    const int tid = otid(), lane = tid & 63, wv = tid >> 6;
    const int gw = blockIdx.x * 8 + wv, NGW = gridDim.x * 8;
    for (int row = gw; row < NB * T; row += NGW) {
        float* xr = a.out + (size_t)row * D;
        f32x4 v[8]; float ss = 0.f;
#pragma unroll
        for (int j = 0; j < 8; ++j) { v[j] = *(const f32x4*)(xr + 4 * lane + 256 * j); ss += (v[j][0] * v[j][0] + v[j][1] * v[j][1]) + (v[j][2] * v[j][2] + v[j][3] * v[j][3]); }
        ss = wave_sum(ss); const float rstd = rsqrtf(ss * (1.f / D) + 1e-6f);
#pragma unroll
        for (int j = 0; j < 8; ++j) { const int col = 4 * lane + 256 * j; const f32x4 g4 = *(const f32x4*)(a.final_g + col); *(f32x4*)(xr + col) = (v[j] * rstd) * g4; }
    }
}

__global__ void __launch_bounds__(512, 2) fwd_kernel(Args a) {
    extern __shared__ __attribute__((aligned(16))) unsigned char smem[];
    LAS unsigned char* lds = (LAS unsigned char*)smem;
    cg::grid_group grid = cg::this_grid();
    const int G = gridDim.x, c = blockIdx.x;
    for (int ph = a.ph_lo; ph < a.ph_hi; ++ph) {
        if (ph > a.ph_lo) grid.sync();
        if (ph == 0) { if (PH_MASK & 1) phase_mod(a, lds); continue; }
        if (ph == 13) { if (PH_MASK & 128) phase_final(a); continue; }
        const int layer = (ph - 1) / 6, sub = (ph - 1) % 6;
        bf16_t* P = (bf16_t*)(a.ws + WS_P);
        if (sub == 0) { if (PH_MASK & 2) phase_norm_convert(a, layer, lds); }
        else if (sub == 1) {
            Gemm g; g.A = (const bf16_t*)(a.ws + WS_H); g.Bt = (const bf16_t*)(a.ws + WS_WTIN); g.lda = D; g.ldb = D; g.K = D; g.a_z = 0; g.b_z = 0;
            g.nM = 68; g.nN = 65; g.nz = 1; g.latent_only = 0; g.G = G; g.c = c;
            EpiP e; e.P = P; if (PH_MASK & 4) gemm_phase(lds, g, e);
        } else if (sub == 2) { if (PH_MASK & 8) phase_mixers(a, layer, lds); }
        else if (sub == 3) {
            if (PH_MASK & 256) phase_readout(a, layer);
            Gemm g; g.A = (const bf16_t*)(a.ws + WS_DIFF); g.Bt = (const bf16_t*)(a.ws + WS_WTPL); g.lda = W; g.ldb = 256; g.K = 256; g.a_z = 256; g.b_z = 65536;
            g.nM = layer ? 64 : 68; g.nN = 1; g.nz = 4; g.latent_only = layer; g.G = G; g.c = c;
            EpiPool e; e.P = P; e.out = (bf16_t*)(a.ws + WS_BB) + (size_t)M * W; e.scale = a.pool_scale + layer * W; if (PH_MASK & 16) gemm_phase(lds, g, e);
        } else if (sub == 4) {
            Gemm g; g.A = (const bf16_t*)(a.ws + WS_BB); g.Bt = (const bf16_t*)(a.ws + WS_WTBR); g.lda = W; g.ldb = W; g.K = W; g.a_z = (size_t)M * W; g.b_z = (size_t)D * W;
            g.nM = layer ? 64 : 68; g.nN = 8; g.nz = 3; g.latent_only = layer; g.G = G; g.c = c;
            EpiMerge e; e.P = P; e.mf = (float*)(a.ws + WS_Y); e.mb = (bf16_t*)(a.ws + WS_H); if (PH_MASK & 32) gemm_phase(lds, g, e);
        } else {
            Gemm g; g.A = (const bf16_t*)(a.ws + WS_H); g.Bt = (const bf16_t*)(a.ws + WS_WTOUT); g.lda = D; g.ldb = D; g.K = D; g.a_z = 0; g.b_z = 0;
            g.nM = layer ? 64 : 68; g.nN = 8; g.nz = 1; g.latent_only = layer; g.G = G; g.c = c;
            EpiOut e; e.xl_old = layer ? (const float*)a.out : a.x; e.xc_old = layer ? (const float*)(a.ws + WS_XCTX) : a.ctx; e.xl_new = a.out; e.xc_new = (float*)(a.ws + WS_XCTX);
            e.mod = (const float*)(a.ws + WS_MOD) + layer * 5 * 6144; if (PH_MASK & 64) gemm_phase(lds, g, e);
        }
    }
}

extern "C" void kernel_launch(void* const* d_in, const int* in_sizes, int n_in, void* d_out, int out_size, void* d_ws, size_t ws_size, hipStream_t stream) {
    static int grid = 0;
    if (grid == 0) {
        if (n_in != 24 || ws_size < WS_END) { fprintf(stderr, "kernel_launch: unexpected n_in %d or ws_size %zu (< %zu)\n", n_in, ws_size, (size_t)WS_END); grid = -1; return; }
        int dev = 0, cus = 0, per_cu = 0;
        hipGetDevice(&dev); hipDeviceGetAttribute(&cus, hipDeviceAttributeMultiprocessorCount, dev);
        if (hipFuncSetAttribute((const void*)fwd_kernel, hipFuncAttributeMaxDynamicSharedMemorySize, LDS_BYTES) != hipSuccess) { fprintf(stderr, "kernel_launch: hipFuncSetAttribute failed\n"); grid = -1; return; }
        hipOccupancyMaxActiveBlocksPerMultiprocessor(&per_cu, (const void*)fwd_kernel, 512, LDS_BYTES);
        if (per_cu < 1) { fprintf(stderr, "kernel_launch: occupancy query says %d\n", per_cu); per_cu = 1; }
        (void)hipGetLastError();
        grid = cus;
    }
    if (grid < 0) return;
    hipMemsetAsync((char*)d_ws + WS_MOD, 0, WS_MOD_BYTES, stream);
    Args a{};
    const float** pp = (const float**)&a;
    for (int i = 0; i < 24; ++i) pp[i] = (const float*)d_in[i];
    a.out = (float*)d_out; a.ws = (unsigned char*)d_ws;
#if N_LAUNCH_PER_PHASE
    for (int ph = 0; ph < NPHASE; ++ph) {
        a.ph_lo = ph; a.ph_hi = ph + 1;
        void* args[] = {&a};
        hipError_t e = hipLaunchCooperativeKernel((const void*)fwd_kernel, dim3(grid), dim3(512), args, LDS_BYTES, stream);
        if (e != hipSuccess) { fprintf(stderr, "cooperative launch failed: %s\n", hipGetErrorString(e)); break; }
    }
#else
    a.ph_lo = 0; a.ph_hi = NPHASE;
    void* args[] = {&a};
    hipError_t e = hipLaunchCooperativeKernel((const void*)fwd_kernel, dim3(grid), dim3(512), args, LDS_BYTES, stream);
    if (e != hipSuccess) fprintf(stderr, "cooperative launch failed: %s (grid %d)\n", hipGetErrorString(e), grid);
#endif
}
```

```cpp
#include <hip/hip_runtime.h>
#include <hip/hip_cooperative_groups.h>
#include <cstdio>
namespace cg = cooperative_groups;

#ifndef N_LAUNCH_PER_PHASE
#define N_LAUNCH_PER_PHASE 0
#endif

#ifndef REP_LAYERS
#define REP_LAYERS 3
#endif
#ifndef PH_MASK
#define PH_MASK 0xffff
#endif
#define LAS __attribute__((address_space(3)))
typedef unsigned short bf16_t;
typedef short bf16x8 __attribute__((ext_vector_type(8)));
typedef float f32x4 __attribute__((ext_vector_type(4)));
typedef unsigned u32x4 __attribute__((ext_vector_type(4)));
typedef unsigned u32x2 __attribute__((ext_vector_type(2)));

constexpr int D = 2048, NB = 4, T = 4096, LC = 256, TT = 4352, M = 17408, W = 1024, NP = 16640;
constexpr int C_Q = 0, C_K = 1024, C_V = 2048, C_NAG = 3072, C_PU = 4096, C_PG = 5120, C_RR = 6144, C_RK = 7168, C_RV = 8192, C_RG = 9216,
              C_MG = 10240, C_LW = 16384, C_LA = 16448;
constexpr int NPHASE = 14;
constexpr int LDS_BYTES = 147456;

constexpr size_t WS_MOD = 0, WS_MOD_BYTES = 262144;
constexpr size_t WS_BONUS = WS_MOD + WS_MOD_BYTES;
constexpr size_t WS_XCTX = WS_BONUS + 2359296;
constexpr size_t WS_WTIN = WS_XCTX + (size_t)NB * LC * D * 4;
constexpr size_t WS_WTBR = WS_WTIN + (size_t)NP * D * 2;
constexpr size_t WS_WTOUT = WS_WTBR + (size_t)3 * D * W * 2;
constexpr size_t WS_WTPL = WS_WTOUT + (size_t)D * D * 2;
constexpr size_t WS_H = WS_WTPL + (size_t)4 * 256 * 256 * 2;
constexpr size_t WS_Y = WS_H + (size_t)M * D * 2;
constexpr size_t WS_BB = WS_Y + (size_t)2 * M * W * 4;
constexpr size_t WS_DIFF = WS_BB + (size_t)3 * M * W * 2;
constexpr size_t WS_P = WS_DIFF + (size_t)M * W * 2;
constexpr size_t WS_END = WS_P + (size_t)M * NP * 2;

struct Args {
    const float *x, *c, *ctx, *c_ctx, *norm_g, *w_mod, *b_mod, *w_in, *na_rpb, *pool_w, *pool_scale, *rw_mu, *rw_w0, *rw_w2, *rw_a0, *rw_a2, *rw_k_k,
        *rw_k_a, *rw_r_k, *rw_lnx_g, *rw_lnx_b, *w_branch, *w_out, *final_g;
    float* out;
    unsigned char* ws;
    int ph_lo, ph_hi;
};

__device__ __forceinline__ float bf2f(bf16_t v) { return __uint_as_float(((unsigned)v) << 16); }
__device__ __forceinline__ float bflo(unsigned u) { return __uint_as_float(u << 16); }
__device__ __forceinline__ float bfhi(unsigned u) { return __uint_as_float(u & 0xffff0000u); }
typedef float f32x2 __attribute__((ext_vector_type(2)));
typedef __bf16 bf16x2_t __attribute__((ext_vector_type(2)));
__device__ __forceinline__ unsigned pk2(float lo, float hi) { const f32x2 v = {lo, hi}; const bf16x2_t b = __builtin_convertvector(v, bf16x2_t); return __builtin_bit_cast(unsigned, b); }
__device__ __forceinline__ float wave_sum(float v) {
#pragma unroll
    for (int o = 1; o < 64; o <<= 1) v += __shfl_xor(v, o);
    return v;
}
template <int CTRL> __device__ __forceinline__ float dppmov(float v) { return __int_as_float(__builtin_amdgcn_update_dpp(0, __float_as_int(v), CTRL, 0xF, 0xF, true)); }
__device__ __forceinline__ float sum8(float v) { v += dppmov<0xB1>(v); v += dppmov<0x4E>(v); v += dppmov<0x141>(v); return v; }
__device__ __forceinline__ float siluf(float x) { return x / (1.f + __expf(-x)); }
__device__ __forceinline__ float sigmf(float x) { return 1.f / (1.f + __expf(-x)); }
__device__ __forceinline__ int otid() { int t = threadIdx.x; asm volatile("" : "+v"(t)); return t; }
__device__ __forceinline__ void lds_wait() { asm volatile("s_waitcnt lgkmcnt(0)" ::: "memory"); }

constexpr int BM = 256, BK = 64, HALF = 128, HTB = HALF * BK * 2, NXCD = 8, WGM = 8;
__device__ __forceinline__ int lds_byte(int r, int c) { const int st = (r >> 4) * 2 + (c >> 5), rr = r & 15, cc = c & 31, ob = rr * 64 + cc * 2; return st * 1024 + (ob ^ (((ob >> 9) & 1) << 5)); }
__device__ __forceinline__ void stage_rc(int b, int& R, int& C) { const int st = b / 1024, sb = b % 1024, swz = sb ^ (((sb >> 9) & 1) << 5); R = (st >> 1) * 16 + swz / 64; C = (st & 1) * 32 + (swz % 64) / 2; }
__device__ __forceinline__ int perm32(int rho) { const int n = rho >> 4, i = rho & 15; return 8 * (i >> 2) + 4 * n + (i & 3); }

struct Unit { int pm, pn, z; };
struct Gemm {
    const bf16_t* A; const bf16_t* Bt; int lda, ldb, K; size_t a_z, b_z;
    int nM, nN, nz, latent_only, G, c;
    __device__ bool next(int i, Unit& u) const {
        const int zi = i % nz, r = i / nz; const long L = (long)r * G + c; const int nwg = nM * nN; if (L >= nwg) return false;
        int wgid = (int)L; { const int q = nwg / NXCD, rr = nwg % NXCD, xcd = wgid % NXCD, off = wgid / NXCD; wgid = (xcd < rr ? xcd * (q + 1) : rr * (q + 1) + (xcd - rr) * q) + off; }
        const int nig = WGM * nN, gid = wgid / nig, fm = gid * WGM, gsz = (nM - fm) < WGM ? (nM - fm) : WGM;
        int pm = fm + ((wgid % nig) % gsz); u.pn = (wgid % nig) / gsz; u.z = zi;
        u.pm = latent_only ? (pm / 16) * 17 + 1 + (pm % 16) : pm; return true;
    }
};

template <class Epi>
__device__ __forceinline__ void gemm_phase(LAS unsigned char* lds, const Gemm g, const Epi& E) {
    const int tid = otid(), wid = __builtin_amdgcn_readfirstlane(tid >> 6), lane = tid & 63, wr = wid >> 2, wc = wid & 3, fr = lane & 15, fq = lane >> 4;
    const int K = g.K, nt = K / BK;
    unsigned voffA[2], voffB[2];
#pragma unroll
    for (int i = 0; i < 2; ++i) { int R, C; stage_rc(tid * 16 + i * 8192, R, C); const int Rb = Epi::PERM ? ((R & ~31) + perm32(R & 31)) : R;
        voffA[i] = (unsigned)(R * g.lda + C) * 2u; voffB[i] = (unsigned)(Rb * g.ldb + C) * 2u; }
    const size_t kstep = (size_t)(BK * 2);
    const size_t hstepA = (size_t)HALF * g.lda * 2, hstepB = (size_t)HALF * g.ldb * 2;
    const unsigned ldsw = (unsigned)wid * 1024u;
    const int aoff = lds_byte(wr * 64 + fr, fq * 8), boff = lds_byte(wc * 32 + fr, fq * 8);
#define PG8_SA(b, h) (((b) * 2 + (h)) * HTB)
#define PG8_SB(b, h) ((4 + (b) * 2 + (h)) * HTB)
#define PG8_STAGE(bufoff, gbase, voff) do { _Pragma("unroll") for (int _i = 0; _i < 2; ++_i) \
        __builtin_amdgcn_global_load_lds((const unsigned*)((const char*)(gbase) + (voff)[_i]), (LAS unsigned*)(lds + (bufoff) + ldsw + _i * 8192), 16, 0, 0); } while (0)
#define PG8_LDA(dst, b, h) do { _Pragma("unroll") for (int m = 0; m < 4; ++m) _Pragma("unroll") for (int k = 0; k < 2; ++k) dst[m][k] = *(const LAS bf16x8*)(lds + PG8_SA(b, h) + aoff + m * 2048 + k * 1024); } while (0)
#define PG8_LDB(dst, b, h) do { _Pragma("unroll") for (int n = 0; n < 2; ++n) _Pragma("unroll") for (int k = 0; k < 2; ++k) dst[n][k] = *(const LAS bf16x8*)(lds + PG8_SB(b, h) + boff + n * 2048 + k * 1024); } while (0)
#define PG8_MMA(ai, bj, At, Bt) do { __builtin_amdgcn_s_setprio(1); _Pragma("unroll") for (int m = 0; m < 4; ++m) _Pragma("unroll") for (int n = 0; n < 2; ++n) _Pragma("unroll") for (int k = 0; k < 2; ++k) \
        acc[ai][bj][m][n] = __builtin_amdgcn_mfma_f32_16x16x32_bf16(Bt[n][k], At[m][k], acc[ai][bj][m][n], 0, 0, 0); __builtin_amdgcn_s_setprio(0); } while (0)
#define PG8_WAIT_V(n) asm volatile("s_waitcnt vmcnt(" #n ")" ::: "memory")
#define PG8_WAIT_L(n) asm volatile("s_waitcnt lgkmcnt(" #n ")" ::: "memory")
#define PG8_BAR __builtin_amdgcn_s_barrier()
#define PG8_SCHED __builtin_amdgcn_sched_barrier(0)
    Unit cur, nxt; int ui = 0;
    if (!g.next(0, cur)) return;
    f32x4 acc[2][2][4][2];
#pragma unroll
    for (int a = 0; a < 2; ++a)
#pragma unroll
        for (int b = 0; b < 2; ++b)
#pragma unroll
            for (int m = 0; m < 4; ++m)
#pragma unroll
                for (int n = 0; n < 2; ++n) acc[a][b][m][n] = (f32x4){0.f, 0.f, 0.f, 0.f};
    bf16x8 At[4][2], B0[2][2], B1[2][2];
    const char* cA = (const char*)(g.A + cur.z * g.a_z + (size_t)cur.pm * BM * g.lda); const char* cB = (const char*)(g.Bt + cur.z * g.b_z + (size_t)cur.pn * BM * g.ldb);
    PG8_STAGE(PG8_SB(0, 0), cB, voffB); PG8_STAGE(PG8_SA(0, 0), cA, voffA); PG8_STAGE(PG8_SB(0, 1), cB + hstepB, voffB); PG8_STAGE(PG8_SA(0, 1), cA + hstepA, voffA);
    if (wr == 1) PG8_BAR;
    PG8_WAIT_V(4); PG8_BAR;
    PG8_STAGE(PG8_SB(1, 0), cB + kstep, voffB); PG8_STAGE(PG8_SA(1, 0), cA + kstep, voffA); PG8_STAGE(PG8_SB(1, 1), cB + hstepB + kstep, voffB);
    PG8_WAIT_V(6); PG8_BAR;
    for (;;) {
        const bool has_next = g.next(ui + 1, nxt);
        const char* nA = has_next ? (const char*)(g.A + nxt.z * g.a_z + (size_t)nxt.pm * BM * g.lda) : cA;
        const char* nB = has_next ? (const char*)(g.Bt + nxt.z * g.b_z + (size_t)nxt.pn * BM * g.ldb) : cB;
        for (int t = 0; t < nt; t += 2) {
            const bool last = (t == nt - 2);
            const char* a1 = cA + (size_t)(t + 1) * kstep;
            const char* a2 = last ? nA : cA + (size_t)(t + 2) * kstep; const char* b2 = last ? nB : cB + (size_t)(t + 2) * kstep;
            const char* a3 = a2 + kstep; const char* b3 = b2 + kstep;
            PG8_LDB(B0, 0, 0); PG8_SCHED; PG8_LDA(At, 0, 0); PG8_STAGE(PG8_SA(1, 1), a1 + hstepA, voffA);
            PG8_WAIT_L(8); PG8_BAR; PG8_WAIT_L(0); PG8_MMA(0, 0, At, B0); PG8_BAR; PG8_SCHED;
            PG8_LDB(B1, 0, 1); PG8_STAGE(PG8_SB(0, 0), b2, voffB);
            PG8_BAR; PG8_WAIT_L(0); PG8_MMA(0, 1, At, B1); PG8_BAR;
            PG8_LDA(At, 0, 1); PG8_STAGE(PG8_SA(0, 0), a2, voffA);
            PG8_BAR; PG8_WAIT_L(0); PG8_MMA(1, 0, At, B0); PG8_BAR; PG8_SCHED;
            PG8_STAGE(PG8_SB(0, 1), b2 + hstepB, voffB);
            PG8_WAIT_V(6); PG8_BAR; PG8_MMA(1, 1, At, B1); PG8_BAR;
            PG8_LDB(B0, 1, 0); PG8_SCHED; PG8_LDA(At, 1, 0); PG8_STAGE(PG8_SA(0, 1), a2 + hstepA, voffA);
            PG8_WAIT_L(8); PG8_BAR; PG8_WAIT_L(0); PG8_MMA(0, 0, At, B0); PG8_BAR; PG8_SCHED;
            PG8_LDB(B1, 1, 1); PG8_STAGE(PG8_SB(1, 0), b3, voffB);
            PG8_BAR; PG8_WAIT_L(0); PG8_MMA(0, 1, At, B1); PG8_BAR;
            PG8_LDA(At, 1, 1); PG8_STAGE(PG8_SA(1, 0), a3, voffA);
            PG8_BAR; PG8_WAIT_L(0); PG8_MMA(1, 0, At, B0); PG8_BAR; PG8_SCHED;
            PG8_STAGE(PG8_SB(1, 1), b3 + hstepB, voffB);
            PG8_WAIT_V(6); PG8_BAR; PG8_MMA(1, 1, At, B1); PG8_BAR;
        }
        E(acc, cur, wr, wc, fr, fq);
        if (!has_next) break;
#pragma unroll
        for (int a = 0; a < 2; ++a)
#pragma unroll
            for (int b = 0; b < 2; ++b)
#pragma unroll
                for (int m = 0; m < 4; ++m)
#pragma unroll
                    for (int n = 0; n < 2; ++n) acc[a][b][m][n] = (f32x4){0.f, 0.f, 0.f, 0.f};
        cur = nxt; cA = nA; cB = nB; ++ui;
    }
    PG8_WAIT_V(0);
    if (wr == 0) PG8_BAR;
    PG8_BAR;
#undef PG8_SA
#undef PG8_SB
#undef PG8_STAGE
#undef PG8_LDA
#undef PG8_LDB
#undef PG8_MMA
#undef PG8_WAIT_V
#undef PG8_WAIT_L
#undef PG8_BAR
#undef PG8_SCHED
}

struct EpiP {
    static constexpr bool PERM = true;
    bf16_t* P;
    __device__ __forceinline__ void operator()(const f32x4 (&acc)[2][2][4][2], const Unit& u, int wr, int wc, int fr, int fq) const {
        const int row0 = u.pm * BM + wr * 64 + fr, col0 = u.pn * BM + wc * 32 + 8 * fq;
#pragma unroll
        for (int ai = 0; ai < 2; ++ai)
#pragma unroll
            for (int m = 0; m < 4; ++m) { bf16_t* rowp = P + (size_t)(row0 + ai * HALF + m * 16) * NP + col0;
#pragma unroll
                for (int bj = 0; bj < 2; ++bj) { const f32x4 v0 = acc[ai][bj][m][0], v1 = acc[ai][bj][m][1];
                    u32x4 o; o.x = pk2(v0[0], v0[1]); o.y = pk2(v0[2], v0[3]); o.z = pk2(v1[0], v1[1]); o.w = pk2(v1[2], v1[3]);
                    *(u32x4*)(rowp + bj * HALF) = o; } }
    }
};
struct EpiPool {
    static constexpr bool PERM = true;
    const bf16_t* P; bf16_t* out; const float* scale;
    __device__ __forceinline__ void operator()(const f32x4 (&acc)[2][2][4][2], const Unit& u, int wr, int wc, int fr, int fq) const {
        const int row0 = u.pm * BM + wr * 64 + fr, col0 = u.z * 256 + wc * 32 + 8 * fq;
#pragma unroll
        for (int ai = 0; ai < 2; ++ai)
#pragma unroll
            for (int m = 0; m < 4; ++m) { const size_t row = (size_t)(row0 + ai * HALF + m * 16);
#pragma unroll
                for (int bj = 0; bj < 2; ++bj) { const int col = col0 + bj * HALF; const f32x4 v0 = acc[ai][bj][m][0], v1 = acc[ai][bj][m][1];
                    const u32x4 gt = *(const u32x4*)(P + row * NP + C_PG + col);
                    const f32x4 s0 = *(const f32x4*)(scale + col), s1 = *(const f32x4*)(scale + col + 4);
                    u32x4 o;
                    o.x = pk2(v0[0] * s0[0] * siluf(bflo(gt.x)), v0[1] * s0[1] * siluf(bfhi(gt.x)));
                    o.y = pk2(v0[2] * s0[2] * siluf(bflo(gt.y)), v0[3] * s0[3] * siluf(bfhi(gt.y)));
                    o.z = pk2(v1[0] * s1[0] * siluf(bflo(gt.z)), v1[1] * s1[1] * siluf(bfhi(gt.z)));
                    o.w = pk2(v1[2] * s1[2] * siluf(bflo(gt.w)), v1[3] * s1[3] * siluf(bfhi(gt.w)));
                    *(u32x4*)(out + row * W + col) = o; } }
    }
};
struct EpiMerge {
    static constexpr bool PERM = false;
    const bf16_t* P; float* mf; bf16_t* mb;
    __device__ __forceinline__ void operator()(const f32x4 (&acc)[2][2][4][2], const Unit& u, int wr, int wc, int fr, int fq) const {
        const int row0 = u.pm * BM + wr * 64 + fr, col0 = u.pn * BM + wc * 32 + 4 * fq;
#pragma unroll
        for (int ai = 0; ai < 2; ++ai)
#pragma unroll
            for (int m = 0; m < 4; ++m) { const size_t row = (size_t)(row0 + ai * HALF + m * 16);
#pragma unroll
                for (int bj = 0; bj < 2; ++bj)
#pragma unroll
                    for (int n = 0; n < 2; ++n) { const int col = col0 + bj * HALF + n * 16; const f32x4 v = acc[ai][bj][m][n];
                        const u32x2 lg = *(const u32x2*)(P + row * NP + C_MG + u.z * D + col);
                        f32x4 r; r[0] = v[0] * sigmf(bflo(lg.x)); r[1] = v[1] * sigmf(bfhi(lg.x)); r[2] = v[2] * sigmf(bflo(lg.y)); r[3] = v[3] * sigmf(bfhi(lg.y));
                        float* mp = mf + row * D + col;
                        if (u.z > 0) { const f32x4 o = *(const f32x4*)mp; r += o; }
                        if (u.z < 2) *(f32x4*)mp = r;
                        else { u32x2 o; o.x = pk2(r[0], r[1]); o.y = pk2(r[2], r[3]); *(u32x2*)(mb + row * D + col) = o; } } }
    }
};
struct EpiOut {
    static constexpr bool PERM = false;
    const float* xl_old; const float* xc_old; float* xl_new; float* xc_new; const float* mod;
    __device__ __forceinline__ void operator()(const f32x4 (&acc)[2][2][4][2], const Unit& u, int wr, int wc, int fr, int fq) const {
        const int b = u.pm / 17, tl = u.pm % 17; const bool isc = (tl == 0);
        const float* xo = isc ? xc_old + (size_t)b * LC * D : xl_old + ((size_t)b * T + (tl - 1) * 256) * D;
        float* xn = isc ? xc_new + (size_t)b * LC * D : xl_new + ((size_t)b * T + (tl - 1) * 256) * D;
        const float* gp = mod + (isc ? 4 : b) * 6144 + 4096;
        const int row0 = wr * 64 + fr, col0 = u.pn * BM + wc * 32 + 4 * fq;
#pragma unroll
        for (int bj = 0; bj < 2; ++bj)
#pragma unroll
            for (int n = 0; n < 2; ++n) { const int col = col0 + bj * HALF + n * 16; const f32x4 gt = *(const f32x4*)(gp + col);
#pragma unroll
                for (int ai = 0; ai < 2; ++ai)
#pragma unroll
                    for (int m = 0; m < 4; ++m) { const size_t off = (size_t)(row0 + ai * HALF + m * 16) * D + col;
                        const f32x4 o = *(const f32x4*)(xo + off); *(f32x4*)(xn + off) = o + gt * acc[ai][bj][m][n]; } }
    }
};

__device__ __forceinline__ void phase_mod(const Args& a, LAS unsigned char* lds) {
    const int tidm = otid();
    LAS float* s = (LAS float*)lds;
    float* modp = (float*)(a.ws + WS_MOD);
    for (int task = blockIdx.x; task < 192; task += gridDim.x) {
        const int l = task / 96, rem = task % 96, cb = rem >> 3, kc = rem & 7, k0 = kc * 256;
        __syncthreads();
        for (int i = tidm; i < 5 * 256; i += 512) { const int r = i >> 8, k = i & 255; const float c = (r < 4) ? a.c[r * D + k0 + k] : a.c_ctx[k0 + k]; s[i] = c / (1.f + expf(-c)); }
        __syncthreads();
        const int n = cb * 512 + tidm;
        const float* w = a.w_mod + (size_t)l * D * 6144 + (size_t)k0 * 6144 + n;
        float a0 = 0.f, a1 = 0.f, a2 = 0.f, a3 = 0.f, a4 = 0.f;
#pragma unroll 8
        for (int k = 0; k < 256; ++k) { const float wv = w[(size_t)k * 6144]; a0 += s[k] * wv; a1 += s[256 + k] * wv; a2 += s[512 + k] * wv; a3 += s[768 + k] * wv; a4 += s[1024 + k] * wv; }
        float* mo = modp + l * 5 * 6144 + n;
        const float bias = (kc == 0) ? a.b_mod[l * 6144 + n] : 0.f;
        atomicAdd(mo, a0 + bias); atomicAdd(mo + 6144, a1 + bias); atomicAdd(mo + 2 * 6144, a2 + bias); atomicAdd(mo + 3 * 6144, a3 + bias); atomicAdd(mo + 4 * 6144, a4 + bias);
    }
}

__device__ __forceinline__ void transpose_item(const float* Wsrc, int ldsrc, int k0, int nsrc0, bf16_t* dst, int ldd, LAS float* scr, int lane) {
    if (nsrc0 >= 0) {
#pragma unroll 8
        for (int i = 0; i < 32; ++i) { const int kk = 2 * i + (lane >> 5); scr[kk * 33 + (lane & 31)] = Wsrc[(size_t)(k0 + kk) * ldsrc + nsrc0 + (lane & 31)]; }
    } else {
#pragma unroll 8
        for (int i = 0; i < 32; ++i) { const int kk = 2 * i + (lane >> 5); scr[kk * 33 + (lane & 31)] = 0.f; }
    }
    lds_wait();
    const int c = lane & 7;
#pragma unroll
    for (int j = 0; j < 4; ++j) { const int n = (lane >> 3) + 8 * j; const LAS float* s = scr + (8 * c) * 33 + n;
        u32x4 o; o.x = pk2(s[0 * 33], s[1 * 33]); o.y = pk2(s[2 * 33], s[3 * 33]); o.z = pk2(s[4 * 33], s[5 * 33]); o.w = pk2(s[6 * 33], s[7 * 33]);
        *(u32x4*)(dst + (size_t)n * ldd + k0 + 8 * c) = o; }
    lds_wait();
}
__device__ __forceinline__ void phase_norm_convert(const Args& a, int layer, LAS unsigned char* lds) {
    const int tid = otid(), lane = tid & 63, wv = tid >> 6;
    const int gw = blockIdx.x * 8 + wv, NGW = gridDim.x * 8;
    {
        LAS float* scr = (LAS float*)(lds + wv * 8448);
        bf16_t* wtin = (bf16_t*)(a.ws + WS_WTIN); bf16_t* wtbr = (bf16_t*)(a.ws + WS_WTBR); bf16_t* wtout = (bf16_t*)(a.ws + WS_WTOUT); bf16_t* wtpl = (bf16_t*)(a.ws + WS_WTPL);
        constexpr int I_IN = 32 * 520, I_BR = 16 * 64, I_OUT = 32 * 64, I_PL = 4 * 8;
        constexpr int NIT = I_IN + 3 * I_BR + I_OUT + 4 * I_PL;
        for (int it = gw; it < NIT; it += NGW) {
            int r = it;
            if (r < I_IN) { const int kb = r / 520, nb = r % 520, n0 = nb * 32; const int ns = n0 < 10240 ? n0 : (n0 < 16384 ? n0 + 128 : (n0 < 16512 ? n0 - 6144 : -1));
                transpose_item(a.w_in + (size_t)layer * D * 16512, 16512, kb * 64, ns, wtin + (size_t)n0 * D, D, scr, lane); continue; }
            r -= I_IN;
            if (r < 3 * I_BR) { const int z = r / I_BR, q = r % I_BR, kb = q / 64, nb = q % 64;
                transpose_item(a.w_branch + ((size_t)layer * 3 + z) * W * D, D, kb * 64, nb * 32, wtbr + (size_t)z * D * W + (size_t)nb * 32 * W, W, scr, lane); continue; }
            r -= 3 * I_BR;
            if (r < I_OUT) { const int kb = r / 64, nb = r % 64;
                transpose_item(a.w_out + (size_t)layer * D * D, D, kb * 64, nb * 32, wtout + (size_t)nb * 32 * D, D, scr, lane); continue; }
            r -= I_OUT;
            { const int z = r / I_PL, q = r % I_PL, kb = q / 8, nb = q % 8;
                transpose_item(a.pool_w + ((size_t)layer * 4 + z) * 65536, 256, kb * 64, nb * 32, wtpl + (size_t)z * 65536 + (size_t)nb * 32 * 256, 256, scr, lane); }
        }
    }
    const float* ng = a.norm_g + layer * D;
    const float* mo = (const float*)(a.ws + WS_MOD) + layer * 5 * 6144;
    const float* xctx = (const float*)(a.ws + WS_XCTX);
    bf16_t* h = (bf16_t*)(a.ws + WS_H);
    for (int row = gw; row < M; row += NGW) {
        const int b = row / TT, t = row % TT; const float* xr; int mr;
        if (t < LC) { xr = (layer == 0 ? a.ctx : xctx) + (size_t)(b * LC + t) * D; mr = 4; }
        else { xr = (layer == 0 ? a.x : (const float*)a.out) + (size_t)(b * T + t - LC) * D; mr = b; }
        f32x4 v[8]; float ss = 0.f;
#pragma unroll
        for (int j = 0; j < 8; ++j) { v[j] = *(const f32x4*)(xr + 4 * lane + 256 * j); ss += (v[j][0] * v[j][0] + v[j][1] * v[j][1]) + (v[j][2] * v[j][2] + v[j][3] * v[j][3]); }
        ss = wave_sum(ss); const float rstd = rsqrtf(ss * (1.f / D) + 1e-6f);
        const float* mrow = mo + mr * 6144;
#pragma unroll
        for (int j = 0; j < 8; ++j) { const int col = 4 * lane + 256 * j; const f32x4 g4 = *(const f32x4*)(ng + col), sh = *(const f32x4*)(mrow + col), sc = *(const f32x4*)(mrow + 2048 + col);
            f32x4 o = (v[j] * rstd) * g4; o = o * (sc + 1.f) + sh;
            u32x2 pk; pk.x = pk2(o[0], o[1]); pk.y = pk2(o[2], o[3]); *(u32x2*)(h + (size_t)row * D + col) = pk; }
    }
}

__device__ __forceinline__ float wsum(float v) {
    v += dppmov<0xB1>(v); v += dppmov<0x4E>(v); v += dppmov<0x141>(v); v += dppmov<0x140>(v);
    const int iv = __float_as_int(v);
    return (__int_as_float(__builtin_amdgcn_readlane(iv, 0)) + __int_as_float(__builtin_amdgcn_readlane(iv, 16))) +
           (__int_as_float(__builtin_amdgcn_readlane(iv, 32)) + __int_as_float(__builtin_amdgcn_readlane(iv, 48)));
}
__device__ __forceinline__ bf16_t f2bf(float x) { return (bf16_t)(pk2(x, x) & 0xffffu); }
__device__ __forceinline__ bf16x8 ldsfrag(const LAS bf16_t* p) { return *(const LAS bf16x8*)p; }
#define MFMA16(a_, b_, c_) __builtin_amdgcn_mfma_f32_16x16x32_bf16(a_, b_, c_, 0, 0, 0)

__device__ __forceinline__ void scan_item(const Args& a, int layer, int item, LAS unsigned char* lds) {
    const int tid = otid(), lane = tid & 63, wv = __builtin_amdgcn_readfirstlane(tid >> 6), fr = lane & 15, fq = lane >> 4;
    const int b = item >> 5, h = (item >> 1) & 15, dir = item & 1;
    LAS float* W2s = (LAS float*)lds;
    LAS float* A2s = W2s + 4096;
    LAS float* LWs = A2s + 4096;
    LAS float* LAs = LWs + 2048;
    LAS float* LD = LAs + 2048;
    LAS float* N1t = LD + 2048;
    LAS float* gC = N1t + 1152;
    LAS bf16_t* At = (LAS bf16_t*)(gC + 64);
    LAS bf16_t* Bn = At + 2304;
    LAS bf16_t* Kn = Bn + 2304;
    LAS bf16_t* Rt = Kn + 2304;
    LAS bf16_t* BpT = Rt + 2304;
    LAS bf16_t* KpT = BpT + 2560;
    LAS bf16_t* Vt = KpT + 2560;
    LAS bf16_t* M2t = Vt + 2560;
    LAS bf16_t* M3t = M2t + 1280;
    LAS bf16_t* M4t = M3t + 1280;
    LAS bf16_t* Tmt = M4t + 1280;
    LAS bf16_t* Xs = Tmt + 1280;
    LAS bf16_t* Us = Xs + 2560;
    LAS bf16_t* S0s = Us + 2560;
    const bf16_t* P = (const bf16_t*)(a.ws + WS_P);
    float* ybuf = (float*)(a.ws + WS_Y);
    float* bonus = (float*)(a.ws + WS_BONUS);
    __syncthreads();
    {
        const float* w2 = a.rw_w2 + ((size_t)(layer * 2 + dir) * 64) * W + h * 64;
        const float* a2 = a.rw_a2 + ((size_t)(layer * 2 + dir) * 64) * W + h * 64;
        for (int i = tid; i < 4096; i += 512) { const int l = i >> 6, c = i & 63; W2s[i] = w2[l * W + c]; A2s[i] = a2[l * W + c]; }
        for (int i = tid; i < 4608; i += 512) ((LAS unsigned*)S0s)[i] = 0u;
    }
    const int ch = h * 64 + lane;
    const float mu_r = a.rw_mu[(layer * 3 + 0) * W + ch], mu_k = a.rw_mu[(layer * 3 + 1) * W + ch], mu_v = a.rw_mu[(layer * 3 + 2) * W + ch];
    const float w0 = a.rw_w0[(layer * 2 + dir) * W + ch], a0 = a.rw_a0[(layer * 2 + dir) * W + ch];
    const float kk_c = a.rw_k_k[layer * W + ch], ka_c = a.rw_k_a[layer * W + ch], rk_c = a.rw_r_k[layer * W + ch];
    f32x4 Sacc[2];
    Sacc[0] = (f32x4){0.f, 0.f, 0.f, 0.f}; Sacc[1] = (f32x4){0.f, 0.f, 0.f, 0.f};
    int cur = 0;
    const int tt = wv >> 2, it = wv & 3;
    __syncthreads();
    for (int seg = 0; seg < 2; ++seg) {
        const int slen = seg ? T : LC; const int rowbase = b * TT + (seg ? LC : 0);
        for (int ck = 0; ck < slen / 32; ++ck) {
            float r_[4], kd_[4], kk_[4], av_[4], v_[4], ld_[4];
#pragma unroll
            for (int q = 0; q < 4; ++q) {
                const int p = wv * 4 + q, pi = ck * 32 + p, t = dir ? (slen - 1 - pi) : pi;
                const bf16_t* pr = P + (size_t)(rowbase + t) * NP;
                LWs[p * 64 + lane] = tanhf(bf2f(pr[C_LW + lane])); LAs[p * 64 + lane] = bf2f(pr[C_LA + lane]);
                const float r0 = bf2f(pr[C_RR + ch]), k0 = bf2f(pr[C_RK + ch]), v0 = bf2f(pr[C_RV + ch]);
                float rs = 0.f, ks = 0.f, vs = 0.f;
                if (t > 0) { rs += bf2f(pr[C_RR + ch - NP]); ks += bf2f(pr[C_RK + ch - NP]); vs += bf2f(pr[C_RV + ch - NP]); }
                if (t < slen - 1) { rs += bf2f(pr[C_RR + ch + NP]); ks += bf2f(pr[C_RK + ch + NP]); vs += bf2f(pr[C_RV + ch + NP]); }
                r_[q] = r0 + mu_r * (0.5f * rs - r0); kd_[q] = k0 + mu_k * (0.5f * ks - k0); v_[q] = v0 + mu_v * (0.5f * vs - v0);
                const float kku = kd_[q] * kk_c; const float ss = wsum(kku * kku);
                kk_[q] = kku / fmaxf(sqrtf(ss), 1e-12f);
            }
            lds_wait();
            {
                float wp[4], ap[4];
#pragma unroll
                for (int q = 0; q < 4; ++q) { wp[q] = w0; ap[q] = a0; }
                for (int l = 0; l < 64; l += 4) {
                    float w2v[4], a2v[4];
#pragma unroll
                    for (int u = 0; u < 4; ++u) { w2v[u] = W2s[(l + u) * 64 + lane]; a2v[u] = A2s[(l + u) * 64 + lane]; }
#pragma unroll
                    for (int q = 0; q < 4; ++q) { const f32x4 lw4 = *(const LAS f32x4*)(LWs + (wv * 4 + q) * 64 + l), la4 = *(const LAS f32x4*)(LAs + (wv * 4 + q) * 64 + l);
                        wp[q] += lw4[0] * w2v[0] + lw4[1] * w2v[1] + lw4[2] * w2v[2] + lw4[3] * w2v[3];
                        ap[q] += la4[0] * a2v[0] + la4[1] * a2v[1] + la4[2] * a2v[2] + la4[3] * a2v[3]; }
                }
#pragma unroll
                for (int q = 0; q < 4; ++q) {
                    const int p = wv * 4 + q, pi = ck * 32 + p, t = dir ? (slen - 1 - pi) : pi;
                    ld_[q] = -0.6065306597f / (1.f + expf(-wp[q]));
                    av_[q] = 1.f / (1.f + expf(-ap[q]));
                    kd_[q] = kd_[q] * (1.f + (av_[q] - 1.f) * ka_c);
                    LD[p * 64 + lane] = ld_[q];
                    const float bs = wsum(r_[q] * kd_[q] * rk_c);
                    if (lane == 0) bonus[((size_t)dir * M + rowbase + t) * 16 + h] = bs;
                }
            }
            __syncthreads();
            {
                float cprev = 0.f;
                for (int p2 = 0; p2 < wv * 4; ++p2) cprev += LD[p2 * 64 + lane];
                float ctot = cprev;
                for (int p2 = wv * 4; p2 < 32; ++p2) ctot += LD[p2 * 64 + lane];
                float cum = cprev;
#pragma unroll
                for (int q = 0; q < 4; ++q) {
                    const int p = wv * 4 + q;
                    cum += ld_[q];
                    const float eg = __expf(cum), egi = __expf(-cum), egm = __expf(cum - ld_[q]), egc = __expf(ctot - cum);
                    const float bq = kk_[q] * av_[q];
                    At[p * 72 + lane] = f2bf(-kk_[q] * egm); Bn[p * 72 + lane] = f2bf(bq * egi); Kn[p * 72 + lane] = f2bf(kd_[q] * egi); Rt[p * 72 + lane] = f2bf(r_[q] * eg);
                    BpT[lane * 40 + p] = f2bf(bq * egc); KpT[lane * 40 + p] = f2bf(kd_[q] * egc); Vt[lane * 40 + p] = f2bf(v_[q]);
                }
                if (wv == 0) gC[lane] = __expf(ctot);
            }
            __syncthreads();
#pragma unroll
            for (int k2 = 0; k2 < 2; ++k2) {
                const int tile = wv * 2 + k2, mi = tile >> 2, st = (tile >> 1) & 1, t2 = tile & 1;
                const LAS bf16_t* Ap = ((mi & 1) ? Kn : Bn) + (st * 16 + fr) * 72 + fq * 8;
                const LAS bf16_t* Bp = ((mi >> 1) ? Rt : At) + (t2 * 16 + fr) * 72 + fq * 8;
                f32x4 acc = (f32x4){0.f, 0.f, 0.f, 0.f};
                acc = MFMA16(ldsfrag(Ap), ldsfrag(Bp), acc); acc = MFMA16(ldsfrag(Ap + 32), ldsfrag(Bp + 32), acc);
                const int t = t2 * 16 + fr, s0 = st * 16 + fq * 4;
#pragma unroll
                for (int rg = 0; rg < 4; ++rg) { const int s = s0 + rg; const bool keep = (mi < 2) ? (s < t) : (s <= t); if (!keep) acc[rg] = 0.f; }
                if (mi == 0) *(LAS f32x4*)(N1t + t * 36 + s0) = acc;
                else { LAS bf16_t* Mp = (mi == 1 ? M2t : (mi == 2 ? M3t : M4t)) + t * 40 + s0; u32x2 o; o.x = pk2(acc[0], acc[1]); o.y = pk2(acc[2], acc[3]); *(LAS u32x2*)Mp = o; }
            }
            __syncthreads();
            const LAS bf16_t* S0c = S0s + cur * 4608;
            {
                const LAS bf16_t* Ap = At + (tt * 16 + fr) * 72 + fq * 8; const LAS bf16_t* Bp = S0c + (it * 16 + fr) * 72 + fq * 8;
                f32x4 acc = (f32x4){0.f, 0.f, 0.f, 0.f};
                acc = MFMA16(ldsfrag(Ap), ldsfrag(Bp), acc); acc = MFMA16(ldsfrag(Ap + 32), ldsfrag(Bp + 32), acc);
                acc = MFMA16(ldsfrag(M2t + (tt * 16 + fr) * 40 + fq * 8), ldsfrag(Vt + (it * 16 + fr) * 40 + fq * 8), acc);
                u32x2 o; o.x = pk2(acc[0], acc[1]); o.y = pk2(acc[2], acc[3]);
                *(LAS u32x2*)(Xs + (it * 16 + fr) * 40 + tt * 16 + fq * 4) = o;
            }
            if (wv == 0 && lane < 32) {
                float Tr[32];
#pragma unroll
                for (int t = 0; t < 32; ++t) {
                    float acc = (lane == t) ? 1.f : 0.f;
#pragma unroll
                    for (int s4 = 0; s4 < (t + 3) / 4; ++s4) { const f32x4 n4 = *(const LAS f32x4*)(N1t + t * 36 + s4 * 4);
#pragma unroll
                        for (int u = 0; u < 4; ++u) if (s4 * 4 + u < t) acc += Tr[s4 * 4 + u] * n4[u]; }
                    Tr[t] = acc;
                }
#pragma unroll
                for (int t = 0; t < 32; ++t) Tmt[t * 40 + lane] = f2bf(Tr[t]);
            }
            __syncthreads();
            {
                f32x4 acc = (f32x4){0.f, 0.f, 0.f, 0.f};
                acc = MFMA16(ldsfrag(Tmt + (tt * 16 + fr) * 40 + fq * 8), ldsfrag(Xs + (it * 16 + fr) * 40 + fq * 8), acc);
                u32x2 o; o.x = pk2(acc[0], acc[1]); o.y = pk2(acc[2], acc[3]);
                *(LAS u32x2*)(Us + (it * 16 + fr) * 40 + tt * 16 + fq * 4) = o;
            }
            __syncthreads();
            {
                const LAS bf16_t* Ap = S0c + (it * 16 + fr) * 72 + fq * 8; const LAS bf16_t* Bp = Rt + (tt * 16 + fr) * 72 + fq * 8;
                f32x4 acc = (f32x4){0.f, 0.f, 0.f, 0.f};
                acc = MFMA16(ldsfrag(Ap), ldsfrag(Bp), acc); acc = MFMA16(ldsfrag(Ap + 32), ldsfrag(Bp + 32), acc);
                const bf16x8 uf = ldsfrag(Us + (it * 16 + fr) * 40 + fq * 8), vf = ldsfrag(Vt + (it * 16 + fr) * 40 + fq * 8);
                acc = MFMA16(uf, ldsfrag(M3t + (tt * 16 + fr) * 40 + fq * 8), acc);
                acc = MFMA16(vf, ldsfrag(M4t + (tt * 16 + fr) * 40 + fq * 8), acc);
                const int p = tt * 16 + fr, pi = ck * 32 + p, t = dir ? (slen - 1 - pi) : pi;
                *(f32x4*)(ybuf + ((size_t)dir * M + rowbase + t) * W + h * 64 + it * 16 + fq * 4) = acc;
                LAS bf16_t* S0n = S0s + (cur ^ 1) * 4608;
#pragma unroll
                for (int k2 = 0; k2 < 2; ++k2) {
                    const int jt = tt * 2 + k2;
                    const f32x4 g4 = *(const LAS f32x4*)(gC + jt * 16 + fq * 4);
                    f32x4 s = Sacc[k2] * g4;
                    s = MFMA16(ldsfrag(BpT + (jt * 16 + fr) * 40 + fq * 8), uf, s);
                    s = MFMA16(ldsfrag(KpT + (jt * 16 + fr) * 40 + fq * 8), vf, s);
                    Sacc[k2] = s;
                    u32x2 o; o.x = pk2(s[0], s[1]); o.y = pk2(s[2], s[3]);
                    *(LAS u32x2*)(S0n + (it * 16 + fr) * 72 + jt * 16 + fq * 4) = o;
                }
            }
            cur ^= 1;
        }
    }
}


__device__ __forceinline__ int clampi(int v, int lo, int hi) { return v < lo ? lo : (v > hi ? hi : v); }

__device__ __forceinline__ void attn_unit(const Args& a, int layer, int unit, bool isctx, LAS unsigned char* lds) {
    const int tid = otid(), lane = tid & 63, wv = tid >> 6, fr = lane & 15, fq = lane >> 4;
    constexpr int VS = 840;
    LAS bf16_t* Vt = (LAS bf16_t*)lds;
    LAS float* rpbs = (LAS float*)(lds + 64 * VS * 2);
    const bf16_t* P = (const bf16_t*)(a.ws + WS_P);
    bf16_t* bna = (bf16_t*)(a.ws + WS_BB);
    int b, h, rp = 0, half = 0;
    if (!isctx) { b = unit >> 9; h = (unit >> 5) & 15; rp = unit & 31; } else { b = unit >> 5; h = (unit >> 1) & 15; half = unit & 1; }
    int r0a = 0, nloc = 0;
    if (!isctx) { r0a = clampi(2 * rp - 4, 0, 56); const int r0b = clampi(2 * rp - 3, 0, 56); nloc = (r0b + 8 - r0a) * 64; }
    __syncthreads();
    for (int cidx = tid; cidx < nloc * 8; cidx += 512) { const int key = cidx >> 3, dc = cidx & 7;
        const u32x4 v = *(const u32x4*)(P + (size_t)(b * TT + LC + r0a * 64 + key) * NP + C_V + h * 64 + dc * 8);
        LAS bf16_t* d = Vt + (dc * 8) * VS + key;
        d[0] = (bf16_t)(v.x & 0xffff); d[VS] = (bf16_t)(v.x >> 16); d[2 * VS] = (bf16_t)(v.y & 0xffff); d[3 * VS] = (bf16_t)(v.y >> 16);
        d[4 * VS] = (bf16_t)(v.z & 0xffff); d[5 * VS] = (bf16_t)(v.z >> 16); d[6 * VS] = (bf16_t)(v.w & 0xffff); d[7 * VS] = (bf16_t)(v.w >> 16); }
    for (int cidx = tid; cidx < 256 * 8; cidx += 512) { const int key = cidx >> 3, dc = cidx & 7;
        const u32x4 v = *(const u32x4*)(P + (size_t)(b * TT + key) * NP + C_V + h * 64 + dc * 8);
        LAS bf16_t* d = Vt + (dc * 8) * VS + 576 + key;
        d[0] = (bf16_t)(v.x & 0xffff); d[VS] = (bf16_t)(v.x >> 16); d[2 * VS] = (bf16_t)(v.y & 0xffff); d[3 * VS] = (bf16_t)(v.y >> 16);
        d[4 * VS] = (bf16_t)(v.z & 0xffff); d[5 * VS] = (bf16_t)(v.z >> 16); d[6 * VS] = (bf16_t)(v.w & 0xffff); d[7 * VS] = (bf16_t)(v.w >> 16); }
    if (!isctx) for (int i = tid; i < 465; i += 512) rpbs[i] = a.na_rpb[(size_t)(layer * 16 + h) * 465 + i];
    __syncthreads();

    int qtok, r = 0, qc = 0, cs = 0, r0 = 0;
    if (!isctx) { r = 2 * rp + (wv >> 2); const int g = wv & 3; qc = g * 16 + fr; cs = (g == 0) ? 0 : (g == 1 ? 8 : (g == 2 ? 24 : 32)); r0 = clampi(r - 4, 0, 56); qtok = b * TT + LC + r * 64 + qc; }
    else qtok = b * TT + half * 128 + wv * 16 + fr;
    bf16x8 qf[2];
    qf[0] = *(const bf16x8*)(P + (size_t)qtok * NP + C_Q + h * 64 + fq * 8);
    qf[1] = *(const bf16x8*)(P + (size_t)qtok * NP + C_Q + h * 64 + 32 + fq * 8);
    const int cstart = clampi(qc - 8, 0, 48);
    float mrun = -1e30f, lrun = 0.f;
    f32x4 o[4];
#pragma unroll
    for (int dt = 0; dt < 4; ++dt) o[dt] = (f32x4){0.f, 0.f, 0.f, 0.f};
    const int nblk = isctx ? 8 : 16;
    for (int blk = 0; blk < nblk; ++blk) {
        const bool loc = (!isctx) && (blk < 8);
        const int gr = r0 + blk;
        f32x4 s[2];
#pragma unroll
        for (int ti = 0; ti < 2; ++ti) {
            size_t ktok;
            if (loc) ktok = (size_t)(b * TT + LC + gr * 64 + cs + ti * 16 + fr); else ktok = (size_t)(b * TT + ((blk & 7) * 32) + ti * 16 + fr);
            const bf16_t* kp = P + ktok * NP + C_K + h * 64 + fq * 8;
            const bf16x8 k0 = *(const bf16x8*)kp, k1 = *(const bf16x8*)(kp + 32);
            f32x4 z = (f32x4){0.f, 0.f, 0.f, 0.f};
            z = __builtin_amdgcn_mfma_f32_16x16x32_bf16(k0, qf[0], z, 0, 0, 0);
            s[ti] = __builtin_amdgcn_mfma_f32_16x16x32_bf16(k1, qf[1], z, 0, 0, 0);
        }
        float sv[8];
        if (loc) {
            const LAS float* brow = rpbs + (gr - r + 7) * 31;
#pragma unroll
            for (int ti = 0; ti < 2; ++ti)
#pragma unroll
                for (int rg = 0; rg < 4; ++rg) { const int kc = cs + ti * 16 + fq * 4 + rg; const bool valid = (kc >= cstart) && (kc < cstart + 16);
                    const int co = clampi(kc - qc + 15, 0, 30); sv[ti * 4 + rg] = valid ? (s[ti][rg] * 0.125f + brow[co]) : -1e30f; }
        } else {
#pragma unroll
            for (int ti = 0; ti < 2; ++ti)
#pragma unroll
                for (int rg = 0; rg < 4; ++rg) sv[ti * 4 + rg] = s[ti][rg] * 0.125f;
        }
        float mx = fmaxf(fmaxf(fmaxf(sv[0], sv[1]), fmaxf(sv[2], sv[3])), fmaxf(fmaxf(sv[4], sv[5]), fmaxf(sv[6], sv[7])));
        mx = fmaxf(mx, __shfl_xor(mx, 16)); mx = fmaxf(mx, __shfl_xor(mx, 32));
        const float mnew = fmaxf(mrun, mx); const float alpha = __expf(mrun - mnew); mrun = mnew;
        float ps = 0.f; float pv[8];
#pragma unroll
        for (int i = 0; i < 8; ++i) { pv[i] = __expf(sv[i] - mnew); ps += pv[i]; }
        lrun = lrun * alpha + ps;
#pragma unroll
        for (int dt = 0; dt < 4; ++dt) o[dt] *= alpha;
        u32x4 pp; pp.x = pk2(pv[0], pv[1]); pp.y = pk2(pv[2], pv[3]); pp.z = pk2(pv[4], pv[5]); pp.w = pk2(pv[6], pv[7]);
        const bf16x8 pf = __builtin_bit_cast(bf16x8, pp);
        const int kbase = loc ? ((gr - r0a) * 64 + cs) : (576 + (blk & 7) * 32);
#pragma unroll
        for (int dt = 0; dt < 4; ++dt) { const LAS bf16_t* vp = Vt + (dt * 16 + fr) * VS + kbase + fq * 4;
            const u32x2 lo = *(const LAS u32x2*)vp, hi = *(const LAS u32x2*)(vp + 16);
            u32x4 vv; vv.x = lo.x; vv.y = lo.y; vv.z = hi.x; vv.w = hi.y;
            o[dt] = __builtin_amdgcn_mfma_f32_16x16x32_bf16(__builtin_bit_cast(bf16x8, vv), pf, o[dt], 0, 0, 0); }
    }
    lrun += __shfl_xor(lrun, 16); lrun += __shfl_xor(lrun, 32);
    const float inv = 1.f / lrun;
#pragma unroll
    for (int dt = 0; dt < 4; ++dt) { const int dcol = h * 64 + dt * 16 + fq * 4;
        const u32x2 gt = *(const u32x2*)(P + (size_t)qtok * NP + C_NAG + dcol);
        u32x2 ov; ov.x = pk2(o[dt][0] * inv * siluf(bflo(gt.x)), o[dt][1] * inv * siluf(bfhi(gt.x))); ov.y = pk2(o[dt][2] * inv * siluf(bflo(gt.y)), o[dt][3] * inv * siluf(bfhi(gt.y)));
        *(u32x2*)(bna + (size_t)qtok * W + dcol) = ov; }
}

__device__ __forceinline__ void pool_unit(const Args& a, int unit) {
    const int tid = otid();
    const bf16_t* P = (const bf16_t*)(a.ws + WS_P);
    bf16_t* diff = (bf16_t*)(a.ws + WS_DIFF);
    const int cc = tid & 127, g = cc >> 5, hw = 1 << g;
    for (int pass = 0; pass < 8; ++pass) {
        const int row = unit * 32 + pass * 4 + (tid >> 7); const int b = row / TT, t = row % TT;
        int s0, slen, tl; if (t < LC) { s0 = b * TT; slen = LC; tl = t; } else { s0 = b * TT + LC; slen = T; tl = t - LC; }
        const int lo = max(tl - hw, 0), hi = min(tl + hw, slen);
        float sm[8];
#pragma unroll
        for (int j = 0; j < 8; ++j) sm[j] = 0.f;
        for (int s = lo; s < hi; ++s) { const u32x4 v = *(const u32x4*)(P + (size_t)(s0 + s) * NP + C_PU + cc * 8);
            sm[0] += bflo(v.x); sm[1] += bfhi(v.x); sm[2] += bflo(v.y); sm[3] += bfhi(v.y); sm[4] += bflo(v.z); sm[5] += bfhi(v.z); sm[6] += bflo(v.w); sm[7] += bfhi(v.w); }
        const float inv = 1.f / (float)(hi - lo);
        const u32x4 u = *(const u32x4*)(P + (size_t)row * NP + C_PU + cc * 8);
        u32x4 o; o.x = pk2(sm[0] * inv - bflo(u.x), sm[1] * inv - bfhi(u.x)); o.y = pk2(sm[2] * inv - bflo(u.y), sm[3] * inv - bfhi(u.y));
        o.z = pk2(sm[4] * inv - bflo(u.z), sm[5] * inv - bfhi(u.z)); o.w = pk2(sm[6] * inv - bflo(u.w), sm[7] * inv - bfhi(u.w));
        *(u32x4*)(diff + (size_t)row * W + cc * 8) = o;
    }
}

__device__ __forceinline__ void phase_mixers(const Args& a, int layer, LAS unsigned char* lds) {
    const int G = gridDim.x, bid = blockIdx.x;
    const int nsc = (G >= 192) ? 128 : 0;
    if (PH_MASK & 0x200) { if (nsc) { if (bid < nsc) { scan_item(a, layer, bid, lds); return; } }
    else { for (int it = bid; it < 128; it += G) scan_item(a, layer, it, lds); } }
    const int w = nsc ? bid - nsc : bid, nw = nsc ? G - nsc : G;
    const int n_lat = 2048, n_ctx = (layer == 0) ? 128 : 0, n_pool = 544;
    for (int u = w; u < n_lat + n_ctx + n_pool; u += nw) {
        if (u < n_lat) { if (PH_MASK & 0x400) attn_unit(a, layer, u, false, lds); }
        else if (u < n_lat + n_ctx) { if (PH_MASK & 0x400) attn_unit(a, layer, u - n_lat, true, lds); }
        else if (PH_MASK & 0x800) pool_unit(a, u - n_lat - n_ctx);
    }
}

__device__ __forceinline__ void phase_readout(const Args& a, int layer) {
    const int tid = otid(), lane = tid & 63, wv = tid >> 6;
    const int gw = blockIdx.x * 8 + wv, NGW = gridDim.x * 8;
    const bf16_t* P = (const bf16_t*)(a.ws + WS_P);
    const float* ybuf = (const float*)(a.ws + WS_Y);
    const float* bonus = (const float*)(a.ws + WS_BONUS);
    bf16_t* brw = (bf16_t*)(a.ws + WS_BB) + (size_t)2 * M * W;
    for (int it = gw; it < M * 16; it += NGW) {
        const int row = it >> 4, h = it & 15; const int b = row / TT, t = row % TT;
        if (layer == 1 && t < LC) continue;
        const int ch = h * 64 + lane;
        int tl, slen; if (t < LC) { tl = t; slen = LC; } else { tl = t - LC; slen = T; }
        const float y = ybuf[(size_t)row * W + ch] + ybuf[((size_t)M + row) * W + ch];
        const float mean = wave_sum(y) * (1.f / 64.f); const float dv = y - mean; const float var = wave_sum(dv * dv) * (1.f / 64.f);
        const float yn = dv * rsqrtf(var + 64e-5f) * a.rw_lnx_g[layer * W + ch] + a.rw_lnx_b[layer * W + ch];
        const bf16_t* pr = P + (size_t)row * NP;
        const float v0 = bf2f(pr[C_RV + ch]); float vs = 0.f;
        if (tl > 0) vs += bf2f(pr[C_RV + ch - NP]);
        if (tl < slen - 1) vs += bf2f(pr[C_RV + ch + NP]);
        const float v = v0 + a.rw_mu[(layer * 3 + 2) * W + ch] * (0.5f * vs - v0);
        const float bs = bonus[(size_t)row * 16 + h] + bonus[((size_t)M + row) * 16 + h];
        const float o = (yn + bs * v) * siluf(bf2f(pr[C_RG + ch]));
        const float o2 = __shfl_down(o, 1);
        if ((lane & 1) == 0) *(unsigned*)(brw + (size_t)row * W + ch) = pk2(o, o2);
    }
}

__device__ __forceinline__ void phase_final(const Args& a) {
    const int tid = otid(), lane = tid & 63, wv = tid >> 6;
    const int gw = blockIdx.x * 8 + wv, NGW = gridDim.x * 8;
    for (int row = gw; row < NB * T; row += NGW) {
        float* xr = a.out + (size_t)row * D;
        f32x4 v[8]; float ss = 0.f;
#pragma unroll
        for (int j = 0; j < 8; ++j) { v[j] = *(const f32x4*)(xr + 4 * lane + 256 * j); ss += (v[j][0] * v[j][0] + v[j][1] * v[j][1]) + (v[j][2] * v[j][2] + v[j][3] * v[j][3]); }
        ss = wave_sum(ss); const float rstd = rsqrtf(ss * (1.f / D) + 1e-6f);
#pragma unroll
        for (int j = 0; j < 8; ++j) { const int col = 4 * lane + 256 * j; const f32x4 g4 = *(const f32x4*)(a.final_g + col); *(f32x4*)(xr + col) = (v[j] * rstd) * g4; }
    }
}

__global__ void __launch_bounds__(512, 2) fwd_kernel(Args a) {
    extern __shared__ __attribute__((aligned(16))) unsigned char smem[];
    LAS unsigned char* lds = (LAS unsigned char*)smem;
    cg::grid_group grid = cg::this_grid();
    const int G = gridDim.x, c = blockIdx.x;
    for (int ph = a.ph_lo; ph < a.ph_hi; ++ph) {
        if (ph > a.ph_lo) grid.sync();
        if (ph == 0) { if (PH_MASK & 1) phase_mod(a, lds); continue; }
        if (ph == 13) { if (PH_MASK & 128) phase_final(a); continue; }
        const int layer = (ph - 1) / 6, sub = (ph - 1) % 6;
        int nrep = 1;
#ifdef REP_SUB
        if (sub == REP_SUB && ((REP_LAYERS >> layer) & 1)) nrep = 2;
#endif
        for (int rep = 0; rep < nrep; ++rep) {
        if (rep) grid.sync();
        bf16_t* P = (bf16_t*)(a.ws + WS_P);
        if (sub == 0) { if (PH_MASK & 2) phase_norm_convert(a, layer, lds); }
        else if (sub == 1) {
            Gemm g; g.A = (const bf16_t*)(a.ws + WS_H); g.Bt = (const bf16_t*)(a.ws + WS_WTIN); g.lda = D; g.ldb = D; g.K = D; g.a_z = 0; g.b_z = 0;
            g.nM = 68; g.nN = 65; g.nz = 1; g.latent_only = 0; g.G = G; g.c = c;
            EpiP e; e.P = P; if (PH_MASK & 4) gemm_phase(lds, g, e);
        } else if (sub == 2) { if (PH_MASK & 8) phase_mixers(a, layer, lds); }
        else if (sub == 3) {
            if (PH_MASK & 256) phase_readout(a, layer);
            Gemm g; g.A = (const bf16_t*)(a.ws + WS_DIFF); g.Bt = (const bf16_t*)(a.ws + WS_WTPL); g.lda = W; g.ldb = 256; g.K = 256; g.a_z = 256; g.b_z = 65536;
            g.nM = layer ? 64 : 68; g.nN = 1; g.nz = 4; g.latent_only = layer; g.G = G; g.c = c;
            EpiPool e; e.P = P; e.out = (bf16_t*)(a.ws + WS_BB) + (size_t)M * W; e.scale = a.pool_scale + layer * W; if (PH_MASK & 16) gemm_phase(lds, g, e);
        } else if (sub == 4) {
            Gemm g; g.A = (const bf16_t*)(a.ws + WS_BB); g.Bt = (const bf16_t*)(a.ws + WS_WTBR); g.lda = W; g.ldb = W; g.K = W; g.a_z = (size_t)M * W; g.b_z = (size_t)D * W;
            g.nM = layer ? 64 : 68; g.nN = 8; g.nz = 3; g.latent_only = layer; g.G = G; g.c = c;
            EpiMerge e; e.P = P; e.mf = (float*)(a.ws + WS_Y); e.mb = (bf16_t*)(a.ws + WS_H); if (PH_MASK & 32) gemm_phase(lds, g, e);
        } else {
            Gemm g; g.A = (const bf16_t*)(a.ws + WS_H); g.Bt = (const bf16_t*)(a.ws + WS_WTOUT); g.lda = D; g.ldb = D; g.K = D; g.a_z = 0; g.b_z = 0;
            g.nM = layer ? 64 : 68; g.nN = 8; g.nz = 1; g.latent_only = layer; g.G = G; g.c = c;
            EpiOut e; e.xl_old = layer ? (const float*)a.out : a.x; e.xc_old = layer ? (const float*)(a.ws + WS_XCTX) : a.ctx; e.xl_new = a.out; e.xc_new = (float*)(a.ws + WS_XCTX);
            e.mod = (const float*)(a.ws + WS_MOD) + layer * 5 * 6144; if (PH_MASK & 64) gemm_phase(lds, g, e);
        }
        }
    }
}

extern "C" void kernel_launch(void* const* d_in, const int* in_sizes, int n_in, void* d_out, int out_size, void* d_ws, size_t ws_size, hipStream_t stream) {
    static int grid = 0;
    if (grid == 0) {
        if (n_in != 24 || ws_size < WS_END) { fprintf(stderr, "kernel_launch: unexpected n_in %d or ws_size %zu (< %zu)\n", n_in, ws_size, (size_t)WS_END); grid = -1; return; }
        int dev = 0, cus = 0, per_cu = 0;
        hipGetDevice(&dev); hipDeviceGetAttribute(&cus, hipDeviceAttributeMultiprocessorCount, dev);
        if (hipFuncSetAttribute((const void*)fwd_kernel, hipFuncAttributeMaxDynamicSharedMemorySize, LDS_BYTES) != hipSuccess) { fprintf(stderr, "kernel_launch: hipFuncSetAttribute failed\n"); grid = -1; return; }
        hipOccupancyMaxActiveBlocksPerMultiprocessor(&per_cu, (const void*)fwd_kernel, 512, LDS_BYTES);
        if (per_cu < 1) { fprintf(stderr, "kernel_launch: occupancy query says %d\n", per_cu); per_cu = 1; }
        (void)hipGetLastError();
        grid = cus;
    }
    if (grid < 0) return;
    hipMemsetAsync((char*)d_ws + WS_MOD, 0, WS_MOD_BYTES, stream);
    Args a{};
    const float** pp = (const float**)&a;
    for (int i = 0; i < 24; ++i) pp[i] = (const float*)d_in[i];
    a.out = (float*)d_out; a.ws = (unsigned char*)d_ws;
#if N_LAUNCH_PER_PHASE
    for (int ph = 0; ph < NPHASE; ++ph) {
        a.ph_lo = ph; a.ph_hi = ph + 1;
        void* args[] = {&a};
        hipError_t e = hipLaunchCooperativeKernel((const void*)fwd_kernel, dim3(grid), dim3(512), args, LDS_BYTES, stream);
        if (e != hipSuccess) { fprintf(stderr, "cooperative launch failed: %s\n", hipGetErrorString(e)); break; }
    }
#else
    a.ph_lo = 0; a.ph_hi = NPHASE;
    void* args[] = {&a};
    hipError_t e = hipLaunchCooperativeKernel((const void*)fwd_kernel, dim3(grid), dim3(512), args, LDS_BYTES, stream);
    if (e != hipSuccess) fprintf(stderr, "cooperative launch failed: %s (grid %d)\n", hipGetErrorString(e), grid);
#endif
}
```

```cpp
#include <hip/hip_runtime.h>
#include <hip/hip_cooperative_groups.h>
#include <cstdio>
namespace cg = cooperative_groups;

#ifndef N_LAUNCH_PER_PHASE
#define N_LAUNCH_PER_PHASE 0
#endif

#ifndef REP_LAYERS
#define REP_LAYERS 3
#endif
#ifndef PH_MASK
#define PH_MASK 0xffff
#endif
#define LAS __attribute__((address_space(3)))
typedef unsigned short bf16_t;
typedef short bf16x8 __attribute__((ext_vector_type(8)));
typedef float f32x4 __attribute__((ext_vector_type(4)));
typedef unsigned u32x4 __attribute__((ext_vector_type(4)));
typedef unsigned u32x2 __attribute__((ext_vector_type(2)));

constexpr int D = 2048, NB = 4, T = 4096, LC = 256, TT = 4352, M = 17408, W = 1024, NP = 16640;
constexpr int C_Q = 0, C_K = 1024, C_V = 2048, C_NAG = 3072, C_PU = 4096, C_PG = 5120, C_RR = 6144, C_RK = 7168, C_RV = 8192, C_RG = 9216,
              C_MG = 10240, C_LW = 16384, C_LA = 16448;
constexpr int NPHASE = 14;
constexpr int LDS_BYTES = 147456;

constexpr size_t WS_MOD = 0, WS_MOD_BYTES = 262144;
constexpr size_t WS_BONUS = WS_MOD + WS_MOD_BYTES;
constexpr size_t WS_XCTX = WS_BONUS + 2359296;
constexpr size_t WS_WTIN = WS_XCTX + (size_t)NB * LC * D * 4;
constexpr size_t WS_WTBR = WS_WTIN + (size_t)NP * D * 2;
constexpr size_t WS_WTOUT = WS_WTBR + (size_t)3 * D * W * 2;
constexpr size_t WS_WTPL = WS_WTOUT + (size_t)D * D * 2;
constexpr size_t WS_H = WS_WTPL + (size_t)4 * 256 * 256 * 2;
constexpr size_t WS_Y = WS_H + (size_t)M * D * 2;
constexpr size_t WS_BB = WS_Y + (size_t)2 * M * W * 4;
constexpr size_t WS_DIFF = WS_BB + (size_t)3 * M * W * 2;
constexpr size_t WS_P = WS_DIFF + (size_t)M * W * 2;
constexpr size_t WS_END = WS_P + (size_t)M * NP * 2;

struct Args {
    const float *x, *c, *ctx, *c_ctx, *norm_g, *w_mod, *b_mod, *w_in, *na_rpb, *pool_w, *pool_scale, *rw_mu, *rw_w0, *rw_w2, *rw_a0, *rw_a2, *rw_k_k,
        *rw_k_a, *rw_r_k, *rw_lnx_g, *rw_lnx_b, *w_branch, *w_out, *final_g;
    float* out;
    unsigned char* ws;
    int ph_lo, ph_hi;
};

__device__ __forceinline__ float bf2f(bf16_t v) { return __uint_as_float(((unsigned)v) << 16); }
__device__ __forceinline__ float bflo(unsigned u) { return __uint_as_float(u << 16); }
__device__ __forceinline__ float bfhi(unsigned u) { return __uint_as_float(u & 0xffff0000u); }
typedef float f32x2 __attribute__((ext_vector_type(2)));
typedef __bf16 bf16x2_t __attribute__((ext_vector_type(2)));
__device__ __forceinline__ unsigned pk2(float lo, float hi) { const f32x2 v = {lo, hi}; const bf16x2_t b = __builtin_convertvector(v, bf16x2_t); return __builtin_bit_cast(unsigned, b); }
__device__ __forceinline__ float wave_sum(float v) {
#pragma unroll
    for (int o = 1; o < 64; o <<= 1) v += __shfl_xor(v, o);
    return v;
}
template <int CTRL> __device__ __forceinline__ float dppmov(float v) { return __int_as_float(__builtin_amdgcn_update_dpp(0, __float_as_int(v), CTRL, 0xF, 0xF, true)); }
__device__ __forceinline__ float sum8(float v) { v += dppmov<0xB1>(v); v += dppmov<0x4E>(v); v += dppmov<0x141>(v); return v; }
__device__ __forceinline__ float siluf(float x) { return x / (1.f + __expf(-x)); }
__device__ __forceinline__ float sigmf(float x) { return 1.f / (1.f + __expf(-x)); }
__device__ __forceinline__ int otid() { int t = threadIdx.x; asm volatile("" : "+v"(t)); return t; }
__device__ __forceinline__ void lds_wait() { asm volatile("s_waitcnt lgkmcnt(0)" ::: "memory"); }

constexpr int BM = 256, BK = 64, HALF = 128, HTB = HALF * BK * 2, NXCD = 8, WGM = 8;
__device__ __forceinline__ int lds_byte(int r, int c) { const int st = (r >> 4) * 2 + (c >> 5), rr = r & 15, cc = c & 31, ob = rr * 64 + cc * 2; return st * 1024 + (ob ^ (((ob >> 9) & 1) << 5)); }
__device__ __forceinline__ void stage_rc(int b, int& R, int& C) { const int st = b / 1024, sb = b % 1024, swz = sb ^ (((sb >> 9) & 1) << 5); R = (st >> 1) * 16 + swz / 64; C = (st & 1) * 32 + (swz % 64) / 2; }
__device__ __forceinline__ int perm32(int rho) { const int n = rho >> 4, i = rho & 15; return 8 * (i >> 2) + 4 * n + (i & 3); }

struct Unit { int pm, pn, z; };
struct Gemm {
    const bf16_t* A; const bf16_t* Bt; int lda, ldb, K; size_t a_z, b_z;
    int nM, nN, nz, latent_only, G, c;
    __device__ bool next(int i, Unit& u) const {
        const int zi = i % nz, r = i / nz; const long L = (long)r * G + c; const int nwg = nM * nN; if (L >= nwg) return false;
        int wgid = (int)L; { const int q = nwg / NXCD, rr = nwg % NXCD, xcd = wgid % NXCD, off = wgid / NXCD; wgid = (xcd < rr ? xcd * (q + 1) : rr * (q + 1) + (xcd - rr) * q) + off; }
        const int nig = WGM * nN, gid = wgid / nig, fm = gid * WGM, gsz = (nM - fm) < WGM ? (nM - fm) : WGM;
        int pm = fm + ((wgid % nig) % gsz); u.pn = (wgid % nig) / gsz; u.z = zi;
        u.pm = latent_only ? (pm / 16) * 17 + 1 + (pm % 16) : pm; return true;
    }
};

template <class Epi>
__device__ __forceinline__ void gemm_phase(LAS unsigned char* lds, const Gemm g, const Epi& E) {
    const int tid = otid(), wid = __builtin_amdgcn_readfirstlane(tid >> 6), lane = tid & 63, wr = wid >> 2, wc = wid & 3, fr = lane & 15, fq = lane >> 4;
    const int K = g.K, nt = K / BK;
    unsigned voffA[2], voffB[2];
#pragma unroll
    for (int i = 0; i < 2; ++i) { int R, C; stage_rc(tid * 16 + i * 8192, R, C); const int Rb = Epi::PERM ? ((R & ~31) + perm32(R & 31)) : R;
        voffA[i] = (unsigned)(R * g.lda + C) * 2u; voffB[i] = (unsigned)(Rb * g.ldb + C) * 2u; }
    const size_t kstep = (size_t)(BK * 2);
    const size_t hstepA = (size_t)HALF * g.lda * 2, hstepB = (size_t)HALF * g.ldb * 2;
    const unsigned ldsw = (unsigned)wid * 1024u;
    const int aoff = lds_byte(wr * 64 + fr, fq * 8), boff = lds_byte(wc * 32 + fr, fq * 8);
#define PG8_SA(b, h) (((b) * 2 + (h)) * HTB)
#define PG8_SB(b, h) ((4 + (b) * 2 + (h)) * HTB)
#define PG8_STAGE(bufoff, gbase, voff) do { _Pragma("unroll") for (int _i = 0; _i < 2; ++_i) \
        __builtin_amdgcn_global_load_lds((const unsigned*)((const char*)(gbase) + (voff)[_i]), (LAS unsigned*)(lds + (bufoff) + ldsw + _i * 8192), 16, 0, 0); } while (0)
#define PG8_LDA(dst, b, h) do { _Pragma("unroll") for (int m = 0; m < 4; ++m) _Pragma("unroll") for (int k = 0; k < 2; ++k) dst[m][k] = *(const LAS bf16x8*)(lds + PG8_SA(b, h) + aoff + m * 2048 + k * 1024); } while (0)
#define PG8_LDB(dst, b, h) do { _Pragma("unroll") for (int n = 0; n < 2; ++n) _Pragma("unroll") for (int k = 0; k < 2; ++k) dst[n][k] = *(const LAS bf16x8*)(lds + PG8_SB(b, h) + boff + n * 2048 + k * 1024); } while (0)
#define PG8_MMA(ai, bj, At, Bt) do { __builtin_amdgcn_s_setprio(1); _Pragma("unroll") for (int m = 0; m < 4; ++m) _Pragma("unroll") for (int n = 0; n < 2; ++n) _Pragma("unroll") for (int k = 0; k < 2; ++k) \
        acc[ai][bj][m][n] = __builtin_amdgcn_mfma_f32_16x16x32_bf16(Bt[n][k], At[m][k], acc[ai][bj][m][n], 0, 0, 0); __builtin_amdgcn_s_setprio(0); } while (0)
#define PG8_WAIT_V(n) asm volatile("s_waitcnt vmcnt(" #n ")" ::: "memory")
#define PG8_WAIT_L(n) asm volatile("s_waitcnt lgkmcnt(" #n ")" ::: "memory")
#define PG8_BAR __builtin_amdgcn_s_barrier()
#define PG8_SCHED __builtin_amdgcn_sched_barrier(0)
    Unit cur, nxt; int ui = 0;
    if (!g.next(0, cur)) return;
    f32x4 acc[2][2][4][2];
#pragma unroll
    for (int a = 0; a < 2; ++a)
#pragma unroll
        for (int b = 0; b < 2; ++b)
#pragma unroll
            for (int m = 0; m < 4; ++m)
#pragma unroll
                for (int n = 0; n < 2; ++n) acc[a][b][m][n] = (f32x4){0.f, 0.f, 0.f, 0.f};
    bf16x8 At[4][2], B0[2][2], B1[2][2];
    const char* cA = (const char*)(g.A + cur.z * g.a_z + (size_t)cur.pm * BM * g.lda); const char* cB = (const char*)(g.Bt + cur.z * g.b_z + (size_t)cur.pn * BM * g.ldb);
    PG8_STAGE(PG8_SB(0, 0), cB, voffB); PG8_STAGE(PG8_SA(0, 0), cA, voffA); PG8_STAGE(PG8_SB(0, 1), cB + hstepB, voffB); PG8_STAGE(PG8_SA(0, 1), cA + hstepA, voffA);
    if (wr == 1) PG8_BAR;
    PG8_WAIT_V(4); PG8_BAR;
    PG8_STAGE(PG8_SB(1, 0), cB + kstep, voffB); PG8_STAGE(PG8_SA(1, 0), cA + kstep, voffA); PG8_STAGE(PG8_SB(1, 1), cB + hstepB + kstep, voffB);
    PG8_WAIT_V(6); PG8_BAR;
    for (;;) {
        const bool has_next = g.next(ui + 1, nxt);
        const char* nA = has_next ? (const char*)(g.A + nxt.z * g.a_z + (size_t)nxt.pm * BM * g.lda) : cA;
        const char* nB = has_next ? (const char*)(g.Bt + nxt.z * g.b_z + (size_t)nxt.pn * BM * g.ldb) : cB;
        for (int t = 0; t < nt; t += 2) {
            const bool last = (t == nt - 2);
            const char* a1 = cA + (size_t)(t + 1) * kstep;
            const char* a2 = last ? nA : cA + (size_t)(t + 2) * kstep; const char* b2 = last ? nB : cB + (size_t)(t + 2) * kstep;
            const char* a3 = a2 + kstep; const char* b3 = b2 + kstep;
            PG8_LDB(B0, 0, 0); PG8_SCHED; PG8_LDA(At, 0, 0); PG8_STAGE(PG8_SA(1, 1), a1 + hstepA, voffA);
            PG8_WAIT_L(8); PG8_BAR; PG8_WAIT_L(0); PG8_MMA(0, 0, At, B0); PG8_BAR; PG8_SCHED;
            PG8_LDB(B1, 0, 1); PG8_STAGE(PG8_SB(0, 0), b2, voffB);
            PG8_BAR; PG8_WAIT_L(0); PG8_MMA(0, 1, At, B1); PG8_BAR;
            PG8_LDA(At, 0, 1); PG8_STAGE(PG8_SA(0, 0), a2, voffA);
            PG8_BAR; PG8_WAIT_L(0); PG8_MMA(1, 0, At, B0); PG8_BAR; PG8_SCHED;
            PG8_STAGE(PG8_SB(0, 1), b2 + hstepB, voffB);
            PG8_WAIT_V(6); PG8_BAR; PG8_MMA(1, 1, At, B1); PG8_BAR;
            PG8_LDB(B0, 1, 0); PG8_SCHED; PG8_LDA(At, 1, 0); PG8_STAGE(PG8_SA(0, 1), a2 + hstepA, voffA);
            PG8_WAIT_L(8); PG8_BAR; PG8_WAIT_L(0); PG8_MMA(0, 0, At, B0); PG8_BAR; PG8_SCHED;
            PG8_LDB(B1, 1, 1); PG8_STAGE(PG8_SB(1, 0), b3, voffB);
            PG8_BAR; PG8_WAIT_L(0); PG8_MMA(0, 1, At, B1); PG8_BAR;
            PG8_LDA(At, 1, 1); PG8_STAGE(PG8_SA(1, 0), a3, voffA);
            PG8_BAR; PG8_WAIT_L(0); PG8_MMA(1, 0, At, B0); PG8_BAR; PG8_SCHED;
            PG8_STAGE(PG8_SB(1, 1), b3 + hstepB, voffB);
            PG8_WAIT_V(6); PG8_BAR; PG8_MMA(1, 1, At, B1); PG8_BAR;
        }
        E(acc, cur, wr, wc, fr, fq);
        if (!has_next) break;
#pragma unroll
        for (int a = 0; a < 2; ++a)
#pragma unroll
            for (int b = 0; b < 2; ++b)
#pragma unroll
                for (int m = 0; m < 4; ++m)
#pragma unroll
                    for (int n = 0; n < 2; ++n) acc[a][b][m][n] = (f32x4){0.f, 0.f, 0.f, 0.f};
        cur = nxt; cA = nA; cB = nB; ++ui;
    }
    PG8_WAIT_V(0);
    if (wr == 0) PG8_BAR;
    PG8_BAR;
#undef PG8_SA
#undef PG8_SB
#undef PG8_STAGE
#undef PG8_LDA
#undef PG8_LDB
#undef PG8_MMA
#undef PG8_WAIT_V
#undef PG8_WAIT_L
#undef PG8_BAR
#undef PG8_SCHED
}

struct EpiP {
    static constexpr bool PERM = true;
    bf16_t* P;
    __device__ __forceinline__ void operator()(const f32x4 (&acc)[2][2][4][2], const Unit& u, int wr, int wc, int fr, int fq) const {
        const int row0 = u.pm * BM + wr * 64 + fr, col0 = u.pn * BM + wc * 32 + 8 * fq;
#pragma unroll
        for (int ai = 0; ai < 2; ++ai)
#pragma unroll
            for (int m = 0; m < 4; ++m) { bf16_t* rowp = P + (size_t)(row0 + ai * HALF + m * 16) * NP + col0;
#pragma unroll
                for (int bj = 0; bj < 2; ++bj) { const f32x4 v0 = acc[ai][bj][m][0], v1 = acc[ai][bj][m][1];
                    u32x4 o; o.x = pk2(v0[0], v0[1]); o.y = pk2(v0[2], v0[3]); o.z = pk2(v1[0], v1[1]); o.w = pk2(v1[2], v1[3]);
                    *(u32x4*)(rowp + bj * HALF) = o; } }
    }
};
struct EpiPool {
    static constexpr bool PERM = true;
    const bf16_t* P; bf16_t* out; const float* scale;
    __device__ __forceinline__ void operator()(const f32x4 (&acc)[2][2][4][2], const Unit& u, int wr, int wc, int fr, int fq) const {
        const int row0 = u.pm * BM + wr * 64 + fr, col0 = u.z * 256 + wc * 32 + 8 * fq;
#pragma unroll
        for (int ai = 0; ai < 2; ++ai)
#pragma unroll
            for (int m = 0; m < 4; ++m) { const size_t row = (size_t)(row0 + ai * HALF + m * 16);
#pragma unroll
                for (int bj = 0; bj < 2; ++bj) { const int col = col0 + bj * HALF; const f32x4 v0 = acc[ai][bj][m][0], v1 = acc[ai][bj][m][1];
                    const u32x4 gt = *(const u32x4*)(P + row * NP + C_PG + col);
                    const f32x4 s0 = *(const f32x4*)(scale + col), s1 = *(const f32x4*)(scale + col + 4);
                    u32x4 o;
                    o.x = pk2(v0[0] * s0[0] * siluf(bflo(gt.x)), v0[1] * s0[1] * siluf(bfhi(gt.x)));
                    o.y = pk2(v0[2] * s0[2] * siluf(bflo(gt.y)), v0[3] * s0[3] * siluf(bfhi(gt.y)));
                    o.z = pk2(v1[0] * s1[0] * siluf(bflo(gt.z)), v1[1] * s1[1] * siluf(bfhi(gt.z)));
                    o.w = pk2(v1[2] * s1[2] * siluf(bflo(gt.w)), v1[3] * s1[3] * siluf(bfhi(gt.w)));
                    *(u32x4*)(out + row * W + col) = o; } }
    }
};
struct EpiMerge {
    static constexpr bool PERM = false;
    const bf16_t* P; float* mf; bf16_t* mb;
    __device__ __forceinline__ void operator()(const f32x4 (&acc)[2][2][4][2], const Unit& u, int wr, int wc, int fr, int fq) const {
        const int row0 = u.pm * BM + wr * 64 + fr, col0 = u.pn * BM + wc * 32 + 4 * fq;
#pragma unroll
        for (int ai = 0; ai < 2; ++ai)
#pragma unroll
            for (int m = 0; m < 4; ++m) { const size_t row = (size_t)(row0 + ai * HALF + m * 16);
#pragma unroll
                for (int bj = 0; bj < 2; ++bj)
#pragma unroll
                    for (int n = 0; n < 2; ++n) { const int col = col0 + bj * HALF + n * 16; const f32x4 v = acc[ai][bj][m][n];
                        const u32x2 lg = *(const u32x2*)(P + row * NP + C_MG + u.z * D + col);
                        f32x4 r; r[0] = v[0] * sigmf(bflo(lg.x)); r[1] = v[1] * sigmf(bfhi(lg.x)); r[2] = v[2] * sigmf(bflo(lg.y)); r[3] = v[3] * sigmf(bfhi(lg.y));
                        float* mp = mf + row * D + col;
                        if (u.z > 0) { const f32x4 o = *(const f32x4*)mp; r += o; }
                        if (u.z < 2) *(f32x4*)mp = r;
                        else { u32x2 o; o.x = pk2(r[0], r[1]); o.y = pk2(r[2], r[3]); *(u32x2*)(mb + row * D + col) = o; } } }
    }
};
struct EpiOut {
    static constexpr bool PERM = false;
    const float* xl_old; const float* xc_old; float* xl_new; float* xc_new; const float* mod;
    __device__ __forceinline__ void operator()(const f32x4 (&acc)[2][2][4][2], const Unit& u, int wr, int wc, int fr, int fq) const {
        const int b = u.pm / 17, tl = u.pm % 17; const bool isc = (tl == 0);
        const float* xo = isc ? xc_old + (size_t)b * LC * D : xl_old + ((size_t)b * T + (tl - 1) * 256) * D;
        float* xn = isc ? xc_new + (size_t)b * LC * D : xl_new + ((size_t)b * T + (tl - 1) * 256) * D;
        const float* gp = mod + (isc ? 4 : b) * 6144 + 4096;
        const int row0 = wr * 64 + fr, col0 = u.pn * BM + wc * 32 + 4 * fq;
#pragma unroll
        for (int bj = 0; bj < 2; ++bj)
#pragma unroll
            for (int n = 0; n < 2; ++n) { const int col = col0 + bj * HALF + n * 16; const f32x4 gt = *(const f32x4*)(gp + col);
#pragma unroll
                for (int ai = 0; ai < 2; ++ai)
#pragma unroll
                    for (int m = 0; m < 4; ++m) { const size_t off = (size_t)(row0 + ai * HALF + m * 16) * D + col;
                        const f32x4 o = *(const f32x4*)(xo + off); *(f32x4*)(xn + off) = o + gt * acc[ai][bj][m][n]; } }
    }
};

__device__ __forceinline__ void phase_mod(const Args& a, LAS unsigned char* lds) {
    const int tidm = otid();
    LAS float* s = (LAS float*)lds;
    float* modp = (float*)(a.ws + WS_MOD);
    for (int task = blockIdx.x; task < 192; task += gridDim.x) {
        const int l = task / 96, rem = task % 96, cb = rem >> 3, kc = rem & 7, k0 = kc * 256;
        __syncthreads();
        for (int i = tidm; i < 5 * 256; i += 512) { const int r = i >> 8, k = i & 255; const float c = (r < 4) ? a.c[r * D + k0 + k] : a.c_ctx[k0 + k]; s[i] = c / (1.f + expf(-c)); }
        __syncthreads();
        const int n = cb * 512 + tidm;
        const float* w = a.w_mod + (size_t)l * D * 6144 + (size_t)k0 * 6144 + n;
        float a0 = 0.f, a1 = 0.f, a2 = 0.f, a3 = 0.f, a4 = 0.f;
#pragma unroll 8
        for (int k = 0; k < 256; ++k) { const float wv = w[(size_t)k * 6144]; a0 += s[k] * wv; a1 += s[256 + k] * wv; a2 += s[512 + k] * wv; a3 += s[768 + k] * wv; a4 += s[1024 + k] * wv; }
        float* mo = modp + l * 5 * 6144 + n;
        const float bias = (kc == 0) ? a.b_mod[l * 6144 + n] : 0.f;
        atomicAdd(mo, a0 + bias); atomicAdd(mo + 6144, a1 + bias); atomicAdd(mo + 2 * 6144, a2 + bias); atomicAdd(mo + 3 * 6144, a3 + bias); atomicAdd(mo + 4 * 6144, a4 + bias);
    }
}

__device__ __forceinline__ void transpose_item(const float* Wsrc, int ldsrc, int k0, int nsrc0, bf16_t* dst, int ldd, LAS float* scr, int lane) {
    if (nsrc0 >= 0) {
#pragma unroll 8
        for (int i = 0; i < 32; ++i) { const int kk = 2 * i + (lane >> 5); scr[kk * 33 + (lane & 31)] = Wsrc[(size_t)(k0 + kk) * ldsrc + nsrc0 + (lane & 31)]; }
    } else {
#pragma unroll 8
        for (int i = 0; i < 32; ++i) { const int kk = 2 * i + (lane >> 5); scr[kk * 33 + (lane & 31)] = 0.f; }
    }
    lds_wait();
    const int c = lane & 7;
#pragma unroll
    for (int j = 0; j < 4; ++j) { const int n = (lane >> 3) + 8 * j; const LAS float* s = scr + (8 * c) * 33 + n;
        u32x4 o; o.x = pk2(s[0 * 33], s[1 * 33]); o.y = pk2(s[2 * 33], s[3 * 33]); o.z = pk2(s[4 * 33], s[5 * 33]); o.w = pk2(s[6 * 33], s[7 * 33]);
        *(u32x4*)(dst + (size_t)n * ldd + k0 + 8 * c) = o; }
    lds_wait();
}
__device__ __forceinline__ void phase_norm_convert(const Args& a, int layer, LAS unsigned char* lds) {
    const int tid = otid(), lane = tid & 63, wv = tid >> 6;
    const int gw = blockIdx.x * 8 + wv, NGW = gridDim.x * 8;
    {
        LAS float* scr = (LAS float*)(lds + wv * 8448);
        bf16_t* wtin = (bf16_t*)(a.ws + WS_WTIN); bf16_t* wtbr = (bf16_t*)(a.ws + WS_WTBR); bf16_t* wtout = (bf16_t*)(a.ws + WS_WTOUT); bf16_t* wtpl = (bf16_t*)(a.ws + WS_WTPL);
        constexpr int I_IN = 32 * 520, I_BR = 16 * 64, I_OUT = 32 * 64, I_PL = 4 * 8;
        constexpr int NIT = I_IN + 3 * I_BR + I_OUT + 4 * I_PL;
        for (int it = gw; it < NIT; it += NGW) {
            int r = it;
            if (r < I_IN) { const int kb = r / 520, nb = r % 520, n0 = nb * 32; const int ns = n0 < 10240 ? n0 : (n0 < 16384 ? n0 + 128 : (n0 < 16512 ? n0 - 6144 : -1));
                transpose_item(a.w_in + (size_t)layer * D * 16512, 16512, kb * 64, ns, wtin + (size_t)n0 * D, D, scr, lane); continue; }
            r -= I_IN;
            if (r < 3 * I_BR) { const int z = r / I_BR, q = r % I_BR, kb = q / 64, nb = q % 64;
                transpose_item(a.w_branch + ((size_t)layer * 3 + z) * W * D, D, kb * 64, nb * 32, wtbr + (size_t)z * D * W + (size_t)nb * 32 * W, W, scr, lane); continue; }
            r -= 3 * I_BR;
            if (r < I_OUT) { const int kb = r / 64, nb = r % 64;
                transpose_item(a.w_out + (size_t)layer * D * D, D, kb * 64, nb * 32, wtout + (size_t)nb * 32 * D, D, scr, lane); continue; }
            r -= I_OUT;
            { const int z = r / I_PL, q = r % I_PL, kb = q / 8, nb = q % 8;
                transpose_item(a.pool_w + ((size_t)layer * 4 + z) * 65536, 256, kb * 64, nb * 32, wtpl + (size_t)z * 65536 + (size_t)nb * 32 * 256, 256, scr, lane); }
        }
    }
    const float* ng = a.norm_g + layer * D;
    const float* mo = (const float*)(a.ws + WS_MOD) + layer * 5 * 6144;
    const float* xctx = (const float*)(a.ws + WS_XCTX);
    bf16_t* h = (bf16_t*)(a.ws + WS_H);
    for (int row = gw; row < M; row += NGW) {
        const int b = row / TT, t = row % TT; const float* xr; int mr;
        if (t < LC) { xr = (layer == 0 ? a.ctx : xctx) + (size_t)(b * LC + t) * D; mr = 4; }
        else { xr = (layer == 0 ? a.x : (const float*)a.out) + (size_t)(b * T + t - LC) * D; mr = b; }
        f32x4 v[8]; float ss = 0.f;
#pragma unroll
        for (int j = 0; j < 8; ++j) { v[j] = *(const f32x4*)(xr + 4 * lane + 256 * j); ss += (v[j][0] * v[j][0] + v[j][1] * v[j][1]) + (v[j][2] * v[j][2] + v[j][3] * v[j][3]); }
        ss = wave_sum(ss); const float rstd = rsqrtf(ss * (1.f / D) + 1e-6f);
        const float* mrow = mo + mr * 6144;
#pragma unroll
        for (int j = 0; j < 8; ++j) { const int col = 4 * lane + 256 * j; const f32x4 g4 = *(const f32x4*)(ng + col), sh = *(const f32x4*)(mrow + col), sc = *(const f32x4*)(mrow + 2048 + col);
            f32x4 o = (v[j] * rstd) * g4; o = o * (sc + 1.f) + sh;
            u32x2 pk; pk.x = pk2(o[0], o[1]); pk.y = pk2(o[2], o[3]); *(u32x2*)(h + (size_t)row * D + col) = pk; }
    }
}

__device__ __forceinline__ float wsum(float v) {
    v += dppmov<0xB1>(v); v += dppmov<0x4E>(v); v += dppmov<0x141>(v); v += dppmov<0x140>(v);
    const int iv = __float_as_int(v);
    return (__int_as_float(__builtin_amdgcn_readlane(iv, 0)) + __int_as_float(__builtin_amdgcn_readlane(iv, 16))) +
           (__int_as_float(__builtin_amdgcn_readlane(iv, 32)) + __int_as_float(__builtin_amdgcn_readlane(iv, 48)));
}
__device__ __forceinline__ bf16_t f2bf(float x) { return (bf16_t)(pk2(x, x) & 0xffffu); }
__device__ __forceinline__ bf16x8 ldsfrag(const LAS bf16_t* p) { return *(const LAS bf16x8*)p; }
#define MFMA16(a_, b_, c_) __builtin_amdgcn_mfma_f32_16x16x32_bf16(a_, b_, c_, 0, 0, 0)

__device__ __forceinline__ void scan_item(const Args& a, int layer, int item, LAS unsigned char* lds) {
    const int tid = otid(), lane = tid & 63, wv = __builtin_amdgcn_readfirstlane(tid >> 6), fr = lane & 15, fq = lane >> 4;
    const int b = item >> 5, h = (item >> 1) & 15, dir = item & 1;
    LAS float* W2s = (LAS float*)lds;
    LAS float* A2s = W2s + 4096;
    LAS float* LWs = A2s + 4096;
    LAS float* LAs = LWs + 2048;
    LAS float* LD = LAs + 2048;
    LAS float* N1t = LD + 2048;
    LAS float* gC = N1t + 1152;
    LAS bf16_t* At = (LAS bf16_t*)(gC + 64);
    LAS bf16_t* Bn = At + 2304;
    LAS bf16_t* Kn = Bn + 2304;
    LAS bf16_t* Rt = Kn + 2304;
    LAS bf16_t* BpT = Rt + 2304;
    LAS bf16_t* KpT = BpT + 2560;
    LAS bf16_t* Vt = KpT + 2560;
    LAS bf16_t* M2t = Vt + 2560;
    LAS bf16_t* M3t = M2t + 1280;
    LAS bf16_t* M4t = M3t + 1280;
    LAS bf16_t* Tmt = M4t + 1280;
    LAS bf16_t* Xs = Tmt + 1280;
    LAS bf16_t* Us = Xs + 2560;
    LAS bf16_t* S0s = Us + 2560;
    const bf16_t* P = (const bf16_t*)(a.ws + WS_P);
    float* ybuf = (float*)(a.ws + WS_Y);
    float* bonus = (float*)(a.ws + WS_BONUS);
    __syncthreads();
    {
        const float* w2 = a.rw_w2 + ((size_t)(layer * 2 + dir) * 64) * W + h * 64;
        const float* a2 = a.rw_a2 + ((size_t)(layer * 2 + dir) * 64) * W + h * 64;
        for (int i = tid; i < 4096; i += 512) { const int l = i >> 6, c = i & 63; W2s[i] = w2[l * W + c]; A2s[i] = a2[l * W + c]; }
        for (int i = tid; i < 4608; i += 512) ((LAS unsigned*)S0s)[i] = 0u;
    }
    const int ch = h * 64 + lane;
    const float mu_r = a.rw_mu[(layer * 3 + 0) * W + ch], mu_k = a.rw_mu[(layer * 3 + 1) * W + ch], mu_v = a.rw_mu[(layer * 3 + 2) * W + ch];
    const float w0 = a.rw_w0[(layer * 2 + dir) * W + ch], a0 = a.rw_a0[(layer * 2 + dir) * W + ch];
    const float kk_c = a.rw_k_k[layer * W + ch], ka_c = a.rw_k_a[layer * W + ch], rk_c = a.rw_r_k[layer * W + ch];
    f32x4 Sacc[2];
    Sacc[0] = (f32x4){0.f, 0.f, 0.f, 0.f}; Sacc[1] = (f32x4){0.f, 0.f, 0.f, 0.f};
    int cur = 0;
    const int tt = wv >> 2, it = wv & 3;
    __syncthreads();
#define SCAN_LOAD(dst, gcx) do { const int g_ = (gcx) < 136 ? (gcx) : 135; const int sg_ = g_ >= 8; const int sl_ = sg_ ? T : LC; const int rb_ = b * TT + (sg_ ? LC : 0); const int ck_ = sg_ ? g_ - 8 : g_; \
        _Pragma("unroll") for (int q = 0; q < 4; ++q) { const int pi_ = ck_ * 32 + wv * 4 + q; const int t_ = dir ? (sl_ - 1 - pi_) : pi_; const int tp_ = t_ > 0 ? t_ - 1 : 0; const int tn_ = t_ < sl_ - 1 ? t_ + 1 : sl_ - 1; \
            const bf16_t* pr_ = P + (size_t)(rb_ + t_) * NP; const bf16_t* pp_ = P + (size_t)(rb_ + tp_) * NP; const bf16_t* pn_ = P + (size_t)(rb_ + tn_) * NP; \
            dst[q][0] = pr_[C_LW + lane]; dst[q][1] = pr_[C_LA + lane]; dst[q][2] = pr_[C_RR + ch]; dst[q][3] = pp_[C_RR + ch]; dst[q][4] = pn_[C_RR + ch]; \
            dst[q][5] = pr_[C_RK + ch]; dst[q][6] = pp_[C_RK + ch]; dst[q][7] = pn_[C_RK + ch]; dst[q][8] = pr_[C_RV + ch]; dst[q][9] = pp_[C_RV + ch]; dst[q][10] = pn_[C_RV + ch]; } } while (0)
    float raw[4][11];
    { bf16_t r0_[4][11]; SCAN_LOAD(r0_, 0);
#pragma unroll
      for (int q = 0; q < 4; ++q)
#pragma unroll
        for (int e = 0; e < 11; ++e) raw[q][e] = bf2f(r0_[q][e]); }
    for (int gc = 0; gc < 136; ++gc) {
        {
            const int seg = gc >= 8; const int slen = seg ? T : LC; const int rowbase = b * TT + (seg ? LC : 0); const int ck = seg ? gc - 8 : gc;
            bf16_t nraw[4][11];
            SCAN_LOAD(nraw, gc + 1);
            float r_[4], kd_[4], kk_[4], av_[4], v_[4], ld_[4];
#pragma unroll
            for (int q = 0; q < 4; ++q) {
                const int p = wv * 4 + q, pi = ck * 32 + p, t = dir ? (slen - 1 - pi) : pi;
                { const float x2 = __expf(2.f * raw[q][0]); LWs[p * 64 + lane] = 1.f - 2.f / (1.f + x2); } LAs[p * 64 + lane] = raw[q][1];
                const float r0 = raw[q][2], k0 = raw[q][5], v0 = raw[q][8];
                const float mp = (t > 0) ? 1.f : 0.f, mn = (t < slen - 1) ? 1.f : 0.f;
                const float rs = mp * raw[q][3] + mn * raw[q][4], ks = mp * raw[q][6] + mn * raw[q][7], vs = mp * raw[q][9] + mn * raw[q][10];
                r_[q] = r0 + mu_r * (0.5f * rs - r0); kd_[q] = k0 + mu_k * (0.5f * ks - k0); v_[q] = v0 + mu_v * (0.5f * vs - v0);
                const float kku = kd_[q] * kk_c; const float ss = wsum(kku * kku);
                kk_[q] = kku / fmaxf(sqrtf(ss), 1e-12f);
            }
            lds_wait();
            {
                float wp[4], ap[4];
#pragma unroll
                for (int q = 0; q < 4; ++q) { wp[q] = w0; ap[q] = a0; }
                for (int l = 0; l < 64; l += 4) {
                    float w2v[4], a2v[4];
#pragma unroll
                    for (int u = 0; u < 4; ++u) { w2v[u] = W2s[(l + u) * 64 + lane]; a2v[u] = A2s[(l + u) * 64 + lane]; }
#pragma unroll
                    for (int q = 0; q < 4; ++q) { const f32x4 lw4 = *(const LAS f32x4*)(LWs + (wv * 4 + q) * 64 + l), la4 = *(const LAS f32x4*)(LAs + (wv * 4 + q) * 64 + l);
                        wp[q] += lw4[0] * w2v[0] + lw4[1] * w2v[1] + lw4[2] * w2v[2] + lw4[3] * w2v[3];
                        ap[q] += la4[0] * a2v[0] + la4[1] * a2v[1] + la4[2] * a2v[2] + la4[3] * a2v[3]; }
                }
#pragma unroll
                for (int q = 0; q < 4; ++q) {
                    const int p = wv * 4 + q, pi = ck * 32 + p, t = dir ? (slen - 1 - pi) : pi;
                    ld_[q] = -0.6065306597f / (1.f + __expf(-wp[q]));
                    av_[q] = 1.f / (1.f + __expf(-ap[q]));
                    kd_[q] = kd_[q] * (1.f + (av_[q] - 1.f) * ka_c);
                    LD[p * 64 + lane] = ld_[q];
                    const float bs = wsum(r_[q] * kd_[q] * rk_c);
                    if (lane == 0) bonus[((size_t)dir * M + rowbase + t) * 16 + h] = bs;
                }
            }
            __syncthreads();
            {
                float cprev = 0.f;
                for (int p2 = 0; p2 < wv * 4; ++p2) cprev += LD[p2 * 64 + lane];
                float ctot = cprev;
                for (int p2 = wv * 4; p2 < 32; ++p2) ctot += LD[p2 * 64 + lane];
                float cum = cprev;
#pragma unroll
                for (int q = 0; q < 4; ++q) {
                    const int p = wv * 4 + q;
                    cum += ld_[q];
                    const float eg = __expf(cum), egi = __expf(-cum), egm = __expf(cum - ld_[q]), egc = __expf(ctot - cum);
                    const float bq = kk_[q] * av_[q];
                    At[p * 72 + lane] = f2bf(-kk_[q] * egm); Bn[p * 72 + lane] = f2bf(bq * egi); Kn[p * 72 + lane] = f2bf(kd_[q] * egi); Rt[p * 72 + lane] = f2bf(r_[q] * eg);
                    BpT[lane * 40 + p] = f2bf(bq * egc); KpT[lane * 40 + p] = f2bf(kd_[q] * egc); Vt[lane * 40 + p] = f2bf(v_[q]);
                }
                if (wv == 0) gC[lane] = __expf(ctot);
            }
            __syncthreads();
#pragma unroll
            for (int k2 = 0; k2 < 2; ++k2) {
                const int tile = wv * 2 + k2, mi = tile >> 2, st = (tile >> 1) & 1, t2 = tile & 1;
                const LAS bf16_t* Ap = ((mi & 1) ? Kn : Bn) + (st * 16 + fr) * 72 + fq * 8;
                const LAS bf16_t* Bp = ((mi >> 1) ? Rt : At) + (t2 * 16 + fr) * 72 + fq * 8;
                f32x4 acc = (f32x4){0.f, 0.f, 0.f, 0.f};
                acc = MFMA16(ldsfrag(Ap), ldsfrag(Bp), acc); acc = MFMA16(ldsfrag(Ap + 32), ldsfrag(Bp + 32), acc);
                const int t = t2 * 16 + fr, s0 = st * 16 + fq * 4;
#pragma unroll
                for (int rg = 0; rg < 4; ++rg) { const int s = s0 + rg; const bool keep = (mi < 2) ? (s < t) : (s <= t); if (!keep) acc[rg] = 0.f; }
                if (mi == 0) *(LAS f32x4*)(N1t + t * 36 + s0) = acc;
                else { LAS bf16_t* Mp = (mi == 1 ? M2t : (mi == 2 ? M3t : M4t)) + t * 40 + s0; u32x2 o; o.x = pk2(acc[0], acc[1]); o.y = pk2(acc[2], acc[3]); *(LAS u32x2*)Mp = o; }
            }
            __syncthreads();
            const LAS bf16_t* S0c = S0s + cur * 4608;
            {
                const LAS bf16_t* Ap = At + (tt * 16 + fr) * 72 + fq * 8; const LAS bf16_t* Bp = S0c + (it * 16 + fr) * 72 + fq * 8;
                f32x4 acc = (f32x4){0.f, 0.f, 0.f, 0.f};
                acc = MFMA16(ldsfrag(Ap), ldsfrag(Bp), acc); acc = MFMA16(ldsfrag(Ap + 32), ldsfrag(Bp + 32), acc);
                acc = MFMA16(ldsfrag(M2t + (tt * 16 + fr) * 40 + fq * 8), ldsfrag(Vt + (it * 16 + fr) * 40 + fq * 8), acc);
                u32x2 o; o.x = pk2(acc[0], acc[1]); o.y = pk2(acc[2], acc[3]);
                *(LAS u32x2*)(Xs + (it * 16 + fr) * 40 + tt * 16 + fq * 4) = o;
            }
            if (wv == 0 && lane < 32) {
                float Tr[32];
#pragma unroll
                for (int t = 0; t < 32; ++t) {
                    float acc = (lane == t) ? 1.f : 0.f;
#pragma unroll
                    for (int s4 = 0; s4 < (t + 3) / 4; ++s4) { const f32x4 n4 = *(const LAS f32x4*)(N1t + t * 36 + s4 * 4);
#pragma unroll
                        for (int u = 0; u < 4; ++u) if (s4 * 4 + u < t) acc += Tr[s4 * 4 + u] * n4[u]; }
                    Tr[t] = acc;
                    if ((t & 1) == 1) asm volatile("" ::: "memory");
                }
#pragma unroll
                for (int t = 0; t < 32; ++t) Tmt[t * 40 + lane] = f2bf(Tr[t]);
            }
            __syncthreads();
            {
                f32x4 acc = (f32x4){0.f, 0.f, 0.f, 0.f};
                acc = MFMA16(ldsfrag(Tmt + (tt * 16 + fr) * 40 + fq * 8), ldsfrag(Xs + (it * 16 + fr) * 40 + fq * 8), acc);
                u32x2 o; o.x = pk2(acc[0], acc[1]); o.y = pk2(acc[2], acc[3]);
                *(LAS u32x2*)(Us + (it * 16 + fr) * 40 + tt * 16 + fq * 4) = o;
            }
            __syncthreads();
            {
                const LAS bf16_t* Ap = S0c + (it * 16 + fr) * 72 + fq * 8; const LAS bf16_t* Bp = Rt + (tt * 16 + fr) * 72 + fq * 8;
                f32x4 acc = (f32x4){0.f, 0.f, 0.f, 0.f};
                acc = MFMA16(ldsfrag(Ap), ldsfrag(Bp), acc); acc = MFMA16(ldsfrag(Ap + 32), ldsfrag(Bp + 32), acc);
                const bf16x8 uf = ldsfrag(Us + (it * 16 + fr) * 40 + fq * 8), vf = ldsfrag(Vt + (it * 16 + fr) * 40 + fq * 8);
                acc = MFMA16(uf, ldsfrag(M3t + (tt * 16 + fr) * 40 + fq * 8), acc);
                acc = MFMA16(vf, ldsfrag(M4t + (tt * 16 + fr) * 40 + fq * 8), acc);
                const int p = tt * 16 + fr, pi = ck * 32 + p, t = dir ? (slen - 1 - pi) : pi;
                *(f32x4*)(ybuf + ((size_t)dir * M + rowbase + t) * W + h * 64 + it * 16 + fq * 4) = acc;
                LAS bf16_t* S0n = S0s + (cur ^ 1) * 4608;
#pragma unroll
                for (int k2 = 0; k2 < 2; ++k2) {
                    const int jt = tt * 2 + k2;
                    const f32x4 g4 = *(const LAS f32x4*)(gC + jt * 16 + fq * 4);
                    f32x4 s = Sacc[k2] * g4;
                    s = MFMA16(ldsfrag(BpT + (jt * 16 + fr) * 40 + fq * 8), uf, s);
                    s = MFMA16(ldsfrag(KpT + (jt * 16 + fr) * 40 + fq * 8), vf, s);
                    Sacc[k2] = s;
                    u32x2 o; o.x = pk2(s[0], s[1]); o.y = pk2(s[2], s[3]);
                    *(LAS u32x2*)(S0n + (it * 16 + fr) * 72 + jt * 16 + fq * 4) = o;
                }
            }
            cur ^= 1;
#pragma unroll
            for (int q = 0; q < 4; ++q)
#pragma unroll
                for (int e = 0; e < 11; ++e) raw[q][e] = bf2f(nraw[q][e]);
        }
    }
#undef SCAN_LOAD
}


__device__ __forceinline__ int clampi(int v, int lo, int hi) { return v < lo ? lo : (v > hi ? hi : v); }

__device__ __forceinline__ void attn_unit(const Args& a, int layer, int unit, bool isctx, LAS unsigned char* lds) {
    const int tid = otid(), lane = tid & 63, wv = tid >> 6, fr = lane & 15, fq = lane >> 4;
    constexpr int VS = 840;
    LAS bf16_t* Vt = (LAS bf16_t*)lds;
    LAS float* rpbs = (LAS float*)(lds + 64 * VS * 2);
    const bf16_t* P = (const bf16_t*)(a.ws + WS_P);
    bf16_t* bna = (bf16_t*)(a.ws + WS_BB);
    int b, h, rp = 0, half = 0;
    if (!isctx) { b = unit >> 9; h = (unit >> 5) & 15; rp = unit & 31; } else { b = unit >> 5; h = (unit >> 1) & 15; half = unit & 1; }
    int r0a = 0, nloc = 0;
    if (!isctx) { r0a = clampi(2 * rp - 4, 0, 56); const int r0b = clampi(2 * rp - 3, 0, 56); nloc = (r0b + 8 - r0a) * 64; }
    __syncthreads();
    {
        const int nk8 = (nloc + 256) * 8;
        u32x4 vv[13];
#pragma unroll
        for (int i = 0; i < 13; ++i) { const int cidx = tid + i * 512; const int key = cidx >> 3, dc = cidx & 7;
            const int srow = (key < nloc) ? (b * TT + LC + r0a * 64 + key) : (b * TT + min(key - nloc, 255));
            if (cidx < nk8) vv[i] = *(const u32x4*)(P + (size_t)srow * NP + C_V + h * 64 + dc * 8); }
#pragma unroll
        for (int i = 0; i < 13; ++i) { const int cidx = tid + i * 512; const int key = cidx >> 3, dc = cidx & 7;
            const int dcol = (key < nloc) ? key : (576 + key - nloc);
            if (cidx < nk8) { const u32x4 v = vv[i]; LAS bf16_t* d = Vt + (dc * 8) * VS + dcol;
                d[0] = (bf16_t)(v.x & 0xffff); d[VS] = (bf16_t)(v.x >> 16); d[2 * VS] = (bf16_t)(v.y & 0xffff); d[3 * VS] = (bf16_t)(v.y >> 16);
                d[4 * VS] = (bf16_t)(v.z & 0xffff); d[5 * VS] = (bf16_t)(v.z >> 16); d[6 * VS] = (bf16_t)(v.w & 0xffff); d[7 * VS] = (bf16_t)(v.w >> 16); } }
    }
    if (!isctx) for (int i = tid; i < 465; i += 512) rpbs[i] = a.na_rpb[(size_t)(layer * 16 + h) * 465 + i];
    __syncthreads();

    int qtok, r = 0, qc = 0, cs = 0, r0 = 0;
    if (!isctx) { r = 2 * rp + (wv >> 2); const int g = wv & 3; qc = g * 16 + fr; cs = (g == 0) ? 0 : (g == 1 ? 8 : (g == 2 ? 24 : 32)); r0 = clampi(r - 4, 0, 56); qtok = b * TT + LC + r * 64 + qc; }
    else qtok = b * TT + half * 128 + wv * 16 + fr;
    bf16x8 qf[2];
    qf[0] = *(const bf16x8*)(P + (size_t)qtok * NP + C_Q + h * 64 + fq * 8);
    qf[1] = *(const bf16x8*)(P + (size_t)qtok * NP + C_Q + h * 64 + 32 + fq * 8);
    const int cstart = clampi(qc - 8, 0, 48);
    float mrun = -1e30f, lrun = 0.f;
    f32x4 o[4];
#pragma unroll
    for (int dt = 0; dt < 4; ++dt) o[dt] = (f32x4){0.f, 0.f, 0.f, 0.f};
    const int nblk = isctx ? 8 : 16;
#define ATT_KLOAD(dst, blkx) do { const int bx_ = (blkx) < nblk ? (blkx) : nblk - 1; const bool lc_ = (!isctx) && (bx_ < 8); \
        _Pragma("unroll") for (int ti = 0; ti < 2; ++ti) { const size_t ktok_ = lc_ ? (size_t)(b * TT + LC + (r0 + bx_) * 64 + cs + ti * 16 + fr) : (size_t)(b * TT + ((bx_ & 7) * 32) + ti * 16 + fr); \
            const bf16_t* kp_ = P + ktok_ * NP + C_K + h * 64 + fq * 8; dst[ti][0] = *(const bf16x8*)kp_; dst[ti][1] = *(const bf16x8*)(kp_ + 32); } } while (0)
    bf16x8 kf[2][2];
    ATT_KLOAD(kf, 0);
    for (int blk = 0; blk < nblk; ++blk) {
        const bool loc = (!isctx) && (blk < 8);
        const int gr = r0 + blk;
        bf16x8 kn[2][2];
        ATT_KLOAD(kn, blk + 1);
        f32x4 s[2];
#pragma unroll
        for (int ti = 0; ti < 2; ++ti) {
            f32x4 z = (f32x4){0.f, 0.f, 0.f, 0.f};
            z = __builtin_amdgcn_mfma_f32_16x16x32_bf16(kf[ti][0], qf[0], z, 0, 0, 0);
            s[ti] = __builtin_amdgcn_mfma_f32_16x16x32_bf16(kf[ti][1], qf[1], z, 0, 0, 0);
        }
        float sv[8];
        if (loc) {
            const LAS float* brow = rpbs + (gr - r + 7) * 31;
#pragma unroll
            for (int ti = 0; ti < 2; ++ti)
#pragma unroll
                for (int rg = 0; rg < 4; ++rg) { const int kc = cs + ti * 16 + fq * 4 + rg; const bool valid = (kc >= cstart) && (kc < cstart + 16);
                    const int co = clampi(kc - qc + 15, 0, 30); sv[ti * 4 + rg] = valid ? (s[ti][rg] * 0.125f + brow[co]) : -1e30f; }
        } else {
#pragma unroll
            for (int ti = 0; ti < 2; ++ti)
#pragma unroll
                for (int rg = 0; rg < 4; ++rg) sv[ti * 4 + rg] = s[ti][rg] * 0.125f;
        }
        float mx = fmaxf(fmaxf(fmaxf(sv[0], sv[1]), fmaxf(sv[2], sv[3])), fmaxf(fmaxf(sv[4], sv[5]), fmaxf(sv[6], sv[7])));
        mx = fmaxf(mx, __shfl_xor(mx, 16)); mx = fmaxf(mx, __shfl_xor(mx, 32));
        const float mnew = fmaxf(mrun, mx); const float alpha = __expf(mrun - mnew); mrun = mnew;
        float ps = 0.f; float pv[8];
#pragma unroll
        for (int i = 0; i < 8; ++i) { pv[i] = __expf(sv[i] - mnew); ps += pv[i]; }
        lrun = lrun * alpha + ps;
#pragma unroll
        for (int dt = 0; dt < 4; ++dt) o[dt] *= alpha;
        u32x4 pp; pp.x = pk2(pv[0], pv[1]); pp.y = pk2(pv[2], pv[3]); pp.z = pk2(pv[4], pv[5]); pp.w = pk2(pv[6], pv[7]);
        const bf16x8 pf = __builtin_bit_cast(bf16x8, pp);
        const int kbase = loc ? ((gr - r0a) * 64 + cs) : (576 + (blk & 7) * 32);
#pragma unroll
        for (int dt = 0; dt < 4; ++dt) { const LAS bf16_t* vp = Vt + (dt * 16 + fr) * VS + kbase + fq * 4;
            const u32x2 lo = *(const LAS u32x2*)vp, hi = *(const LAS u32x2*)(vp + 16);
            u32x4 vv; vv.x = lo.x; vv.y = lo.y; vv.z = hi.x; vv.w = hi.y;
            o[dt] = __builtin_amdgcn_mfma_f32_16x16x32_bf16(__builtin_bit_cast(bf16x8, vv), pf, o[dt], 0, 0, 0); }
#pragma unroll
        for (int ti = 0; ti < 2; ++ti) { kf[ti][0] = kn[ti][0]; kf[ti][1] = kn[ti][1]; }
    }
#undef ATT_KLOAD
    lrun += __shfl_xor(lrun, 16); lrun += __shfl_xor(lrun, 32);
    const float inv = 1.f / lrun;
#pragma unroll
    for (int dt = 0; dt < 4; ++dt) { const int dcol = h * 64 + dt * 16 + fq * 4;
        const u32x2 gt = *(const u32x2*)(P + (size_t)qtok * NP + C_NAG + dcol);
        u32x2 ov; ov.x = pk2(o[dt][0] * inv * siluf(bflo(gt.x)), o[dt][1] * inv * siluf(bfhi(gt.x))); ov.y = pk2(o[dt][2] * inv * siluf(bflo(gt.y)), o[dt][3] * inv * siluf(bfhi(gt.y)));
        *(u32x2*)(bna + (size_t)qtok * W + dcol) = ov; }
}

__device__ __forceinline__ void pool_unit(const Args& a, int unit) {
    const int tid = otid();
    const bf16_t* P = (const bf16_t*)(a.ws + WS_P);
    bf16_t* diff = (bf16_t*)(a.ws + WS_DIFF);
    const int cc = tid & 127, g = cc >> 5, hw = 1 << g;
    for (int pass = 0; pass < 8; ++pass) {
        const int row = unit * 32 + pass * 4 + (tid >> 7); const int b = row / TT, t = row % TT;
        int s0, slen, tl; if (t < LC) { s0 = b * TT; slen = LC; tl = t; } else { s0 = b * TT + LC; slen = T; tl = t - LC; }
        const int lo = max(tl - hw, 0), hi = min(tl + hw, slen);
        float sm[8];
#pragma unroll
        for (int j = 0; j < 8; ++j) sm[j] = 0.f;
        u32x4 wv4[16];
#pragma unroll
        for (int k = 0; k < 16; ++k) { const int sx = tl - hw + k; const bool ok = (k < 2 * hw) && (sx >= 0) && (sx < slen); const int sc = ok ? sx : tl;
            wv4[k] = *(const u32x4*)(P + (size_t)(s0 + sc) * NP + C_PU + cc * 8); }
#pragma unroll
        for (int k = 0; k < 16; ++k) { const int sx = tl - hw + k; const bool ok = (k < 2 * hw) && (sx >= 0) && (sx < slen); const float mk = ok ? 1.f : 0.f; const u32x4 v = wv4[k];
            sm[0] += mk * bflo(v.x); sm[1] += mk * bfhi(v.x); sm[2] += mk * bflo(v.y); sm[3] += mk * bfhi(v.y); sm[4] += mk * bflo(v.z); sm[5] += mk * bfhi(v.z); sm[6] += mk * bflo(v.w); sm[7] += mk * bfhi(v.w); }
        const float inv = 1.f / (float)(hi - lo);
        const u32x4 u = *(const u32x4*)(P + (size_t)row * NP + C_PU + cc * 8);
        u32x4 o; o.x = pk2(sm[0] * inv - bflo(u.x), sm[1] * inv - bfhi(u.x)); o.y = pk2(sm[2] * inv - bflo(u.y), sm[3] * inv - bfhi(u.y));
        o.z = pk2(sm[4] * inv - bflo(u.z), sm[5] * inv - bfhi(u.z)); o.w = pk2(sm[6] * inv - bflo(u.w), sm[7] * inv - bfhi(u.w));
        *(u32x4*)(diff + (size_t)row * W + cc * 8) = o;
    }
}

__device__ __forceinline__ void phase_mixers(const Args& a, int layer, LAS unsigned char* lds) {
    const int G = gridDim.x, bid = blockIdx.x;
    const int nsc = (G >= 192) ? 128 : 0;
    if (PH_MASK & 0x200) { if (nsc) { if (bid < nsc) { scan_item(a, layer, bid, lds); return; } }
    else { for (int it = bid; it < 128; it += G) scan_item(a, layer, it, lds); } }
    const int w = nsc ? bid - nsc : bid, nw = nsc ? G - nsc : G;
    const int n_lat = 2048, n_ctx = (layer == 0) ? 128 : 0, n_pool = 544;
    for (int u = w; u < n_lat + n_ctx + n_pool; u += nw) {
        if (u < n_lat) { if (PH_MASK & 0x400) attn_unit(a, layer, u, false, lds); }
        else if (u < n_lat + n_ctx) { if (PH_MASK & 0x400) attn_unit(a, layer, u - n_lat, true, lds); }
        else if (PH_MASK & 0x800) pool_unit(a, u - n_lat - n_ctx);
    }
}

__device__ __forceinline__ void phase_readout(const Args& a, int layer) {
    const int tid = otid(), lane = tid & 63, wv = tid >> 6;
    const int gw = blockIdx.x * 8 + wv, NGW = gridDim.x * 8;
    const bf16_t* P = (const bf16_t*)(a.ws + WS_P);
    const float* ybuf = (const float*)(a.ws + WS_Y);
    const float* bonus = (const float*)(a.ws + WS_BONUS);
    bf16_t* brw = (bf16_t*)(a.ws + WS_BB) + (size_t)2 * M * W;
    for (int it = gw; it < M * 16; it += NGW) {
        const int row = it >> 4, h = it & 15; const int b = row / TT, t = row % TT;
        if (layer == 1 && t < LC) continue;
        const int ch = h * 64 + lane;
        int tl, slen; if (t < LC) { tl = t; slen = LC; } else { tl = t - LC; slen = T; }
        const float y = ybuf[(size_t)row * W + ch] + ybuf[((size_t)M + row) * W + ch];
        const float mean = wave_sum(y) * (1.f / 64.f); const float dv = y - mean; const float var = wave_sum(dv * dv) * (1.f / 64.f);
        const float yn = dv * rsqrtf(var + 64e-5f) * a.rw_lnx_g[layer * W + ch] + a.rw_lnx_b[layer * W + ch];
        const bf16_t* pr = P + (size_t)row * NP;
        const float v0 = bf2f(pr[C_RV + ch]); float vs = 0.f;
        if (tl > 0) vs += bf2f(pr[C_RV + ch - NP]);
        if (tl < slen - 1) vs += bf2f(pr[C_RV + ch + NP]);
        const float v = v0 + a.rw_mu[(layer * 3 + 2) * W + ch] * (0.5f * vs - v0);
        const float bs = bonus[(size_t)row * 16 + h] + bonus[((size_t)M + row) * 16 + h];
        const float o = (yn + bs * v) * siluf(bf2f(pr[C_RG + ch]));
        const float o2 = __shfl_down(o, 1);
        if ((lane & 1) == 0) *(unsigned*)(brw + (size_t)row * W + ch) = pk2(o, o2);
    }
}

__device__ __forceinline__ void phase_final(const Args& a) {
    const int tid = otid(), lane = tid & 63, wv = tid >> 6;
    const int gw = blockIdx.x * 8 + wv, NGW = gridDim.x * 8;
    for (int row = gw; row < NB * T; row += NGW) {
        float* xr = a.out + (size_t)row * D;
        f32x4 v[8]; float ss = 0.f;
#pragma unroll
        for (int j = 0; j < 8; ++j) { v[j] = *(const f32x4*)(xr + 4 * lane + 256 * j); ss += (v[j][0] * v[j][0] + v[j][1] * v[j][1]) + (v[j][2] * v[j][2] + v[j][3] * v[j][3]); }
        ss = wave_sum(ss); const float rstd = rsqrtf(ss * (1.f / D) + 1e-6f);
#pragma unroll
        for (int j = 0; j < 8; ++j) { const int col = 4 * lane + 256 * j; const f32x4 g4 = *(const f32x4*)(a.final_g + col); *(f32x4*)(xr + col) = (v[j] * rstd) * g4; }
    }
}

__global__ void __launch_bounds__(512, 2) fwd_kernel(Args a) {
    extern __shared__ __attribute__((aligned(16))) unsigned char smem[];
    LAS unsigned char* lds = (LAS unsigned char*)smem;
    cg::grid_group grid = cg::this_grid();
    const int G = gridDim.x, c = blockIdx.x;
    for (int ph = a.ph_lo; ph < a.ph_hi; ++ph) {
        if (ph > a.ph_lo) grid.sync();
        if (ph == 0) { if (PH_MASK & 1) phase_mod(a, lds); continue; }
        if (ph == 13) { if (PH_MASK & 128) phase_final(a); continue; }
        const int layer = (ph - 1) / 6, sub = (ph - 1) % 6;
        int nrep = 1;
#ifdef REP_SUB
        if (sub == REP_SUB && ((REP_LAYERS >> layer) & 1)) nrep = 2;
#endif
        for (int rep = 0; rep < nrep; ++rep) {
        if (rep) grid.sync();
        bf16_t* P = (bf16_t*)(a.ws + WS_P);
        if (sub == 0) { if (PH_MASK & 2) phase_norm_convert(a, layer, lds); }
        else if (sub == 1) {
            Gemm g; g.A = (const bf16_t*)(a.ws + WS_H); g.Bt = (const bf16_t*)(a.ws + WS_WTIN); g.lda = D; g.ldb = D; g.K = D; g.a_z = 0; g.b_z = 0;
            g.nM = 68; g.nN = 65; g.nz = 1; g.latent_only = 0; g.G = G; g.c = c;
            EpiP e; e.P = P; if (PH_MASK & 4) gemm_phase(lds, g, e);
        } else if (sub == 2) { if (PH_MASK & 8) phase_mixers(a, layer, lds); }
        else if (sub == 3) {
            if (PH_MASK & 256) phase_readout(a, layer);
            Gemm g; g.A = (const bf16_t*)(a.ws + WS_DIFF); g.Bt = (const bf16_t*)(a.ws + WS_WTPL); g.lda = W; g.ldb = 256; g.K = 256; g.a_z = 256; g.b_z = 65536;
            g.nM = layer ? 64 : 68; g.nN = 1; g.nz = 4; g.latent_only = layer; g.G = G; g.c = c;
            EpiPool e; e.P = P; e.out = (bf16_t*)(a.ws + WS_BB) + (size_t)M * W; e.scale = a.pool_scale + layer * W; if (PH_MASK & 16) gemm_phase(lds, g, e);
        } else if (sub == 4) {
            Gemm g; g.A = (const bf16_t*)(a.ws + WS_BB); g.Bt = (const bf16_t*)(a.ws + WS_WTBR); g.lda = W; g.ldb = W; g.K = W; g.a_z = (size_t)M * W; g.b_z = (size_t)D * W;
            g.nM = layer ? 64 : 68; g.nN = 8; g.nz = 3; g.latent_only = layer; g.G = G; g.c = c;
            EpiMerge e; e.P = P; e.mf = (float*)(a.ws + WS_Y); e.mb = (bf16_t*)(a.ws + WS_H); if (PH_MASK & 32) gemm_phase(lds, g, e);
        } else {
            Gemm g; g.A = (const bf16_t*)(a.ws + WS_H); g.Bt = (const bf16_t*)(a.ws + WS_WTOUT); g.lda = D; g.ldb = D; g.K = D; g.a_z = 0; g.b_z = 0;
            g.nM = layer ? 64 : 68; g.nN = 8; g.nz = 1; g.latent_only = layer; g.G = G; g.c = c;
            EpiOut e; e.xl_old = layer ? (const float*)a.out : a.x; e.xc_old = layer ? (const float*)(a.ws + WS_XCTX) : a.ctx; e.xl_new = a.out; e.xc_new = (float*)(a.ws + WS_XCTX);
            e.mod = (const float*)(a.ws + WS_MOD) + layer * 5 * 6144; if (PH_MASK & 64) gemm_phase(lds, g, e);
        }
        }
    }
}

extern "C" void kernel_launch(void* const* d_in, const int* in_sizes, int n_in, void* d_out, int out_size, void* d_ws, size_t ws_size, hipStream_t stream) {
    static int grid = 0;
    if (grid == 0) {
        if (n_in != 24 || ws_size < WS_END) { fprintf(stderr, "kernel_launch: unexpected n_in %d or ws_size %zu (< %zu)\n", n_in, ws_size, (size_t)WS_END); grid = -1; return; }
        int dev = 0, cus = 0, per_cu = 0;
        hipGetDevice(&dev); hipDeviceGetAttribute(&cus, hipDeviceAttributeMultiprocessorCount, dev);
        if (hipFuncSetAttribute((const void*)fwd_kernel, hipFuncAttributeMaxDynamicSharedMemorySize, LDS_BYTES) != hipSuccess) { fprintf(stderr, "kernel_launch: hipFuncSetAttribute failed\n"); grid = -1; return; }
        hipOccupancyMaxActiveBlocksPerMultiprocessor(&per_cu, (const void*)fwd_kernel, 512, LDS_BYTES);
        if (per_cu < 1) { fprintf(stderr, "kernel_launch: occupancy query says %d\n", per_cu); per_cu = 1; }
        (void)hipGetLastError();
        grid = cus;
    }
    if (grid < 0) return;
    hipMemsetAsync((char*)d_ws + WS_MOD, 0, WS_MOD_BYTES, stream);
    Args a{};
    const float** pp = (const float**)&a;
    for (int i = 0; i < 24; ++i) pp[i] = (const float*)d_in[i];
    a.out = (float*)d_out; a.ws = (unsigned char*)d_ws;
#if N_LAUNCH_PER_PHASE
    for (int ph = 0; ph < NPHASE; ++ph) {
        a.ph_lo = ph; a.ph_hi = ph + 1;
        void* args[] = {&a};
        hipError_t e = hipLaunchCooperativeKernel((const void*)fwd_kernel, dim3(grid), dim3(512), args, LDS_BYTES, stream);
        if (e != hipSuccess) { fprintf(stderr, "cooperative launch failed: %s\n", hipGetErrorString(e)); break; }
    }
#else
    a.ph_lo = 0; a.ph_hi = NPHASE;
    void* args[] = {&a};
    hipError_t e = hipLaunchCooperativeKernel((const void*)fwd_kernel, dim3(grid), dim3(512), args, LDS_BYTES, stream);
    if (e != hipSuccess) fprintf(stderr, "cooperative launch failed: %s (grid %d)\n", hipGetErrorString(e), grid);
#endif
}
```

```cpp
#include <hip/hip_runtime.h>
#include <hip/hip_cooperative_groups.h>
#include <cstdio>
namespace cg = cooperative_groups;

#ifndef N_LAUNCH_PER_PHASE
#define N_LAUNCH_PER_PHASE 0
#endif

#ifndef REP_LAYERS
#define REP_LAYERS 3
#endif
#ifndef PH_MASK
#define PH_MASK 0xffff
#endif
#define LAS __attribute__((address_space(3)))
typedef unsigned short bf16_t;
typedef short bf16x8 __attribute__((ext_vector_type(8)));
typedef float f32x4 __attribute__((ext_vector_type(4)));
typedef unsigned u32x4 __attribute__((ext_vector_type(4)));
typedef unsigned u32x2 __attribute__((ext_vector_type(2)));

constexpr int D = 2048, NB = 4, T = 4096, LC = 256, TT = 4352, M = 17408, W = 1024, NP = 16640;
constexpr int C_Q = 0, C_K = 1024, C_V = 2048, C_NAG = 3072, C_PU = 4096, C_PG = 5120, C_RR = 6144, C_RK = 7168, C_RV = 8192, C_RG = 9216,
              C_MG = 10240, C_LW = 16384, C_LA = 16448;
constexpr int NPHASE = 14;
constexpr int LDS_BYTES = 163840;

constexpr size_t WS_MOD = 0, WS_MOD_BYTES = 262144;
constexpr size_t WS_BONUS = WS_MOD + WS_MOD_BYTES;
constexpr size_t WS_XCTX = WS_BONUS + 2359296;
constexpr size_t WS_WTIN = WS_XCTX + (size_t)NB * LC * D * 4;
constexpr size_t WS_WTBR = WS_WTIN + (size_t)NP * D * 2;
constexpr size_t WS_WTOUT = WS_WTBR + (size_t)3 * D * W * 2;
constexpr size_t WS_WTPL = WS_WTOUT + (size_t)D * D * 2;
constexpr size_t WS_H = WS_WTPL + (size_t)4 * 256 * 256 * 2;
constexpr size_t WS_Y = WS_H + (size_t)M * D * 2;
constexpr size_t WS_BB = WS_Y + (size_t)2 * M * W * 4;
constexpr size_t WS_DIFF = WS_BB + (size_t)3 * M * W * 2;
constexpr size_t WS_P = WS_DIFF + (size_t)M * W * 2;
constexpr size_t WS_END = WS_P + (size_t)M * NP * 2;

struct Args {
    const float *x, *c, *ctx, *c_ctx, *norm_g, *w_mod, *b_mod, *w_in, *na_rpb, *pool_w, *pool_scale, *rw_mu, *rw_w0, *rw_w2, *rw_a0, *rw_a2, *rw_k_k,
        *rw_k_a, *rw_r_k, *rw_lnx_g, *rw_lnx_b, *w_branch, *w_out, *final_g;
    float* out;
    unsigned char* ws;
    int ph_lo, ph_hi;
};

__device__ __forceinline__ float bf2f(bf16_t v) { return __uint_as_float(((unsigned)v) << 16); }
__device__ __forceinline__ float bflo(unsigned u) { return __uint_as_float(u << 16); }
__device__ __forceinline__ float bfhi(unsigned u) { return __uint_as_float(u & 0xffff0000u); }
typedef float f32x2 __attribute__((ext_vector_type(2)));
typedef __bf16 bf16x2_t __attribute__((ext_vector_type(2)));
__device__ __forceinline__ unsigned pk2(float lo, float hi) { const f32x2 v = {lo, hi}; const bf16x2_t b = __builtin_convertvector(v, bf16x2_t); return __builtin_bit_cast(unsigned, b); }
__device__ __forceinline__ float wave_sum(float v) {
#pragma unroll
    for (int o = 1; o < 64; o <<= 1) v += __shfl_xor(v, o);
    return v;
}
template <int CTRL> __device__ __forceinline__ float dppmov(float v) { return __int_as_float(__builtin_amdgcn_update_dpp(0, __float_as_int(v), CTRL, 0xF, 0xF, true)); }
__device__ __forceinline__ float sum8(float v) { v += dppmov<0xB1>(v); v += dppmov<0x4E>(v); v += dppmov<0x141>(v); return v; }
__device__ __forceinline__ float siluf(float x) { return x / (1.f + __expf(-x)); }
__device__ __forceinline__ float sigmf(float x) { return 1.f / (1.f + __expf(-x)); }
__device__ __forceinline__ int otid() { int t = threadIdx.x; asm volatile("" : "+v"(t)); return t; }
__device__ __forceinline__ void lds_wait() { asm volatile("s_waitcnt lgkmcnt(0)" ::: "memory"); }

constexpr int BM = 256, BK = 64, HALF = 128, HTB = HALF * BK * 2, NXCD = 8, WGM = 8;
__device__ __forceinline__ int lds_byte(int r, int c) { const int st = (r >> 4) * 2 + (c >> 5), rr = r & 15, cc = c & 31, ob = rr * 64 + cc * 2; return st * 1024 + (ob ^ (((ob >> 9) & 1) << 5)); }
__device__ __forceinline__ void stage_rc(int b, int& R, int& C) { const int st = b / 1024, sb = b % 1024, swz = sb ^ (((sb >> 9) & 1) << 5); R = (st >> 1) * 16 + swz / 64; C = (st & 1) * 32 + (swz % 64) / 2; }
__device__ __forceinline__ int perm32(int rho) { const int n = rho >> 4, i = rho & 15; return 8 * (i >> 2) + 4 * n + (i & 3); }

struct Unit { int pm, pn, z; };
struct Gemm {
    const bf16_t* A; const bf16_t* Bt; int lda, ldb, K; size_t a_z, b_z;
    int nM, nN, nz, latent_only, G, c;
    __device__ bool next(int i, Unit& u) const {
        const int zi = i % nz, r = i / nz; const long L = (long)r * G + c; const int nwg = nM * nN; if (L >= nwg) return false;
        int wgid = (int)L; { const int q = nwg / NXCD, rr = nwg % NXCD, xcd = wgid % NXCD, off = wgid / NXCD; wgid = (xcd < rr ? xcd * (q + 1) : rr * (q + 1) + (xcd - rr) * q) + off; }
        const int nig = WGM * nN, gid = wgid / nig, fm = gid * WGM, gsz = (nM - fm) < WGM ? (nM - fm) : WGM;
        int pm = fm + ((wgid % nig) % gsz); u.pn = (wgid % nig) / gsz; u.z = zi;
        u.pm = latent_only ? (pm / 16) * 17 + 1 + (pm % 16) : pm; return true;
    }
};

template <class Epi>
__device__ __forceinline__ void gemm_phase(LAS unsigned char* lds, const Gemm g, const Epi& E) {
    const int tid = otid(), wid = __builtin_amdgcn_readfirstlane(tid >> 6), lane = tid & 63, wr = wid >> 2, wc = wid & 3, fr = lane & 15, fq = lane >> 4;
    const int K = g.K, nt = K / BK;
    unsigned voffA[2], voffB[2];
#pragma unroll
    for (int i = 0; i < 2; ++i) { int R, C; stage_rc(tid * 16 + i * 8192, R, C); const int Rb = Epi::PERM ? ((R & ~31) + perm32(R & 31)) : R;
        voffA[i] = (unsigned)(R * g.lda + C) * 2u; voffB[i] = (unsigned)(Rb * g.ldb + C) * 2u; }
    const size_t kstep = (size_t)(BK * 2);
    const size_t hstepA = (size_t)HALF * g.lda * 2, hstepB = (size_t)HALF * g.ldb * 2;
    const unsigned ldsw = (unsigned)wid * 1024u;
    const int aoff = lds_byte(wr * 64 + fr, fq * 8), boff = lds_byte(wc * 32 + fr, fq * 8);
#define PG8_SA(b, h) (((b) * 2 + (h)) * HTB)
#define PG8_SB(b, h) ((4 + (b) * 2 + (h)) * HTB)
#define PG8_STAGE(bufoff, gbase, voff) do { _Pragma("unroll") for (int _i = 0; _i < 2; ++_i) \
        __builtin_amdgcn_global_load_lds((const unsigned*)((const char*)(gbase) + (voff)[_i]), (LAS unsigned*)(lds + (bufoff) + ldsw + _i * 8192), 16, 0, 0); } while (0)
#define PG8_LDA(dst, b, h) do { _Pragma("unroll") for (int m = 0; m < 4; ++m) _Pragma("unroll") for (int k = 0; k < 2; ++k) dst[m][k] = *(const LAS bf16x8*)(lds + PG8_SA(b, h) + aoff + m * 2048 + k * 1024); } while (0)
#define PG8_LDB(dst, b, h) do { _Pragma("unroll") for (int n = 0; n < 2; ++n) _Pragma("unroll") for (int k = 0; k < 2; ++k) dst[n][k] = *(const LAS bf16x8*)(lds + PG8_SB(b, h) + boff + n * 2048 + k * 1024); } while (0)
#define PG8_MMA(ai, bj, At, Bt) do { __builtin_amdgcn_s_setprio(1); _Pragma("unroll") for (int m = 0; m < 4; ++m) _Pragma("unroll") for (int n = 0; n < 2; ++n) _Pragma("unroll") for (int k = 0; k < 2; ++k) \
        acc[ai][bj][m][n] = __builtin_amdgcn_mfma_f32_16x16x32_bf16(Bt[n][k], At[m][k], acc[ai][bj][m][n], 0, 0, 0); __builtin_amdgcn_s_setprio(0); } while (0)
#define PG8_WAIT_V(n) asm volatile("s_waitcnt vmcnt(" #n ")" ::: "memory")
#define PG8_WAIT_L(n) asm volatile("s_waitcnt lgkmcnt(" #n ")" ::: "memory")
#define PG8_BAR __builtin_amdgcn_s_barrier()
#define PG8_SCHED __builtin_amdgcn_sched_barrier(0)
    Unit cur, nxt; int ui = 0;
    if (!g.next(0, cur)) return;
    f32x4 acc[2][2][4][2];
#pragma unroll
    for (int a = 0; a < 2; ++a)
#pragma unroll
        for (int b = 0; b < 2; ++b)
#pragma unroll
            for (int m = 0; m < 4; ++m)
#pragma unroll
                for (int n = 0; n < 2; ++n) acc[a][b][m][n] = (f32x4){0.f, 0.f, 0.f, 0.f};
    bf16x8 At[4][2], B0[2][2], B1[2][2];
    const char* cA = (const char*)(g.A + cur.z * g.a_z + (size_t)cur.pm * BM * g.lda); const char* cB = (const char*)(g.Bt + cur.z * g.b_z + (size_t)cur.pn * BM * g.ldb);
    PG8_STAGE(PG8_SB(0, 0), cB, voffB); PG8_STAGE(PG8_SA(0, 0), cA, voffA); PG8_STAGE(PG8_SB(0, 1), cB + hstepB, voffB); PG8_STAGE(PG8_SA(0, 1), cA + hstepA, voffA);
    if (wr == 1) PG8_BAR;
    PG8_WAIT_V(4); PG8_BAR;
    PG8_STAGE(PG8_SB(1, 0), cB + kstep, voffB); PG8_STAGE(PG8_SA(1, 0), cA + kstep, voffA); PG8_STAGE(PG8_SB(1, 1), cB + hstepB + kstep, voffB);
    PG8_WAIT_V(6); PG8_BAR;
    for (;;) {
        const bool has_next = g.next(ui + 1, nxt);
        const char* nA = has_next ? (const char*)(g.A + nxt.z * g.a_z + (size_t)nxt.pm * BM * g.lda) : cA;
        const char* nB = has_next ? (const char*)(g.Bt + nxt.z * g.b_z + (size_t)nxt.pn * BM * g.ldb) : cB;
        for (int t = 0; t < nt; t += 2) {
            const bool last = (t == nt - 2);
            const char* a1 = cA + (size_t)(t + 1) * kstep;
            const char* a2 = last ? nA : cA + (size_t)(t + 2) * kstep; const char* b2 = last ? nB : cB + (size_t)(t + 2) * kstep;
            const char* a3 = a2 + kstep; const char* b3 = b2 + kstep;
            PG8_LDB(B0, 0, 0); PG8_SCHED; PG8_LDA(At, 0, 0); PG8_STAGE(PG8_SA(1, 1), a1 + hstepA, voffA);
            PG8_WAIT_L(8); PG8_BAR; PG8_WAIT_L(0); PG8_MMA(0, 0, At, B0); PG8_BAR; PG8_SCHED;
            PG8_LDB(B1, 0, 1); PG8_STAGE(PG8_SB(0, 0), b2, voffB);
            PG8_BAR; PG8_WAIT_L(0); PG8_MMA(0, 1, At, B1); PG8_BAR;
            PG8_LDA(At, 0, 1); PG8_STAGE(PG8_SA(0, 0), a2, voffA);
            PG8_BAR; PG8_WAIT_L(0); PG8_MMA(1, 0, At, B0); PG8_BAR; PG8_SCHED;
            PG8_STAGE(PG8_SB(0, 1), b2 + hstepB, voffB);
            PG8_WAIT_V(6); PG8_BAR; PG8_MMA(1, 1, At, B1); PG8_BAR;
            PG8_LDB(B0, 1, 0); PG8_SCHED; PG8_LDA(At, 1, 0); PG8_STAGE(PG8_SA(0, 1), a2 + hstepA, voffA);
            PG8_WAIT_L(8); PG8_BAR; PG8_WAIT_L(0); PG8_MMA(0, 0, At, B0); PG8_BAR; PG8_SCHED;
            PG8_LDB(B1, 1, 1); PG8_STAGE(PG8_SB(1, 0), b3, voffB);
            PG8_BAR; PG8_WAIT_L(0); PG8_MMA(0, 1, At, B1); PG8_BAR;
            PG8_LDA(At, 1, 1); PG8_STAGE(PG8_SA(1, 0), a3, voffA);
            PG8_BAR; PG8_WAIT_L(0); PG8_MMA(1, 0, At, B0); PG8_BAR; PG8_SCHED;
            PG8_STAGE(PG8_SB(1, 1), b3 + hstepB, voffB);
            PG8_WAIT_V(6); PG8_BAR; PG8_MMA(1, 1, At, B1); PG8_BAR;
        }
        E(acc, cur, wr, wc, fr, fq);
        if (!has_next) break;
#pragma unroll
        for (int a = 0; a < 2; ++a)
#pragma unroll
            for (int b = 0; b < 2; ++b)
#pragma unroll
                for (int m = 0; m < 4; ++m)
#pragma unroll
                    for (int n = 0; n < 2; ++n) acc[a][b][m][n] = (f32x4){0.f, 0.f, 0.f, 0.f};
        cur = nxt; cA = nA; cB = nB; ++ui;
    }
    PG8_WAIT_V(0);
    if (wr == 0) PG8_BAR;
    PG8_BAR;
#undef PG8_SA
#undef PG8_SB
#undef PG8_STAGE
#undef PG8_LDA
#undef PG8_LDB
#undef PG8_MMA
#undef PG8_WAIT_V
#undef PG8_WAIT_L
#undef PG8_BAR
#undef PG8_SCHED
}

struct EpiP {
    static constexpr bool PERM = true;
    bf16_t* P;
    __device__ __forceinline__ void operator()(const f32x4 (&acc)[2][2][4][2], const Unit& u, int wr, int wc, int fr, int fq) const {
        const int row0 = u.pm * BM + wr * 64 + fr, col0 = u.pn * BM + wc * 32 + 8 * fq;
#pragma unroll
        for (int ai = 0; ai < 2; ++ai)
#pragma unroll
            for (int m = 0; m < 4; ++m) { bf16_t* rowp = P + (size_t)(row0 + ai * HALF + m * 16) * NP + col0;
#pragma unroll
                for (int bj = 0; bj < 2; ++bj) { const f32x4 v0 = acc[ai][bj][m][0], v1 = acc[ai][bj][m][1];
                    u32x4 o; o.x = pk2(v0[0], v0[1]); o.y = pk2(v0[2], v0[3]); o.z = pk2(v1[0], v1[1]); o.w = pk2(v1[2], v1[3]);
                    *(u32x4*)(rowp + bj * HALF) = o; } }
    }
};
struct EpiPool {
    static constexpr bool PERM = true;
    const bf16_t* P; bf16_t* out; const float* scale;
    __device__ __forceinline__ void operator()(const f32x4 (&acc)[2][2][4][2], const Unit& u, int wr, int wc, int fr, int fq) const {
        const int row0 = u.pm * BM + wr * 64 + fr, col0 = u.z * 256 + wc * 32 + 8 * fq;
#pragma unroll
        for (int ai = 0; ai < 2; ++ai)
#pragma unroll
            for (int m = 0; m < 4; ++m) { const size_t row = (size_t)(row0 + ai * HALF + m * 16);
#pragma unroll
                for (int bj = 0; bj < 2; ++bj) { const int col = col0 + bj * HALF; const f32x4 v0 = acc[ai][bj][m][0], v1 = acc[ai][bj][m][1];
                    const u32x4 gt = *(const u32x4*)(P + row * NP + C_PG + col);
                    const f32x4 s0 = *(const f32x4*)(scale + col), s1 = *(const f32x4*)(scale + col + 4);
                    u32x4 o;
                    o.x = pk2(v0[0] * s0[0] * siluf(bflo(gt.x)), v0[1] * s0[1] * siluf(bfhi(gt.x)));
                    o.y = pk2(v0[2] * s0[2] * siluf(bflo(gt.y)), v0[3] * s0[3] * siluf(bfhi(gt.y)));
                    o.z = pk2(v1[0] * s1[0] * siluf(bflo(gt.z)), v1[1] * s1[1] * siluf(bfhi(gt.z)));
                    o.w = pk2(v1[2] * s1[2] * siluf(bflo(gt.w)), v1[3] * s1[3] * siluf(bfhi(gt.w)));
                    *(u32x4*)(out + row * W + col) = o; } }
    }
};
struct EpiMerge {
    static constexpr bool PERM = false;
    const bf16_t* P; float* mf; bf16_t* mb;
    __device__ __forceinline__ void operator()(const f32x4 (&acc)[2][2][4][2], const Unit& u, int wr, int wc, int fr, int fq) const {
        const int row0 = u.pm * BM + wr * 64 + fr, col0 = u.pn * BM + wc * 32 + 4 * fq;
#pragma unroll
        for (int ai = 0; ai < 2; ++ai)
#pragma unroll
            for (int m = 0; m < 4; ++m) { const size_t row = (size_t)(row0 + ai * HALF + m * 16);
#pragma unroll
                for (int bj = 0; bj < 2; ++bj)
#pragma unroll
                    for (int n = 0; n < 2; ++n) { const int col = col0 + bj * HALF + n * 16; const f32x4 v = acc[ai][bj][m][n];
                        const u32x2 lg = *(const u32x2*)(P + row * NP + C_MG + u.z * D + col);
                        f32x4 r; r[0] = v[0] * sigmf(bflo(lg.x)); r[1] = v[1] * sigmf(bfhi(lg.x)); r[2] = v[2] * sigmf(bflo(lg.y)); r[3] = v[3] * sigmf(bfhi(lg.y));
                        float* mp = mf + row * D + col;
                        if (u.z > 0) { const f32x4 o = *(const f32x4*)mp; r += o; }
                        if (u.z < 2) *(f32x4*)mp = r;
                        else { u32x2 o; o.x = pk2(r[0], r[1]); o.y = pk2(r[2], r[3]); *(u32x2*)(mb + row * D + col) = o; } } }
    }
};
struct EpiOut {
    static constexpr bool PERM = false;
    const float* xl_old; const float* xc_old; float* xl_new; float* xc_new; const float* mod;
    __device__ __forceinline__ void operator()(const f32x4 (&acc)[2][2][4][2], const Unit& u, int wr, int wc, int fr, int fq) const {
        const int b = u.pm / 17, tl = u.pm % 17; const bool isc = (tl == 0);
        const float* xo = isc ? xc_old + (size_t)b * LC * D : xl_old + ((size_t)b * T + (tl - 1) * 256) * D;
        float* xn = isc ? xc_new + (size_t)b * LC * D : xl_new + ((size_t)b * T + (tl - 1) * 256) * D;
        const float* gp = mod + (isc ? 4 : b) * 6144 + 4096;
        const int row0 = wr * 64 + fr, col0 = u.pn * BM + wc * 32 + 4 * fq;
#pragma unroll
        for (int bj = 0; bj < 2; ++bj)
#pragma unroll
            for (int n = 0; n < 2; ++n) { const int col = col0 + bj * HALF + n * 16; const f32x4 gt = *(const f32x4*)(gp + col);
#pragma unroll
                for (int ai = 0; ai < 2; ++ai)
#pragma unroll
                    for (int m = 0; m < 4; ++m) { const size_t off = (size_t)(row0 + ai * HALF + m * 16) * D + col;
                        const f32x4 o = *(const f32x4*)(xo + off); *(f32x4*)(xn + off) = o + gt * acc[ai][bj][m][n]; } }
    }
};

__device__ __forceinline__ void phase_mod(const Args& a, LAS unsigned char* lds) {
    const int tidm = otid();
    LAS float* s = (LAS float*)lds;
    float* modp = (float*)(a.ws + WS_MOD);
    for (int task = blockIdx.x; task < 192; task += gridDim.x) {
        const int l = task / 96, rem = task % 96, cb = rem >> 3, kc = rem & 7, k0 = kc * 256;
        __syncthreads();
        for (int i = tidm; i < 5 * 256; i += 512) { const int r = i >> 8, k = i & 255; const float c = (r < 4) ? a.c[r * D + k0 + k] : a.c_ctx[k0 + k]; s[i] = c / (1.f + expf(-c)); }
        __syncthreads();
        const int n = cb * 512 + tidm;
        const float* w = a.w_mod + (size_t)l * D * 6144 + (size_t)k0 * 6144 + n;
        float a0 = 0.f, a1 = 0.f, a2 = 0.f, a3 = 0.f, a4 = 0.f;
#pragma unroll 8
        for (int k = 0; k < 256; ++k) { const float wv = w[(size_t)k * 6144]; a0 += s[k] * wv; a1 += s[256 + k] * wv; a2 += s[512 + k] * wv; a3 += s[768 + k] * wv; a4 += s[1024 + k] * wv; }
        float* mo = modp + l * 5 * 6144 + n;
        const float bias = (kc == 0) ? a.b_mod[l * 6144 + n] : 0.f;
        atomicAdd(mo, a0 + bias); atomicAdd(mo + 6144, a1 + bias); atomicAdd(mo + 2 * 6144, a2 + bias); atomicAdd(mo + 3 * 6144, a3 + bias); atomicAdd(mo + 4 * 6144, a4 + bias);
    }
}

__device__ __forceinline__ void transpose_item(const float* Wsrc, int ldsrc, int k0, int nsrc0, bf16_t* dst, int ldd, LAS float* scr, int lane) {
    if (nsrc0 >= 0) {
#pragma unroll 8
        for (int i = 0; i < 32; ++i) { const int kk = 2 * i + (lane >> 5); scr[kk * 33 + (lane & 31)] = Wsrc[(size_t)(k0 + kk) * ldsrc + nsrc0 + (lane & 31)]; }
    } else {
#pragma unroll 8
        for (int i = 0; i < 32; ++i) { const int kk = 2 * i + (lane >> 5); scr[kk * 33 + (lane & 31)] = 0.f; }
    }
    lds_wait();
    const int c = lane & 7;
#pragma unroll
    for (int j = 0; j < 4; ++j) { const int n = (lane >> 3) + 8 * j; const LAS float* s = scr + (8 * c) * 33 + n;
        u32x4 o; o.x = pk2(s[0 * 33], s[1 * 33]); o.y = pk2(s[2 * 33], s[3 * 33]); o.z = pk2(s[4 * 33], s[5 * 33]); o.w = pk2(s[6 * 33], s[7 * 33]);
        *(u32x4*)(dst + (size_t)n * ldd + k0 + 8 * c) = o; }
    lds_wait();
}
__device__ __forceinline__ void phase_norm_convert(const Args& a, int layer, LAS unsigned char* lds) {
    const int tid = otid(), lane = tid & 63, wv = tid >> 6;
    const int gw = blockIdx.x * 8 + wv, NGW = gridDim.x * 8;
    {
        LAS float* scr = (LAS float*)(lds + wv * 8448);
        bf16_t* wtin = (bf16_t*)(a.ws + WS_WTIN); bf16_t* wtbr = (bf16_t*)(a.ws + WS_WTBR); bf16_t* wtout = (bf16_t*)(a.ws + WS_WTOUT); bf16_t* wtpl = (bf16_t*)(a.ws + WS_WTPL);
        constexpr int I_IN = 32 * 520, I_BR = 16 * 64, I_OUT = 32 * 64, I_PL = 4 * 8;
        constexpr int NIT = I_IN + 3 * I_BR + I_OUT + 4 * I_PL;
        for (int it = gw; it < NIT; it += NGW) {
            int r = it;
            if (r < I_IN) { const int kb = r / 520, nb = r % 520, n0 = nb * 32; const int ns = n0 < 10240 ? n0 : (n0 < 16384 ? n0 + 128 : (n0 < 16512 ? n0 - 6144 : -1));
                transpose_item(a.w_in + (size_t)layer * D * 16512, 16512, kb * 64, ns, wtin + (size_t)n0 * D, D, scr, lane); continue; }
            r -= I_IN;
            if (r < 3 * I_BR) { const int z = r / I_BR, q = r % I_BR, kb = q / 64, nb = q % 64;
                transpose_item(a.w_branch + ((size_t)layer * 3 + z) * W * D, D, kb * 64, nb * 32, wtbr + (size_t)z * D * W + (size_t)nb * 32 * W, W, scr, lane); continue; }
            r -= 3 * I_BR;
            if (r < I_OUT) { const int kb = r / 64, nb = r % 64;
                transpose_item(a.w_out + (size_t)layer * D * D, D, kb * 64, nb * 32, wtout + (size_t)nb * 32 * D, D, scr, lane); continue; }
            r -= I_OUT;
            { const int z = r / I_PL, q = r % I_PL, kb = q / 8, nb = q % 8;
                transpose_item(a.pool_w + ((size_t)layer * 4 + z) * 65536, 256, kb * 64, nb * 32, wtpl + (size_t)z * 65536 + (size_t)nb * 32 * 256, 256, scr, lane); }
        }
    }
    const float* ng = a.norm_g + layer * D;
    const float* mo = (const float*)(a.ws + WS_MOD) + layer * 5 * 6144;
    const float* xctx = (const float*)(a.ws + WS_XCTX);
    bf16_t* h = (bf16_t*)(a.ws + WS_H);
    for (int row = gw; row < M; row += NGW) {
        const int b = row / TT, t = row % TT; const float* xr; int mr;
        if (t < LC) { xr = (layer == 0 ? a.ctx : xctx) + (size_t)(b * LC + t) * D; mr = 4; }
        else { xr = (layer == 0 ? a.x : (const float*)a.out) + (size_t)(b * T + t - LC) * D; mr = b; }
        f32x4 v[8]; float ss = 0.f;
#pragma unroll
        for (int j = 0; j < 8; ++j) { v[j] = *(const f32x4*)(xr + 4 * lane + 256 * j); ss += (v[j][0] * v[j][0] + v[j][1] * v[j][1]) + (v[j][2] * v[j][2] + v[j][3] * v[j][3]); }
        ss = wave_sum(ss); const float rstd = rsqrtf(ss * (1.f / D) + 1e-6f);
        const float* mrow = mo + mr * 6144;
#pragma unroll
        for (int j = 0; j < 8; ++j) { const int col = 4 * lane + 256 * j; const f32x4 g4 = *(const f32x4*)(ng + col), sh = *(const f32x4*)(mrow + col), sc = *(const f32x4*)(mrow + 2048 + col);
            f32x4 o = (v[j] * rstd) * g4; o = o * (sc + 1.f) + sh;
            u32x2 pk; pk.x = pk2(o[0], o[1]); pk.y = pk2(o[2], o[3]); *(u32x2*)(h + (size_t)row * D + col) = pk; }
    }
}

__device__ __forceinline__ float wsum(float v) {
    v += dppmov<0xB1>(v); v += dppmov<0x4E>(v); v += dppmov<0x141>(v); v += dppmov<0x140>(v);
    const int iv = __float_as_int(v);
    return (__int_as_float(__builtin_amdgcn_readlane(iv, 0)) + __int_as_float(__builtin_amdgcn_readlane(iv, 16))) +
           (__int_as_float(__builtin_amdgcn_readlane(iv, 32)) + __int_as_float(__builtin_amdgcn_readlane(iv, 48)));
}
__device__ __forceinline__ bf16_t f2bf(float x) { return (bf16_t)(pk2(x, x) & 0xffffu); }
__device__ __forceinline__ bf16x8 ldsfrag(const LAS bf16_t* p) { return *(const LAS bf16x8*)p; }
#define MFMA16(a_, b_, c_) __builtin_amdgcn_mfma_f32_16x16x32_bf16(a_, b_, c_, 0, 0, 0)

__device__ __forceinline__ void scan_item(const Args& a, int layer, int item, LAS unsigned char* lds) {
    const int tid = otid(), lane = tid & 63, wv = __builtin_amdgcn_readfirstlane(tid >> 6), fr = lane & 15, fq = lane >> 4;
    const int b = item >> 5, h = (item >> 1) & 15, dir = item & 1;
    LAS float* N1t = (LAS float*)lds;
    LAS float* gC = N1t + 1152;
    LAS bf16_t* N1b = (LAS bf16_t*)(gC + 64);
    LAS bf16_t* T11r = N1b + 640;
    LAS bf16_t* Gt = T11r + 640;
    LAS bf16_t* At = Gt + 640;
    LAS bf16_t* Bn = At + 2304;
    LAS bf16_t* Kn = Bn + 2304;
    LAS bf16_t* Rt = Kn + 2304;
    LAS bf16_t* BpT = Rt + 2304;
    LAS bf16_t* KpT = BpT + 2560;
    LAS bf16_t* Vt = KpT + 2560;
    LAS bf16_t* M2t = Vt + 2560;
    LAS bf16_t* M3t = M2t + 1280;
    LAS bf16_t* M4t = M3t + 1280;
    LAS bf16_t* Tmt = M4t + 1280;
    LAS bf16_t* Xs = Tmt + 1280;
    LAS bf16_t* Us = Xs + 2560;
    LAS float* WPs = (LAS float*)(Us + 2560);
    LAS float* APs = WPs + 2176;
    LAS float* LD = APs + 2176;
    LAS bf16_t* W2T = (LAS bf16_t*)(LD + 2048);
    LAS bf16_t* A2T = W2T + 4608;
    LAS bf16_t* LWb = A2T + 4608;
    LAS bf16_t* LAb = LWb + 2304;
    LAS bf16_t* S0s = LAb + 2304;
    LAS bf16_t* RAW = S0s + 9216;
    LAS float* Ys = WPs;
    const bf16_t* P = (const bf16_t*)(a.ws + WS_P);
    float* ybuf = (float*)(a.ws + WS_Y);
    float* bonus = (float*)(a.ws + WS_BONUS);
    __syncthreads();
    {
        const float* w2 = a.rw_w2 + ((size_t)(layer * 2 + dir) * 64) * W + h * 64;
        const float* a2 = a.rw_a2 + ((size_t)(layer * 2 + dir) * 64) * W + h * 64;
        for (int i = tid; i < 4096; i += 512) { const int l = i >> 6, c = i & 63; W2T[c * 72 + l] = f2bf(w2[l * W + c]); A2T[c * 72 + l] = f2bf(a2[l * W + c]); }
        for (int i = tid; i < 4608; i += 512) ((LAS unsigned*)S0s)[i] = 0u;
    }
    const int ch = h * 64 + lane;
    const float mu_r = a.rw_mu[(layer * 3 + 0) * W + ch], mu_k = a.rw_mu[(layer * 3 + 1) * W + ch], mu_v = a.rw_mu[(layer * 3 + 2) * W + ch];
    const float w0 = a.rw_w0[(layer * 2 + dir) * W + ch], a0 = a.rw_a0[(layer * 2 + dir) * W + ch];
    const float kk_c = a.rw_k_k[layer * W + ch], ka_c = a.rw_k_a[layer * W + ch], rk_c = a.rw_r_k[layer * W + ch];
    f32x4 Sacc[2];
    Sacc[0] = (f32x4){0.f, 0.f, 0.f, 0.f}; Sacc[1] = (f32x4){0.f, 0.f, 0.f, 0.f};
    int cur = 0;
    const int tt = wv >> 2, it = wv & 3;
    const bf16x8 zfrag = (bf16x8){0, 0, 0, 0, 0, 0, 0, 0};
#define SBAR() do { asm volatile("s_waitcnt lgkmcnt(0)" ::: "memory"); __builtin_amdgcn_s_barrier(); asm volatile("" ::: "memory"); } while (0)
#define SCAN_LOAD(dst, gcx) do { const int g_ = (gcx) < 136 ? (gcx) : 135; const int sg_ = g_ >= 8; const int sl_ = sg_ ? T : LC; const int rb_ = b * TT + (sg_ ? LC : 0); const int ck_ = sg_ ? g_ - 8 : g_; \
        const int tlo_ = dir ? (sl_ - 32 * (ck_ + 1)) : 32 * ck_; \
        _Pragma("unroll") for (int k = 0; k < 3; ++k) { const int pc_ = tid + 512 * k; int row_ = pc_ >> 3; row_ = row_ < 170 ? row_ : 169; const int arr_ = row_ / 34, ri_ = row_ - arr_ * 34; \
            int tok_ = tlo_ - 1 + ri_; tok_ = tok_ < 0 ? 0 : (tok_ > sl_ - 1 ? sl_ - 1 : tok_); \
            const int col_ = (arr_ == 0) ? C_LW : ((arr_ == 1) ? C_LA : ((arr_ == 2 ? C_RR : (arr_ == 3 ? C_RK : C_RV)) + h * 64)); \
            dst[k] = *(const u32x4*)(P + (size_t)(rb_ + tok_) * NP + col_ + (pc_ & 7) * 8); } } while (0)
    u32x4 nr[3];
    SCAN_LOAD(nr, 0);
    SBAR();
    for (int gc = 0; gc < 136; ++gc) {
        {
            int lane_v = lane; asm volatile("" : "+v"(lane_v));
            const int lane = lane_v, fr = lane & 15, fq = lane >> 4, tid = (wv << 6) | lane;
            const int seg = gc >= 8; const int slen = seg ? T : LC; const int rowbase = b * TT + (seg ? LC : 0); const int ck = seg ? gc - 8 : gc;
            const int tlo = dir ? (slen - 32 * (ck + 1)) : 32 * ck;
#pragma unroll
            for (int k = 0; k < 3; ++k) { const int pc = tid + 512 * k; if (pc < 1360) *(LAS u32x4*)(RAW + pc * 8) = nr[k]; }
            SBAR();
            SCAN_LOAD(nr, gc + 1);
            if (gc > 0) {
                const int gp = gc - 1; const int sgp = gp >= 8; const int slp = sgp ? T : LC; const int rbp = b * TT + (sgp ? LC : 0); const int ckp = sgp ? gp - 8 : gp;
                const int p = tid >> 4, pi = ckp * 32 + p, t = dir ? (slp - 1 - pi) : pi;
                const f32x4 yv = *(const LAS f32x4*)(Ys + p * 68 + (tid & 15) * 4);
                *(f32x4*)(ybuf + ((size_t)dir * M + rbp + t) * W + h * 64 + (tid & 15) * 4) = yv;
            }
            float r_[4], kd_[4], kk_[4], av_[4], v_[4], ld_[4];
#pragma unroll
            for (int q = 0; q < 4; ++q) {
                const int p = wv * 4 + q, pi = ck * 32 + p, t = dir ? (slen - 1 - pi) : pi;
                const int ri = t - tlo + 1;
                const LAS bf16_t* rw = RAW + ri * 64 + lane;
                { const float x2 = __expf(2.f * bf2f(rw[0])); LWb[p * 72 + lane] = f2bf(1.f - 2.f / (1.f + x2)); } LAb[p * 72 + lane] = rw[34 * 64];
                const float r0 = bf2f(rw[68 * 64]), k0 = bf2f(rw[102 * 64]), v0 = bf2f(rw[136 * 64]);
                const float mp = (t > 0) ? 1.f : 0.f, mn = (t < slen - 1) ? 1.f : 0.f;
                const float rs = mp * bf2f(rw[67 * 64]) + mn * bf2f(rw[69 * 64]), ks = mp * bf2f(rw[101 * 64]) + mn * bf2f(rw[103 * 64]), vs = mp * bf2f(rw[135 * 64]) + mn * bf2f(rw[137 * 64]);
                r_[q] = r0 + mu_r * (0.5f * rs - r0); kd_[q] = k0 + mu_k * (0.5f * ks - k0); v_[q] = v0 + mu_v * (0.5f * vs - v0);
                const float kku = kd_[q] * kk_c; const float ss = wsum(kku * kku);
                kk_[q] = kku / fmaxf(sqrtf(ss), 1e-12f);
                asm volatile("" ::: "memory");
            }
            SBAR();
            {
                const LAS bf16_t* Aw = LWb + (tt * 16 + fr) * 72 + fq * 8; const LAS bf16_t* Bw = W2T + (it * 16 + fr) * 72 + fq * 8;
                const LAS bf16_t* Aa = LAb + (tt * 16 + fr) * 72 + fq * 8; const LAS bf16_t* Ba = A2T + (it * 16 + fr) * 72 + fq * 8;
                f32x4 cw = (f32x4){0.f, 0.f, 0.f, 0.f}, ca = (f32x4){0.f, 0.f, 0.f, 0.f};
                cw = MFMA16(ldsfrag(Aw), ldsfrag(Bw), cw); cw = MFMA16(ldsfrag(Aw + 32), ldsfrag(Bw + 32), cw);
                ca = MFMA16(ldsfrag(Aa), ldsfrag(Ba), ca); ca = MFMA16(ldsfrag(Aa + 32), ldsfrag(Ba + 32), ca);
#pragma unroll
                for (int rg = 0; rg < 4; ++rg) { WPs[(tt * 16 + fq * 4 + rg) * 68 + it * 16 + fr] = cw[rg]; APs[(tt * 16 + fq * 4 + rg) * 68 + it * 16 + fr] = ca[rg]; }
            }
            SBAR();
#pragma unroll
            for (int q = 0; q < 4; ++q) {
                const int p = wv * 4 + q, pi = ck * 32 + p, t = dir ? (slen - 1 - pi) : pi;
                const float wp = w0 + WPs[p * 68 + lane], ap = a0 + APs[p * 68 + lane];
                ld_[q] = -0.6065306597f / (1.f + __expf(-wp));
                av_[q] = 1.f / (1.f + __expf(-ap));
                kd_[q] = kd_[q] * (1.f + (av_[q] - 1.f) * ka_c);
                LD[p * 64 + lane] = ld_[q];
                const float bs = wsum(r_[q] * kd_[q] * rk_c);
                if (lane == 0) bonus[((size_t)dir * M + rowbase + t) * 16 + h] = bs;
            }
            SBAR();
            {
                float cprev = 0.f;
                for (int p2 = 0; p2 < wv * 4; ++p2) cprev += LD[p2 * 64 + lane];
                float ctot = cprev;
                for (int p2 = wv * 4; p2 < 32; ++p2) ctot += LD[p2 * 64 + lane];
                float cum = cprev;
#pragma unroll
                for (int q = 0; q < 4; ++q) {
                    const int p = wv * 4 + q;
                    cum += ld_[q];
                    const float eg = __expf(cum), egi = __expf(-cum), egm = __expf(cum - ld_[q]), egc = __expf(ctot - cum);
                    const float bq = kk_[q] * av_[q];
                    At[p * 72 + lane] = f2bf(-kk_[q] * egm); Bn[p * 72 + lane] = f2bf(bq * egi); Kn[p * 72 + lane] = f2bf(kd_[q] * egi); Rt[p * 72 + lane] = f2bf(r_[q] * eg);
                    BpT[lane * 40 + p] = f2bf(bq * egc); KpT[lane * 40 + p] = f2bf(kd_[q] * egc); Vt[lane * 40 + p] = f2bf(v_[q]);
                }
                if (wv == 0) gC[lane] = __expf(ctot);
            }
            SBAR();
#pragma unroll
            for (int k2 = 0; k2 < 2; ++k2) {
                const int tile = wv * 2 + k2, mi = tile >> 2, st = (tile >> 1) & 1, t2 = tile & 1;
                const LAS bf16_t* Ap = ((mi & 1) ? Kn : Bn) + (st * 16 + fr) * 72 + fq * 8;
                const LAS bf16_t* Bp = ((mi >> 1) ? Rt : At) + (t2 * 16 + fr) * 72 + fq * 8;
                f32x4 acc = (f32x4){0.f, 0.f, 0.f, 0.f};
                acc = MFMA16(ldsfrag(Ap), ldsfrag(Bp), acc); acc = MFMA16(ldsfrag(Ap + 32), ldsfrag(Bp + 32), acc);
                const int t = t2 * 16 + fr, s0 = st * 16 + fq * 4;
#pragma unroll
                for (int rg = 0; rg < 4; ++rg) { const int s = s0 + rg; const bool keep = (mi < 2) ? (s < t) : (s <= t); if (!keep) acc[rg] = 0.f; }
                if (mi == 0) { *(LAS f32x4*)(N1t + t * 36 + s0) = acc;
                    if (tile == 1) {
#pragma unroll
                        for (int rg = 0; rg < 4; ++rg) N1b[(fq * 4 + rg) * 40 + fr] = f2bf(acc[rg]); } }
                else { LAS bf16_t* Mp = (mi == 1 ? M2t : (mi == 2 ? M3t : M4t)) + t * 40 + s0; u32x2 o; o.x = pk2(acc[0], acc[1]); o.y = pk2(acc[2], acc[3]); *(LAS u32x2*)Mp = o; }
            }
            SBAR();
            const LAS bf16_t* S0c = S0s + cur * 4608;
            {
                const LAS bf16_t* Ap = At + (tt * 16 + fr) * 72 + fq * 8; const LAS bf16_t* Bp = S0c + (it * 16 + fr) * 72 + fq * 8;
                f32x4 acc = (f32x4){0.f, 0.f, 0.f, 0.f};
                acc = MFMA16(ldsfrag(Ap), ldsfrag(Bp), acc); acc = MFMA16(ldsfrag(Ap + 32), ldsfrag(Bp + 32), acc);
                acc = MFMA16(ldsfrag(M2t + (tt * 16 + fr) * 40 + fq * 8), ldsfrag(Vt + (it * 16 + fr) * 40 + fq * 8), acc);
                u32x2 o; o.x = pk2(acc[0], acc[1]); o.y = pk2(acc[2], acc[3]);
                *(LAS u32x2*)(Xs + (it * 16 + fr) * 40 + tt * 16 + fq * 4) = o;
            }
            if (wv == 0) {
                if (lane < 32) {
                    const int blk = lane >> 4, r = lane & 15;
                    float Tr[16];
#pragma unroll
                    for (int t = 0; t < 16; ++t) {
                        float acc = (r == t) ? 1.f : 0.f;
#pragma unroll
                        for (int s4 = 0; s4 < (t + 3) / 4; ++s4) { const f32x4 n4 = *(const LAS f32x4*)(N1t + (blk * 16 + t) * 36 + blk * 16 + s4 * 4);
#pragma unroll
                            for (int u = 0; u < 4; ++u) if (s4 * 4 + u < t) acc += Tr[s4 * 4 + u] * n4[u]; }
                        Tr[t] = acc;
                        if ((t & 3) == 3) asm volatile("" ::: "memory");
                    }
#pragma unroll
                    for (int t = 0; t < 16; ++t) { Tmt[(blk * 16 + t) * 40 + blk * 16 + r] = f2bf(Tr[t]); if (blk == 1) Tmt[t * 40 + 16 + r] = 0; }
                    if (blk == 0) {
#pragma unroll
                        for (int s2 = 0; s2 < 8; ++s2) *(LAS unsigned*)(T11r + r * 40 + s2 * 2) = pk2(Tr[2 * s2], Tr[2 * s2 + 1]);
                    }
                }
                lds_wait();
                {
                    const bf16x8 af = (fq < 2) ? ldsfrag(Tmt + (16 + fr) * 40 + 16 + fq * 8) : zfrag;
                    const bf16x8 bf = (fq < 2) ? ldsfrag(N1b + fr * 40 + fq * 8) : zfrag;
                    f32x4 g = (f32x4){0.f, 0.f, 0.f, 0.f};
                    g = MFMA16(af, bf, g);
#pragma unroll
                    for (int rg = 0; rg < 4; ++rg) Gt[(fq * 4 + rg) * 40 + fr] = f2bf(g[rg]);
                }
                lds_wait();
                {
                    const bf16x8 af = (fq < 2) ? ldsfrag(Gt + fr * 40 + fq * 8) : zfrag;
                    const bf16x8 bf = (fq < 2) ? ldsfrag(T11r + fr * 40 + fq * 8) : zfrag;
                    f32x4 g = (f32x4){0.f, 0.f, 0.f, 0.f};
                    g = MFMA16(af, bf, g);
#pragma unroll
                    for (int rg = 0; rg < 4; ++rg) Tmt[(16 + fq * 4 + rg) * 40 + fr] = f2bf(g[rg]);
                }
            }
            SBAR();
            {
                f32x4 acc = (f32x4){0.f, 0.f, 0.f, 0.f};
                acc = MFMA16(ldsfrag(Tmt + (tt * 16 + fr) * 40 + fq * 8), ldsfrag(Xs + (it * 16 + fr) * 40 + fq * 8), acc);
                u32x2 o; o.x = pk2(acc[0], acc[1]); o.y = pk2(acc[2], acc[3]);
                *(LAS u32x2*)(Us + (it * 16 + fr) * 40 + tt * 16 + fq * 4) = o;
            }
            SBAR();
            {
                const LAS bf16_t* Ap = S0c + (it * 16 + fr) * 72 + fq * 8; const LAS bf16_t* Bp = Rt + (tt * 16 + fr) * 72 + fq * 8;
                f32x4 acc = (f32x4){0.f, 0.f, 0.f, 0.f};
                acc = MFMA16(ldsfrag(Ap), ldsfrag(Bp), acc); acc = MFMA16(ldsfrag(Ap + 32), ldsfrag(Bp + 32), acc);
                const bf16x8 uf = ldsfrag(Us + (it * 16 + fr) * 40 + fq * 8), vf = ldsfrag(Vt + (it * 16 + fr) * 40 + fq * 8);
                acc = MFMA16(uf, ldsfrag(M3t + (tt * 16 + fr) * 40 + fq * 8), acc);
                acc = MFMA16(vf, ldsfrag(M4t + (tt * 16 + fr) * 40 + fq * 8), acc);
                *(LAS f32x4*)(Ys + (tt * 16 + fr) * 68 + it * 16 + fq * 4) = acc;
                LAS bf16_t* S0n = S0s + (cur ^ 1) * 4608;
#pragma unroll
                for (int k2 = 0; k2 < 2; ++k2) {
                    const int jt = tt * 2 + k2;
                    const f32x4 g4 = *(const LAS f32x4*)(gC + jt * 16 + fq * 4);
                    f32x4 s = Sacc[k2] * g4;
                    s = MFMA16(ldsfrag(BpT + (jt * 16 + fr) * 40 + fq * 8), uf, s);
                    s = MFMA16(ldsfrag(KpT + (jt * 16 + fr) * 40 + fq * 8), vf, s);
                    Sacc[k2] = s;
                    u32x2 o; o.x = pk2(s[0], s[1]); o.y = pk2(s[2], s[3]);
                    *(LAS u32x2*)(S0n + (it * 16 + fr) * 72 + jt * 16 + fq * 4) = o;
                }
            }
            cur ^= 1;
        }
    }
    SBAR();
    {
        const int p = tid >> 4, pi = 127 * 32 + p, t = dir ? (T - 1 - pi) : pi;
        const f32x4 yv = *(const LAS f32x4*)(Ys + p * 68 + (tid & 15) * 4);
        *(f32x4*)(ybuf + ((size_t)dir * M + b * TT + LC + t) * W + h * 64 + (tid & 15) * 4) = yv;
    }
#undef SCAN_LOAD
#undef SBAR
}


__device__ __forceinline__ int clampi(int v, int lo, int hi) { return v < lo ? lo : (v > hi ? hi : v); }

__device__ __forceinline__ void attn_unit(const Args& a, int layer, int unit, bool isctx, LAS unsigned char* lds) {
    const int tid = otid(), lane = tid & 63, wv = tid >> 6, fr = lane & 15, fq = lane >> 4;
    constexpr int VS = 840;
    LAS bf16_t* Vt = (LAS bf16_t*)lds;
    LAS float* rpbs = (LAS float*)(lds + 64 * VS * 2);
    const bf16_t* P = (const bf16_t*)(a.ws + WS_P);
    bf16_t* bna = (bf16_t*)(a.ws + WS_BB);
    int b, h, rp = 0, half = 0;
    if (!isctx) { b = unit >> 9; h = (unit >> 5) & 15; rp = unit & 31; } else { b = unit >> 5; h = (unit >> 1) & 15; half = unit & 1; }
    int r0a = 0, nloc = 0;
    if (!isctx) { r0a = clampi(2 * rp - 4, 0, 56); const int r0b = clampi(2 * rp - 3, 0, 56); nloc = (r0b + 8 - r0a) * 64; }
    __syncthreads();
    {
        const int nk8 = (nloc + 256) * 8;
        u32x4 vv[13];
#pragma unroll
        for (int i = 0; i < 13; ++i) { const int cidx = tid + i * 512; const int key = cidx >> 3, dc = cidx & 7;
            const int srow = (key < nloc) ? (b * TT + LC + r0a * 64 + key) : (b * TT + min(key - nloc, 255));
            if (cidx < nk8) vv[i] = *(const u32x4*)(P + (size_t)srow * NP + C_V + h * 64 + dc * 8); }
#pragma unroll
        for (int i = 0; i < 13; ++i) { const int cidx = tid + i * 512; const int key = cidx >> 3, dc = cidx & 7;
            const int dcol = (key < nloc) ? key : (576 + key - nloc);
            if (cidx < nk8) { const u32x4 v = vv[i]; LAS bf16_t* d = Vt + (dc * 8) * VS + dcol;
                d[0] = (bf16_t)(v.x & 0xffff); d[VS] = (bf16_t)(v.x >> 16); d[2 * VS] = (bf16_t)(v.y & 0xffff); d[3 * VS] = (bf16_t)(v.y >> 16);
                d[4 * VS] = (bf16_t)(v.z & 0xffff); d[5 * VS] = (bf16_t)(v.z >> 16); d[6 * VS] = (bf16_t)(v.w & 0xffff); d[7 * VS] = (bf16_t)(v.w >> 16); } }
    }
    if (!isctx) for (int i = tid; i < 465; i += 512) rpbs[i] = a.na_rpb[(size_t)(layer * 16 + h) * 465 + i];
    __syncthreads();

    int qtok, r = 0, qc = 0, cs = 0, r0 = 0;
    if (!isctx) { r = 2 * rp + (wv >> 2); const int g = wv & 3; qc = g * 16 + fr; cs = (g == 0) ? 0 : (g == 1 ? 8 : (g == 2 ? 24 : 32)); r0 = clampi(r - 4, 0, 56); qtok = b * TT + LC + r * 64 + qc; }
    else qtok = b * TT + half * 128 + wv * 16 + fr;
    bf16x8 qf[2];
    qf[0] = *(const bf16x8*)(P + (size_t)qtok * NP + C_Q + h * 64 + fq * 8);
    qf[1] = *(const bf16x8*)(P + (size_t)qtok * NP + C_Q + h * 64 + 32 + fq * 8);
    const int cstart = clampi(qc - 8, 0, 48);
    float mrun = -1e30f, lrun = 0.f;
    f32x4 o[4];
#pragma unroll
    for (int dt = 0; dt < 4; ++dt) o[dt] = (f32x4){0.f, 0.f, 0.f, 0.f};
    const int nblk = isctx ? 8 : 16;
#define ATT_KLOAD(dst, blkx) do { const int bx_ = (blkx) < nblk ? (blkx) : nblk - 1; const bool lc_ = (!isctx) && (bx_ < 8); \
        _Pragma("unroll") for (int ti = 0; ti < 2; ++ti) { const size_t ktok_ = lc_ ? (size_t)(b * TT + LC + (r0 + bx_) * 64 + cs + ti * 16 + fr) : (size_t)(b * TT + ((bx_ & 7) * 32) + ti * 16 + fr); \
            const bf16_t* kp_ = P + ktok_ * NP + C_K + h * 64 + fq * 8; dst[ti][0] = *(const bf16x8*)kp_; dst[ti][1] = *(const bf16x8*)(kp_ + 32); } } while (0)
    bf16x8 kf[2][2];
    ATT_KLOAD(kf, 0);
    for (int blk = 0; blk < nblk; ++blk) {
        const bool loc = (!isctx) && (blk < 8);
        const int gr = r0 + blk;
        bf16x8 kn[2][2];
        ATT_KLOAD(kn, blk + 1);
        f32x4 s[2];
#pragma unroll
        for (int ti = 0; ti < 2; ++ti) {
            f32x4 z = (f32x4){0.f, 0.f, 0.f, 0.f};
            z = __builtin_amdgcn_mfma_f32_16x16x32_bf16(kf[ti][0], qf[0], z, 0, 0, 0);
            s[ti] = __builtin_amdgcn_mfma_f32_16x16x32_bf16(kf[ti][1], qf[1], z, 0, 0, 0);
        }
        float sv[8];
        if (loc) {
            const LAS float* brow = rpbs + (gr - r + 7) * 31;
#pragma unroll
            for (int ti = 0; ti < 2; ++ti)
#pragma unroll
                for (int rg = 0; rg < 4; ++rg) { const int kc = cs + ti * 16 + fq * 4 + rg; const bool valid = (kc >= cstart) && (kc < cstart + 16);
                    const int co = clampi(kc - qc + 15, 0, 30); sv[ti * 4 + rg] = valid ? (s[ti][rg] * 0.125f + brow[co]) : -1e30f; }
        } else {
#pragma unroll
            for (int ti = 0; ti < 2; ++ti)
#pragma unroll
                for (int rg = 0; rg < 4; ++rg) sv[ti * 4 + rg] = s[ti][rg] * 0.125f;
        }
        float mx = fmaxf(fmaxf(fmaxf(sv[0], sv[1]), fmaxf(sv[2], sv[3])), fmaxf(fmaxf(sv[4], sv[5]), fmaxf(sv[6], sv[7])));
        mx = fmaxf(mx, __shfl_xor(mx, 16)); mx = fmaxf(mx, __shfl_xor(mx, 32));
        const float mnew = fmaxf(mrun, mx); const float alpha = __expf(mrun - mnew); mrun = mnew;
        float ps = 0.f; float pv[8];
#pragma unroll
        for (int i = 0; i < 8; ++i) { pv[i] = __expf(sv[i] - mnew); ps += pv[i]; }
        lrun = lrun * alpha + ps;
#pragma unroll
        for (int dt = 0; dt < 4; ++dt) o[dt] *= alpha;
        u32x4 pp; pp.x = pk2(pv[0], pv[1]); pp.y = pk2(pv[2], pv[3]); pp.z = pk2(pv[4], pv[5]); pp.w = pk2(pv[6], pv[7]);
        const bf16x8 pf = __builtin_bit_cast(bf16x8, pp);
        const int kbase = loc ? ((gr - r0a) * 64 + cs) : (576 + (blk & 7) * 32);
#pragma unroll
        for (int dt = 0; dt < 4; ++dt) { const LAS bf16_t* vp = Vt + (dt * 16 + fr) * VS + kbase + fq * 4;
            const u32x2 lo = *(const LAS u32x2*)vp, hi = *(const LAS u32x2*)(vp + 16);
            u32x4 vv; vv.x = lo.x; vv.y = lo.y; vv.z = hi.x; vv.w = hi.y;
            o[dt] = __builtin_amdgcn_mfma_f32_16x16x32_bf16(__builtin_bit_cast(bf16x8, vv), pf, o[dt], 0, 0, 0); }
#pragma unroll
        for (int ti = 0; ti < 2; ++ti) { kf[ti][0] = kn[ti][0]; kf[ti][1] = kn[ti][1]; }
    }
#undef ATT_KLOAD
    lrun += __shfl_xor(lrun, 16); lrun += __shfl_xor(lrun, 32);
    const float inv = 1.f / lrun;
#pragma unroll
    for (int dt = 0; dt < 4; ++dt) { const int dcol = h * 64 + dt * 16 + fq * 4;
        const u32x2 gt = *(const u32x2*)(P + (size_t)qtok * NP + C_NAG + dcol);
        u32x2 ov; ov.x = pk2(o[dt][0] * inv * siluf(bflo(gt.x)), o[dt][1] * inv * siluf(bfhi(gt.x))); ov.y = pk2(o[dt][2] * inv * siluf(bflo(gt.y)), o[dt][3] * inv * siluf(bfhi(gt.y)));
        *(u32x2*)(bna + (size_t)qtok * W + dcol) = ov; }
}

__device__ __forceinline__ void pool_unit(const Args& a, int unit) {
    const int tid = otid();
    const bf16_t* P = (const bf16_t*)(a.ws + WS_P);
    bf16_t* diff = (bf16_t*)(a.ws + WS_DIFF);
    const int cc = tid & 127, g = cc >> 5, hw = 1 << g;
    for (int pass = 0; pass < 8; ++pass) {
        const int row = unit * 32 + pass * 4 + (tid >> 7); const int b = row / TT, t = row % TT;
        int s0, slen, tl; if (t < LC) { s0 = b * TT; slen = LC; tl = t; } else { s0 = b * TT + LC; slen = T; tl = t - LC; }
        const int lo = max(tl - hw, 0), hi = min(tl + hw, slen);
        float sm[8];
#pragma unroll
        for (int j = 0; j < 8; ++j) sm[j] = 0.f;
        u32x4 wv4[16];
#pragma unroll
        for (int k = 0; k < 16; ++k) { const int sx = tl - hw + k; const bool ok = (k < 2 * hw) && (sx >= 0) && (sx < slen); const int sc = ok ? sx : tl;
            wv4[k] = *(const u32x4*)(P + (size_t)(s0 + sc) * NP + C_PU + cc * 8); }
#pragma unroll
        for (int k = 0; k < 16; ++k) { const int sx = tl - hw + k; const bool ok = (k < 2 * hw) && (sx >= 0) && (sx < slen); const float mk = ok ? 1.f : 0.f; const u32x4 v = wv4[k];
            sm[0] += mk * bflo(v.x); sm[1] += mk * bfhi(v.x); sm[2] += mk * bflo(v.y); sm[3] += mk * bfhi(v.y); sm[4] += mk * bflo(v.z); sm[5] += mk * bfhi(v.z); sm[6] += mk * bflo(v.w); sm[7] += mk * bfhi(v.w); }
        const float inv = 1.f / (float)(hi - lo);
        const u32x4 u = *(const u32x4*)(P + (size_t)row * NP + C_PU + cc * 8);
        u32x4 o; o.x = pk2(sm[0] * inv - bflo(u.x), sm[1] * inv - bfhi(u.x)); o.y = pk2(sm[2] * inv - bflo(u.y), sm[3] * inv - bfhi(u.y));
        o.z = pk2(sm[4] * inv - bflo(u.z), sm[5] * inv - bfhi(u.z)); o.w = pk2(sm[6] * inv - bflo(u.w), sm[7] * inv - bfhi(u.w));
        *(u32x4*)(diff + (size_t)row * W + cc * 8) = o;
    }
}

__device__ __forceinline__ void phase_mixers(const Args& a, int layer, LAS unsigned char* lds) {
    const int G = gridDim.x, bid = blockIdx.x;
    const int nsc = (G >= 192) ? 128 : 0;
    if (PH_MASK & 0x200) { const int sstep = nsc ? nsc : G; if (!nsc || bid < nsc) { for (int it = bid; it < 128; it += sstep) scan_item(a, layer, it, lds); } if (nsc && bid < nsc) return; }
    const int w = nsc ? bid - nsc : bid, nw = nsc ? G - nsc : G;
    const int n_lat = 2048, n_ctx = (layer == 0) ? 128 : 0, n_pool = 544;
    for (int u = w; u < n_lat + n_ctx + n_pool; u += nw) {
        if (u < n_lat) { if (PH_MASK & 0x400) attn_unit(a, layer, u, false, lds); }
        else if (u < n_lat + n_ctx) { if (PH_MASK & 0x400) attn_unit(a, layer, u - n_lat, true, lds); }
        else if (PH_MASK & 0x800) pool_unit(a, u - n_lat - n_ctx);
    }
}

__device__ __forceinline__ void phase_readout(const Args& a, int layer) {
    const int tid = otid(), lane = tid & 63, wv = tid >> 6;
    const int gw = blockIdx.x * 8 + wv, NGW = gridDim.x * 8;
    const bf16_t* P = (const bf16_t*)(a.ws + WS_P);
    const float* ybuf = (const float*)(a.ws + WS_Y);
    const float* bonus = (const float*)(a.ws + WS_BONUS);
    bf16_t* brw = (bf16_t*)(a.ws + WS_BB) + (size_t)2 * M * W;
    for (int it = gw; it < M * 16; it += NGW) {
        const int row = it >> 4, h = it & 15; const int b = row / TT, t = row % TT;
        if (layer == 1 && t < LC) continue;
        const int ch = h * 64 + lane;
        int tl, slen; if (t < LC) { tl = t; slen = LC; } else { tl = t - LC; slen = T; }
        const float y = ybuf[(size_t)row * W + ch] + ybuf[((size_t)M + row) * W + ch];
        const float mean = wave_sum(y) * (1.f / 64.f); const float dv = y - mean; const float var = wave_sum(dv * dv) * (1.f / 64.f);
        const float yn = dv * rsqrtf(var + 64e-5f) * a.rw_lnx_g[layer * W + ch] + a.rw_lnx_b[layer * W + ch];
        const bf16_t* pr = P + (size_t)row * NP;
        const float v0 = bf2f(pr[C_RV + ch]); float vs = 0.f;
        if (tl > 0) vs += bf2f(pr[C_RV + ch - NP]);
        if (tl < slen - 1) vs += bf2f(pr[C_RV + ch + NP]);
        const float v = v0 + a.rw_mu[(layer * 3 + 2) * W + ch] * (0.5f * vs - v0);
        const float bs = bonus[(size_t)row * 16 + h] + bonus[((size_t)M + row) * 16 + h];
        const float o = (yn + bs * v) * siluf(bf2f(pr[C_RG + ch]));
        const float o2 = __shfl_down(o, 1);
        if ((lane & 1) == 0) *(unsigned*)(brw + (size_t)row * W + ch) = pk2(o, o2);
    }
}

__device__ __forceinline__ void phase_final(const Args& a) {
    const int tid = otid(), lane = tid & 63, wv = tid >> 6;
    const int gw = blockIdx.x * 8 + wv, NGW = gridDim.x * 8;
    for (int row = gw; row < NB * T; row += NGW) {
        float* xr = a.out + (size_t)row * D;
        f32x4 v[8]; float ss = 0.f;
#pragma unroll
        for (int j = 0; j < 8; ++j) { v[j] = *(const f32x4*)(xr + 4 * lane + 256 * j); ss += (v[j][0] * v[j][0] + v[j][1] * v[j][1]) + (v[j][2] * v[j][2] + v[j][3] * v[j][3]); }
        ss = wave_sum(ss); const float rstd = rsqrtf(ss * (1.f / D) + 1e-6f);
#pragma unroll
        for (int j = 0; j < 8; ++j) { const int col = 4 * lane + 256 * j; const f32x4 g4 = *(const f32x4*)(a.final_g + col); *(f32x4*)(xr + col) = (v[j] * rstd) * g4; }
    }
}

__global__ void __launch_bounds__(512, 2) fwd_kernel(Args a) {
    extern __shared__ __attribute__((aligned(16))) unsigned char smem[];
    LAS unsigned char* lds = (LAS unsigned char*)smem;
    cg::grid_group grid = cg::this_grid();
    const int G = gridDim.x, c = blockIdx.x;
    for (int ph = a.ph_lo; ph < a.ph_hi; ++ph) {
        if (ph > a.ph_lo) grid.sync();
        if (ph == 0) { if (PH_MASK & 1) phase_mod(a, lds); continue; }
        if (ph == 13) { if (PH_MASK & 128) phase_final(a); continue; }
        const int layer = (ph - 1) / 6, sub = (ph - 1) % 6;
        int nrep = 1;
#ifdef REP_SUB
        if (sub == REP_SUB && ((REP_LAYERS >> layer) & 1)) nrep = 2;
#endif
        for (int rep = 0; rep < nrep; ++rep) {
        if (rep) grid.sync();
        bf16_t* P = (bf16_t*)(a.ws + WS_P);
        if (sub == 0) { if (PH_MASK & 2) phase_norm_convert(a, layer, lds); }
        else if (sub == 1) {
            Gemm g; g.A = (const bf16_t*)(a.ws + WS_H); g.Bt = (const bf16_t*)(a.ws + WS_WTIN); g.lda = D; g.ldb = D; g.K = D; g.a_z = 0; g.b_z = 0;
            g.nM = 68; g.nN = 65; g.nz = 1; g.latent_only = 0; g.G = G; g.c = c;
            EpiP e; e.P = P; if (PH_MASK & 4) gemm_phase(lds, g, e);
        } else if (sub == 2) { if (PH_MASK & 8) phase_mixers(a, layer, lds); }
        else if (sub == 3) {
            if (PH_MASK & 256) phase_readout(a, layer);
            Gemm g; g.A = (const bf16_t*)(a.ws + WS_DIFF); g.Bt = (const bf16_t*)(a.ws + WS_WTPL); g.lda = W; g.ldb = 256; g.K = 256; g.a_z = 256; g.b_z = 65536;
            g.nM = layer ? 64 : 68; g.nN = 1; g.nz = 4; g.latent_only = layer; g.G = G; g.c = c;
            EpiPool e; e.P = P; e.out = (bf16_t*)(a.ws + WS_BB) + (size_t)M * W; e.scale = a.pool_scale + layer * W; if (PH_MASK & 16) gemm_phase(lds, g, e);
        } else if (sub == 4) {
            Gemm g; g.A = (const bf16_t*)(a.ws + WS_BB); g.Bt = (const bf16_t*)(a.ws + WS_WTBR); g.lda = W; g.ldb = W; g.K = W; g.a_z = (size_t)M * W; g.b_z = (size_t)D * W;
            g.nM = layer ? 64 : 68; g.nN = 8; g.nz = 3; g.latent_only = layer; g.G = G; g.c = c;
            EpiMerge e; e.P = P; e.mf = (float*)(a.ws + WS_Y); e.mb = (bf16_t*)(a.ws + WS_H); if (PH_MASK & 32) gemm_phase(lds, g, e);
        } else {
            Gemm g; g.A = (const bf16_t*)(a.ws + WS_H); g.Bt = (const bf16_t*)(a.ws + WS_WTOUT); g.lda = D; g.ldb = D; g.K = D; g.a_z = 0; g.b_z = 0;
            g.nM = layer ? 64 : 68; g.nN = 8; g.nz = 1; g.latent_only = layer; g.G = G; g.c = c;
            EpiOut e; e.xl_old = layer ? (const float*)a.out : a.x; e.xc_old = layer ? (const float*)(a.ws + WS_XCTX) : a.ctx; e.xl_new = a.out; e.xc_new = (float*)(a.ws + WS_XCTX);
            e.mod = (const float*)(a.ws + WS_MOD) + layer * 5 * 6144; if (PH_MASK & 64) gemm_phase(lds, g, e);
        }
        }
    }
}

extern "C" void kernel_launch(void* const* d_in, const int* in_sizes, int n_in, void* d_out, int out_size, void* d_ws, size_t ws_size, hipStream_t stream) {
    static int grid = 0;
    if (grid == 0) {
        if (n_in != 24 || ws_size < WS_END) { fprintf(stderr, "kernel_launch: unexpected n_in %d or ws_size %zu (< %zu)\n", n_in, ws_size, (size_t)WS_END); grid = -1; return; }
        int dev = 0, cus = 0, per_cu = 0;
        hipGetDevice(&dev); hipDeviceGetAttribute(&cus, hipDeviceAttributeMultiprocessorCount, dev);
        if (hipFuncSetAttribute((const void*)fwd_kernel, hipFuncAttributeMaxDynamicSharedMemorySize, LDS_BYTES) != hipSuccess) { fprintf(stderr, "kernel_launch: hipFuncSetAttribute failed\n"); grid = -1; return; }
        hipOccupancyMaxActiveBlocksPerMultiprocessor(&per_cu, (const void*)fwd_kernel, 512, LDS_BYTES);
        if (per_cu < 1) { fprintf(stderr, "kernel_launch: occupancy query says %d\n", per_cu); per_cu = 1; }
        (void)hipGetLastError();
        grid = cus;
    }
    if (grid < 0) return;
    hipMemsetAsync((char*)d_ws + WS_MOD, 0, WS_MOD_BYTES, stream);
    Args a{};
    const float** pp = (const float**)&a;
    for (int i = 0; i < 24; ++i) pp[i] = (const float*)d_in[i];
    a.out = (float*)d_out; a.ws = (unsigned char*)d_ws;
#if N_LAUNCH_PER_PHASE
    for (int ph = 0; ph < NPHASE; ++ph) {
        a.ph_lo = ph; a.ph_hi = ph + 1;
        void* args[] = {&a};
        hipError_t e = hipLaunchCooperativeKernel((const void*)fwd_kernel, dim3(grid), dim3(512), args, LDS_BYTES, stream);
        if (e != hipSuccess) { fprintf(stderr, "cooperative launch failed: %s\n", hipGetErrorString(e)); break; }
    }
#else
    a.ph_lo = 0; a.ph_hi = NPHASE;
    void* args[] = {&a};
    hipError_t e = hipLaunchCooperativeKernel((const void*)fwd_kernel, dim3(grid), dim3(512), args, LDS_BYTES, stream);
    if (e != hipSuccess) fprintf(stderr, "cooperative launch failed: %s (grid %d)\n", hipGetErrorString(e), grid);
#endif
}
```

```cpp
#include <hip/hip_runtime.h>
#include <hip/hip_cooperative_groups.h>
#include <cstdio>
namespace cg = cooperative_groups;

#ifndef N_LAUNCH_PER_PHASE
#define N_LAUNCH_PER_PHASE 0
#endif

#ifndef REP_LAYERS
#define REP_LAYERS 3
#endif
#ifndef PH_MASK
#define PH_MASK 0xffff
#endif
#define LAS __attribute__((address_space(3)))
typedef unsigned short bf16_t;
typedef short bf16x8 __attribute__((ext_vector_type(8)));
typedef float f32x4 __attribute__((ext_vector_type(4)));
typedef unsigned u32x4 __attribute__((ext_vector_type(4)));
typedef unsigned u32x2 __attribute__((ext_vector_type(2)));

constexpr int D = 2048, NB = 4, T = 4096, LC = 256, TT = 4352, M = 17408, W = 1024, NP = 16640;
constexpr int C_Q = 0, C_K = 1024, C_V = 2048, C_NAG = 3072, C_PU = 4096, C_PG = 5120, C_RR = 6144, C_RK = 7168, C_RV = 8192, C_RG = 9216,
              C_MG = 10240, C_LW = 16384, C_LA = 16448;
constexpr int NPHASE = 14;
constexpr int LDS_BYTES = 163840;

constexpr size_t WS_MOD = 0, WS_MOD_BYTES = 262144;
constexpr size_t WS_BONUS = WS_MOD + WS_MOD_BYTES;
constexpr size_t WS_XCTX = WS_BONUS + 2359296;
constexpr size_t WS_WTIN = WS_XCTX + (size_t)NB * LC * D * 4;
constexpr size_t WS_WTBR = WS_WTIN + (size_t)NP * D * 2;
constexpr size_t WS_WTOUT = WS_WTBR + (size_t)3 * D * W * 2;
constexpr size_t WS_WTPL = WS_WTOUT + (size_t)D * D * 2;
constexpr size_t WS_H = WS_WTPL + (size_t)4 * 256 * 256 * 2;
constexpr size_t WS_Y = WS_H + (size_t)M * D * 2;
constexpr size_t WS_BB = WS_Y + (size_t)2 * M * W * 4;
constexpr size_t WS_DIFF = WS_BB + (size_t)3 * M * W * 2;
constexpr size_t WS_P = WS_DIFF + (size_t)M * W * 2;
constexpr size_t WS_END = WS_P + (size_t)M * NP * 2;

struct Args {
    const float *x, *c, *ctx, *c_ctx, *norm_g, *w_mod, *b_mod, *w_in, *na_rpb, *pool_w, *pool_scale, *rw_mu, *rw_w0, *rw_w2, *rw_a0, *rw_a2, *rw_k_k,
        *rw_k_a, *rw_r_k, *rw_lnx_g, *rw_lnx_b, *w_branch, *w_out, *final_g;
    float* out;
    unsigned char* ws;
    int ph_lo, ph_hi;
};

__device__ __forceinline__ float bf2f(bf16_t v) { return __uint_as_float(((unsigned)v) << 16); }
__device__ __forceinline__ float bflo(unsigned u) { return __uint_as_float(u << 16); }
__device__ __forceinline__ float bfhi(unsigned u) { return __uint_as_float(u & 0xffff0000u); }
typedef float f32x2 __attribute__((ext_vector_type(2)));
typedef __bf16 bf16x2_t __attribute__((ext_vector_type(2)));
__device__ __forceinline__ unsigned pk2(float lo, float hi) { const f32x2 v = {lo, hi}; const bf16x2_t b = __builtin_convertvector(v, bf16x2_t); return __builtin_bit_cast(unsigned, b); }
__device__ __forceinline__ float wave_sum(float v) {
#pragma unroll
    for (int o = 1; o < 64; o <<= 1) v += __shfl_xor(v, o);
    return v;
}
template <int CTRL> __device__ __forceinline__ float dppmov(float v) { return __int_as_float(__builtin_amdgcn_update_dpp(0, __float_as_int(v), CTRL, 0xF, 0xF, true)); }
__device__ __forceinline__ float sum8(float v) { v += dppmov<0xB1>(v); v += dppmov<0x4E>(v); v += dppmov<0x141>(v); return v; }
__device__ __forceinline__ float siluf(float x) { return x / (1.f + __expf(-x)); }
__device__ __forceinline__ float sigmf(float x) { return 1.f / (1.f + __expf(-x)); }
__device__ __forceinline__ int otid() { int t = threadIdx.x; asm volatile("" : "+v"(t)); return t; }
__device__ __forceinline__ void lds_wait() { asm volatile("s_waitcnt lgkmcnt(0)" ::: "memory"); }

constexpr int BM = 256, BK = 64, HALF = 128, HTB = HALF * BK * 2, NXCD = 8, WGM = 8;
__device__ __forceinline__ int lds_byte(int r, int c) { const int st = (r >> 4) * 2 + (c >> 5), rr = r & 15, cc = c & 31, ob = rr * 64 + cc * 2; return st * 1024 + (ob ^ (((ob >> 9) & 1) << 5)); }
__device__ __forceinline__ void stage_rc(int b, int& R, int& C) { const int st = b / 1024, sb = b % 1024, swz = sb ^ (((sb >> 9) & 1) << 5); R = (st >> 1) * 16 + swz / 64; C = (st & 1) * 32 + (swz % 64) / 2; }
__device__ __forceinline__ int perm32(int rho) { const int n = rho >> 4, i = rho & 15; return 8 * (i >> 2) + 4 * n + (i & 3); }

struct Unit { int pm, pn, z; };
struct Gemm {
    const bf16_t* A; const bf16_t* Bt; int lda, ldb, K; size_t a_z, b_z;
    int nM, nN, nz, latent_only, G, c;
    __device__ bool next(int i, Unit& u) const {
        const int zi = i % nz, r = i / nz; const long L = (long)r * G + c; const int nwg = nM * nN; if (L >= nwg) return false;
        int wgid = (int)L; { const int q = nwg / NXCD, rr = nwg % NXCD, xcd = wgid % NXCD, off = wgid / NXCD; wgid = (xcd < rr ? xcd * (q + 1) : rr * (q + 1) + (xcd - rr) * q) + off; }
        const int nig = WGM * nN, gid = wgid / nig, fm = gid * WGM, gsz = (nM - fm) < WGM ? (nM - fm) : WGM;
        int pm = fm + ((wgid % nig) % gsz); u.pn = (wgid % nig) / gsz; u.z = zi;
        u.pm = latent_only ? (pm / 16) * 17 + 1 + (pm % 16) : pm; return true;
    }
};

template <class Epi>
__device__ __forceinline__ void gemm_phase(LAS unsigned char* lds, const Gemm g, const Epi& E) {
    const int tid = otid(), wid = __builtin_amdgcn_readfirstlane(tid >> 6), lane = tid & 63, wr = wid >> 2, wc = wid & 3, fr = lane & 15, fq = lane >> 4;
    const int K = g.K, nt = K / BK;
    unsigned voffA[2], voffB[2];
#pragma unroll
    for (int i = 0; i < 2; ++i) { int R, C; stage_rc(tid * 16 + i * 8192, R, C); const int Rb = Epi::PERM ? ((R & ~31) + perm32(R & 31)) : R;
        voffA[i] = (unsigned)(R * g.lda + C) * 2u; voffB[i] = (unsigned)(Rb * g.ldb + C) * 2u; }
    const size_t kstep = (size_t)(BK * 2);
    const size_t hstepA = (size_t)HALF * g.lda * 2, hstepB = (size_t)HALF * g.ldb * 2;
    const unsigned ldsw = (unsigned)wid * 1024u;
    const int aoff = lds_byte(wr * 64 + fr, fq * 8), boff = lds_byte(wc * 32 + fr, fq * 8);
#define PG8_SA(b, h) (((b) * 2 + (h)) * HTB)
#define PG8_SB(b, h) ((4 + (b) * 2 + (h)) * HTB)
#define PG8_STAGE(bufoff, gbase, voff) do { _Pragma("unroll") for (int _i = 0; _i < 2; ++_i) \
        __builtin_amdgcn_global_load_lds((const unsigned*)((const char*)(gbase) + (voff)[_i]), (LAS unsigned*)(lds + (bufoff) + ldsw + _i * 8192), 16, 0, 0); } while (0)
#define PG8_LDA(dst, b, h) do { _Pragma("unroll") for (int m = 0; m < 4; ++m) _Pragma("unroll") for (int k = 0; k < 2; ++k) dst[m][k] = *(const LAS bf16x8*)(lds + PG8_SA(b, h) + aoff + m * 2048 + k * 1024); } while (0)
#define PG8_LDB(dst, b, h) do { _Pragma("unroll") for (int n = 0; n < 2; ++n) _Pragma("unroll") for (int k = 0; k < 2; ++k) dst[n][k] = *(const LAS bf16x8*)(lds + PG8_SB(b, h) + boff + n * 2048 + k * 1024); } while (0)
#define PG8_MMA(ai, bj, At, Bt) do { __builtin_amdgcn_s_setprio(1); _Pragma("unroll") for (int m = 0; m < 4; ++m) _Pragma("unroll") for (int n = 0; n < 2; ++n) _Pragma("unroll") for (int k = 0; k < 2; ++k) \
        acc[ai][bj][m][n] = __builtin_amdgcn_mfma_f32_16x16x32_bf16(Bt[n][k], At[m][k], acc[ai][bj][m][n], 0, 0, 0); __builtin_amdgcn_s_setprio(0); } while (0)
#define PG8_WAIT_V(n) asm volatile("s_waitcnt vmcnt(" #n ")" ::: "memory")
#define PG8_WAIT_L(n) asm volatile("s_waitcnt lgkmcnt(" #n ")" ::: "memory")
#define PG8_BAR __builtin_amdgcn_s_barrier()
#define PG8_SCHED __builtin_amdgcn_sched_barrier(0)
    Unit cur, nxt; int ui = 0;
    if (!g.next(0, cur)) return;
    f32x4 acc[2][2][4][2];
#pragma unroll
    for (int a = 0; a < 2; ++a)
#pragma unroll
        for (int b = 0; b < 2; ++b)
#pragma unroll
            for (int m = 0; m < 4; ++m)
#pragma unroll
                for (int n = 0; n < 2; ++n) acc[a][b][m][n] = (f32x4){0.f, 0.f, 0.f, 0.f};
    bf16x8 At[4][2], B0[2][2], B1[2][2];
    const char* cA = (const char*)(g.A + cur.z * g.a_z + (size_t)cur.pm * BM * g.lda); const char* cB = (const char*)(g.Bt + cur.z * g.b_z + (size_t)cur.pn * BM * g.ldb);
    PG8_STAGE(PG8_SB(0, 0), cB, voffB); PG8_STAGE(PG8_SA(0, 0), cA, voffA); PG8_STAGE(PG8_SB(0, 1), cB + hstepB, voffB); PG8_STAGE(PG8_SA(0, 1), cA + hstepA, voffA);
    if (wr == 1) PG8_BAR;
    PG8_WAIT_V(4); PG8_BAR;
    PG8_STAGE(PG8_SB(1, 0), cB + kstep, voffB); PG8_STAGE(PG8_SA(1, 0), cA + kstep, voffA); PG8_STAGE(PG8_SB(1, 1), cB + hstepB + kstep, voffB);
    PG8_WAIT_V(6); PG8_BAR;
    for (;;) {
        const bool has_next = g.next(ui + 1, nxt);
        const char* nA = has_next ? (const char*)(g.A + nxt.z * g.a_z + (size_t)nxt.pm * BM * g.lda) : cA;
        const char* nB = has_next ? (const char*)(g.Bt + nxt.z * g.b_z + (size_t)nxt.pn * BM * g.ldb) : cB;
        for (int t = 0; t < nt; t += 2) {
            const bool last = (t == nt - 2);
            const char* a1 = cA + (size_t)(t + 1) * kstep;
            const char* a2 = last ? nA : cA + (size_t)(t + 2) * kstep; const char* b2 = last ? nB : cB + (size_t)(t + 2) * kstep;
            const char* a3 = a2 + kstep; const char* b3 = b2 + kstep;
            PG8_LDB(B0, 0, 0); PG8_SCHED; PG8_LDA(At, 0, 0); PG8_STAGE(PG8_SA(1, 1), a1 + hstepA, voffA);
            PG8_WAIT_L(8); PG8_BAR; PG8_WAIT_L(0); PG8_MMA(0, 0, At, B0); PG8_BAR; PG8_SCHED;
            PG8_LDB(B1, 0, 1); PG8_STAGE(PG8_SB(0, 0), b2, voffB);
            PG8_BAR; PG8_WAIT_L(0); PG8_MMA(0, 1, At, B1); PG8_BAR;
            PG8_LDA(At, 0, 1); PG8_STAGE(PG8_SA(0, 0), a2, voffA);
            PG8_BAR; PG8_WAIT_L(0); PG8_MMA(1, 0, At, B0); PG8_BAR; PG8_SCHED;
            PG8_STAGE(PG8_SB(0, 1), b2 + hstepB, voffB);
            PG8_WAIT_V(6); PG8_BAR; PG8_MMA(1, 1, At, B1); PG8_BAR;
            PG8_LDB(B0, 1, 0); PG8_SCHED; PG8_LDA(At, 1, 0); PG8_STAGE(PG8_SA(0, 1), a2 + hstepA, voffA);
            PG8_WAIT_L(8); PG8_BAR; PG8_WAIT_L(0); PG8_MMA(0, 0, At, B0); PG8_BAR; PG8_SCHED;
            PG8_LDB(B1, 1, 1); PG8_STAGE(PG8_SB(1, 0), b3, voffB);
            PG8_BAR; PG8_WAIT_L(0); PG8_MMA(0, 1, At, B1); PG8_BAR;
            PG8_LDA(At, 1, 1); PG8_STAGE(PG8_SA(1, 0), a3, voffA);
            PG8_BAR; PG8_WAIT_L(0); PG8_MMA(1, 0, At, B0); PG8_BAR; PG8_SCHED;
            PG8_STAGE(PG8_SB(1, 1), b3 + hstepB, voffB);
            PG8_WAIT_V(6); PG8_BAR; PG8_MMA(1, 1, At, B1); PG8_BAR;
        }
        E(acc, cur, wr, wc, fr, fq);
        if (!has_next) break;
#pragma unroll
        for (int a = 0; a < 2; ++a)
#pragma unroll
            for (int b = 0; b < 2; ++b)
#pragma unroll
                for (int m = 0; m < 4; ++m)
#pragma unroll
                    for (int n = 0; n < 2; ++n) acc[a][b][m][n] = (f32x4){0.f, 0.f, 0.f, 0.f};
        cur = nxt; cA = nA; cB = nB; ++ui;
    }
    PG8_WAIT_V(0);
    if (wr == 0) PG8_BAR;
    PG8_BAR;
#undef PG8_SA
#undef PG8_SB
#undef PG8_STAGE
#undef PG8_LDA
#undef PG8_LDB
#undef PG8_MMA
#undef PG8_WAIT_V
#undef PG8_WAIT_L
#undef PG8_BAR
#undef PG8_SCHED
}

struct EpiP {
    static constexpr bool PERM = true;
    bf16_t* P;
    __device__ __forceinline__ void operator()(const f32x4 (&acc)[2][2][4][2], const Unit& u, int wr, int wc, int fr, int fq) const {
        const int row0 = u.pm * BM + wr * 64 + fr, col0 = u.pn * BM + wc * 32 + 8 * fq;
#pragma unroll
        for (int ai = 0; ai < 2; ++ai)
#pragma unroll
            for (int m = 0; m < 4; ++m) { bf16_t* rowp = P + (size_t)(row0 + ai * HALF + m * 16) * NP + col0;
#pragma unroll
                for (int bj = 0; bj < 2; ++bj) { const f32x4 v0 = acc[ai][bj][m][0], v1 = acc[ai][bj][m][1];
                    u32x4 o; o.x = pk2(v0[0], v0[1]); o.y = pk2(v0[2], v0[3]); o.z = pk2(v1[0], v1[1]); o.w = pk2(v1[2], v1[3]);
                    *(u32x4*)(rowp + bj * HALF) = o; } }
    }
};
struct EpiPool {
    static constexpr bool PERM = true;
    const bf16_t* P; bf16_t* out; const float* scale;
    __device__ __forceinline__ void operator()(const f32x4 (&acc)[2][2][4][2], const Unit& u, int wr, int wc, int fr, int fq) const {
        const int row0 = u.pm * BM + wr * 64 + fr, col0 = u.z * 256 + wc * 32 + 8 * fq;
#pragma unroll
        for (int ai = 0; ai < 2; ++ai)
#pragma unroll
            for (int m = 0; m < 4; ++m) { const size_t row = (size_t)(row0 + ai * HALF + m * 16);
#pragma unroll
                for (int bj = 0; bj < 2; ++bj) { const int col = col0 + bj * HALF; const f32x4 v0 = acc[ai][bj][m][0], v1 = acc[ai][bj][m][1];
                    const u32x4 gt = *(const u32x4*)(P + row * NP + C_PG + col);
                    const f32x4 s0 = *(const f32x4*)(scale + col), s1 = *(const f32x4*)(scale + col + 4);
                    u32x4 o;
                    o.x = pk2(v0[0] * s0[0] * siluf(bflo(gt.x)), v0[1] * s0[1] * siluf(bfhi(gt.x)));
                    o.y = pk2(v0[2] * s0[2] * siluf(bflo(gt.y)), v0[3] * s0[3] * siluf(bfhi(gt.y)));
                    o.z = pk2(v1[0] * s1[0] * siluf(bflo(gt.z)), v1[1] * s1[1] * siluf(bfhi(gt.z)));
                    o.w = pk2(v1[2] * s1[2] * siluf(bflo(gt.w)), v1[3] * s1[3] * siluf(bfhi(gt.w)));
                    *(u32x4*)(out + row * W + col) = o; } }
    }
};
struct EpiMerge {
    static constexpr bool PERM = false;
    const bf16_t* P; float* mf; bf16_t* mb;
    __device__ __forceinline__ void operator()(const f32x4 (&acc)[2][2][4][2], const Unit& u, int wr, int wc, int fr, int fq) const {
        const int row0 = u.pm * BM + wr * 64 + fr, col0 = u.pn * BM + wc * 32 + 4 * fq;
        const bool hasold = u.z > 0;
        f32x4 old[4]; u32x2 lg[4];
#define EM_LOAD(it_, old_, lg_) do { const size_t row_ = (size_t)(row0 + ((it_) >> 2) * HALF + ((it_) & 3) * 16); \
            _Pragma("unroll") for (int q_ = 0; q_ < 4; ++q_) { const int col_ = col0 + (q_ >> 1) * HALF + (q_ & 1) * 16; \
                lg_[q_] = *(const u32x2*)(P + row_ * NP + C_MG + u.z * D + col_); \
                old_[q_] = hasold ? *(const f32x4*)(mf + row_ * D + col_) : (f32x4){0.f, 0.f, 0.f, 0.f}; } } while (0)
        EM_LOAD(0, old, lg);
#pragma unroll
        for (int it = 0; it < 8; ++it) {
            f32x4 oldn[4]; u32x2 lgn[4];
            if (it < 7) EM_LOAD(it + 1, oldn, lgn);
            const int ai = it >> 2, m = it & 3; const size_t row = (size_t)(row0 + ai * HALF + m * 16);
#pragma unroll
            for (int q = 0; q < 4; ++q) { const int bj = q >> 1, n = q & 1; const int col = col0 + bj * HALF + n * 16; const f32x4 v = acc[ai][bj][m][n];
                f32x4 r; r[0] = v[0] * sigmf(bflo(lg[q].x)); r[1] = v[1] * sigmf(bfhi(lg[q].x)); r[2] = v[2] * sigmf(bflo(lg[q].y)); r[3] = v[3] * sigmf(bfhi(lg[q].y));
                r += old[q];
                if (u.z < 2) *(f32x4*)(mf + row * D + col) = r;
                else { u32x2 o; o.x = pk2(r[0], r[1]); o.y = pk2(r[2], r[3]); *(u32x2*)(mb + row * D + col) = o; } }
            if (it < 7) {
#pragma unroll
                for (int q = 0; q < 4; ++q) { old[q] = oldn[q]; lg[q] = lgn[q]; } }
        }
#undef EM_LOAD
    }
};
struct EpiOut {
    static constexpr bool PERM = false;
    const float* xl_old; const float* xc_old; float* xl_new; float* xc_new; const float* mod;
    __device__ __forceinline__ void operator()(const f32x4 (&acc)[2][2][4][2], const Unit& u, int wr, int wc, int fr, int fq) const {
        const int b = u.pm / 17, tl = u.pm % 17; const bool isc = (tl == 0);
        const float* xo = isc ? xc_old + (size_t)b * LC * D : xl_old + ((size_t)b * T + (tl - 1) * 256) * D;
        float* xn = isc ? xc_new + (size_t)b * LC * D : xl_new + ((size_t)b * T + (tl - 1) * 256) * D;
        const float* gp = mod + (isc ? 4 : b) * 6144 + 4096;
        const int row0 = wr * 64 + fr, col0 = u.pn * BM + wc * 32 + 4 * fq;
        f32x4 gt[4];
#pragma unroll
        for (int q = 0; q < 4; ++q) gt[q] = *(const f32x4*)(gp + col0 + (q >> 1) * HALF + (q & 1) * 16);
        f32x4 old[4];
#define EO_LOAD(it_, old_) do { const size_t off_ = (size_t)(row0 + ((it_) >> 2) * HALF + ((it_) & 3) * 16) * D + col0; \
            _Pragma("unroll") for (int q_ = 0; q_ < 4; ++q_) old_[q_] = *(const f32x4*)(xo + off_ + (q_ >> 1) * HALF + (q_ & 1) * 16); } while (0)
        EO_LOAD(0, old);
#pragma unroll
        for (int it = 0; it < 8; ++it) {
            f32x4 oldn[4];
            if (it < 7) EO_LOAD(it + 1, oldn);
            const int ai = it >> 2, m = it & 3; const size_t off = (size_t)(row0 + ai * HALF + m * 16) * D + col0;
#pragma unroll
            for (int q = 0; q < 4; ++q) *(f32x4*)(xn + off + (q >> 1) * HALF + (q & 1) * 16) = old[q] + gt[q] * acc[ai][q >> 1][m][q & 1];
            if (it < 7) {
#pragma unroll
                for (int q = 0; q < 4; ++q) old[q] = oldn[q]; }
        }
#undef EO_LOAD
    }
};

__device__ __forceinline__ void phase_mod(const Args& a, LAS unsigned char* lds) {
    const int tidm = otid();
    LAS float* s = (LAS float*)lds;
    float* modp = (float*)(a.ws + WS_MOD);
    for (int task = blockIdx.x; task < 192; task += gridDim.x) {
        const int l = task / 96, rem = task % 96, cb = rem >> 3, kc = rem & 7, k0 = kc * 256;
        __syncthreads();
        for (int i = tidm; i < 5 * 256; i += 512) { const int r = i >> 8, k = i & 255; const float c = (r < 4) ? a.c[r * D + k0 + k] : a.c_ctx[k0 + k]; s[i] = c / (1.f + expf(-c)); }
        __syncthreads();
        const int n = cb * 512 + tidm;
        const float* w = a.w_mod + (size_t)l * D * 6144 + (size_t)k0 * 6144 + n;
        float a0 = 0.f, a1 = 0.f, a2 = 0.f, a3 = 0.f, a4 = 0.f;
#pragma unroll 8
        for (int k = 0; k < 256; ++k) { const float wv = w[(size_t)k * 6144]; a0 += s[k] * wv; a1 += s[256 + k] * wv; a2 += s[512 + k] * wv; a3 += s[768 + k] * wv; a4 += s[1024 + k] * wv; }
        float* mo = modp + l * 5 * 6144 + n;
        const float bias = (kc == 0) ? a.b_mod[l * 6144 + n] : 0.f;
        atomicAdd(mo, a0 + bias); atomicAdd(mo + 6144, a1 + bias); atomicAdd(mo + 2 * 6144, a2 + bias); atomicAdd(mo + 3 * 6144, a3 + bias); atomicAdd(mo + 4 * 6144, a4 + bias);
    }
}

__device__ __forceinline__ void transpose_item(const float* Wsrc, int ldsrc, int k0, int nsrc0, bf16_t* dst, int ldd, LAS float* scr, int lane) {
    if (nsrc0 >= 0) {
#pragma unroll 8
        for (int i = 0; i < 32; ++i) { const int kk = 2 * i + (lane >> 5); scr[kk * 33 + (lane & 31)] = Wsrc[(size_t)(k0 + kk) * ldsrc + nsrc0 + (lane & 31)]; }
    } else {
#pragma unroll 8
        for (int i = 0; i < 32; ++i) { const int kk = 2 * i + (lane >> 5); scr[kk * 33 + (lane & 31)] = 0.f; }
    }
    lds_wait();
    const int c = lane & 7;
#pragma unroll
    for (int j = 0; j < 4; ++j) { const int n = (lane >> 3) + 8 * j; const LAS float* s = scr + (8 * c) * 33 + n;
        u32x4 o; o.x = pk2(s[0 * 33], s[1 * 33]); o.y = pk2(s[2 * 33], s[3 * 33]); o.z = pk2(s[4 * 33], s[5 * 33]); o.w = pk2(s[6 * 33], s[7 * 33]);
        *(u32x4*)(dst + (size_t)n * ldd + k0 + 8 * c) = o; }
    lds_wait();
}
__device__ __forceinline__ void phase_norm_convert(const Args& a, int layer, LAS unsigned char* lds) {
    const int tid = otid(), lane = tid & 63, wv = tid >> 6;
    const int gw = blockIdx.x * 8 + wv, NGW = gridDim.x * 8;
    {
        LAS float* scr = (LAS float*)(lds + wv * 8448);
        bf16_t* wtin = (bf16_t*)(a.ws + WS_WTIN); bf16_t* wtbr = (bf16_t*)(a.ws + WS_WTBR); bf16_t* wtout = (bf16_t*)(a.ws + WS_WTOUT); bf16_t* wtpl = (bf16_t*)(a.ws + WS_WTPL);
        constexpr int I_IN = 32 * 520, I_BR = 16 * 64, I_OUT = 32 * 64, I_PL = 4 * 8;
        constexpr int NIT = I_IN + 3 * I_BR + I_OUT + 4 * I_PL;
        for (int it = gw; it < NIT; it += NGW) {
            int r = it;
            if (r < I_IN) { const int kb = r / 520, nb = r % 520, n0 = nb * 32; const int ns = n0 < 10240 ? n0 : (n0 < 16384 ? n0 + 128 : (n0 < 16512 ? n0 - 6144 : -1));
                transpose_item(a.w_in + (size_t)layer * D * 16512, 16512, kb * 64, ns, wtin + (size_t)n0 * D, D, scr, lane); continue; }
            r -= I_IN;
            if (r < 3 * I_BR) { const int z = r / I_BR, q = r % I_BR, kb = q / 64, nb = q % 64;
                transpose_item(a.w_branch + ((size_t)layer * 3 + z) * W * D, D, kb * 64, nb * 32, wtbr + (size_t)z * D * W + (size_t)nb * 32 * W, W, scr, lane); continue; }
            r -= 3 * I_BR;
            if (r < I_OUT) { const int kb = r / 64, nb = r % 64;
                transpose_item(a.w_out + (size_t)layer * D * D, D, kb * 64, nb * 32, wtout + (size_t)nb * 32 * D, D, scr, lane); continue; }
            r -= I_OUT;
            { const int z = r / I_PL, q = r % I_PL, kb = q / 8, nb = q % 8;
                transpose_item(a.pool_w + ((size_t)layer * 4 + z) * 65536, 256, kb * 64, nb * 32, wtpl + (size_t)z * 65536 + (size_t)nb * 32 * 256, 256, scr, lane); }
        }
    }
    const float* ng = a.norm_g + layer * D;
    const float* mo = (const float*)(a.ws + WS_MOD) + layer * 5 * 6144;
    const float* xctx = (const float*)(a.ws + WS_XCTX);
    bf16_t* h = (bf16_t*)(a.ws + WS_H);
    for (int row = gw; row < M; row += NGW) {
        const int b = row / TT, t = row % TT; const float* xr; int mr;
        if (t < LC) { xr = (layer == 0 ? a.ctx : xctx) + (size_t)(b * LC + t) * D; mr = 4; }
        else { xr = (layer == 0 ? a.x : (const float*)a.out) + (size_t)(b * T + t - LC) * D; mr = b; }
        f32x4 v[8]; float ss = 0.f;
#pragma unroll
        for (int j = 0; j < 8; ++j) { v[j] = *(const f32x4*)(xr + 4 * lane + 256 * j); ss += (v[j][0] * v[j][0] + v[j][1] * v[j][1]) + (v[j][2] * v[j][2] + v[j][3] * v[j][3]); }
        ss = wave_sum(ss); const float rstd = rsqrtf(ss * (1.f / D) + 1e-6f);
        const float* mrow = mo + mr * 6144;
#pragma unroll
        for (int j = 0; j < 8; ++j) { const int col = 4 * lane + 256 * j; const f32x4 g4 = *(const f32x4*)(ng + col), sh = *(const f32x4*)(mrow + col), sc = *(const f32x4*)(mrow + 2048 + col);
            f32x4 o = (v[j] * rstd) * g4; o = o * (sc + 1.f) + sh;
            u32x2 pk; pk.x = pk2(o[0], o[1]); pk.y = pk2(o[2], o[3]); *(u32x2*)(h + (size_t)row * D + col) = pk; }
    }
}

__device__ __forceinline__ float wsum(float v) {
    v += dppmov<0xB1>(v); v += dppmov<0x4E>(v); v += dppmov<0x141>(v); v += dppmov<0x140>(v);
    const int iv = __float_as_int(v);
    return (__int_as_float(__builtin_amdgcn_readlane(iv, 0)) + __int_as_float(__builtin_amdgcn_readlane(iv, 16))) +
           (__int_as_float(__builtin_amdgcn_readlane(iv, 32)) + __int_as_float(__builtin_amdgcn_readlane(iv, 48)));
}
__device__ __forceinline__ bf16_t f2bf(float x) { return (bf16_t)(pk2(x, x) & 0xffffu); }
__device__ __forceinline__ bf16x8 ldsfrag(const LAS bf16_t* p) { return *(const LAS bf16x8*)p; }
#define MFMA16(a_, b_, c_) __builtin_amdgcn_mfma_f32_16x16x32_bf16(a_, b_, c_, 0, 0, 0)

__device__ __forceinline__ void scan_item(const Args& a, int layer, int item, LAS unsigned char* lds) {
    const int tid = otid(), lane = tid & 63, wv = __builtin_amdgcn_readfirstlane(tid >> 6), fr = lane & 15, fq = lane >> 4;
    const int b = item >> 5, h = (item >> 1) & 15, dir = item & 1;
    LAS float* N1t = (LAS float*)lds;
    LAS float* gC = N1t + 1152;
    LAS bf16_t* N1b = (LAS bf16_t*)(gC + 64);
    LAS bf16_t* T11r = N1b + 640;
    LAS bf16_t* Gt = T11r + 640;
    LAS bf16_t* At = Gt + 640;
    LAS bf16_t* Bn = At + 2304;
    LAS bf16_t* Kn = Bn + 2304;
    LAS bf16_t* Rt = Kn + 2304;
    LAS bf16_t* BpT = Rt + 2304;
    LAS bf16_t* KpT = BpT + 2560;
    LAS bf16_t* Vt = KpT + 2560;
    LAS bf16_t* M2t = Vt + 2560;
    LAS bf16_t* M3t = M2t + 1280;
    LAS bf16_t* M4t = M3t + 1280;
    LAS bf16_t* Tmt = M4t + 1280;
    LAS bf16_t* Xs = Tmt + 1280;
    LAS bf16_t* Us = Xs + 2560;
    LAS float* WPs = (LAS float*)(Us + 2560);
    LAS float* APs = WPs + 2176;
    LAS float* LD = APs + 2176;
    LAS bf16_t* W2T = (LAS bf16_t*)(LD + 2048);
    LAS bf16_t* A2T = W2T + 4608;
    LAS bf16_t* LWb = A2T + 4608;
    LAS bf16_t* LAb = LWb + 2304;
    LAS bf16_t* S0s = LAb + 2304;
    LAS bf16_t* RAW = S0s + 9216;
    LAS float* Ys = WPs;
    const bf16_t* P = (const bf16_t*)(a.ws + WS_P);
    float* ybuf = (float*)(a.ws + WS_Y);
    float* bonus = (float*)(a.ws + WS_BONUS);
    __syncthreads();
    {
        const float* w2 = a.rw_w2 + ((size_t)(layer * 2 + dir) * 64) * W + h * 64;
        const float* a2 = a.rw_a2 + ((size_t)(layer * 2 + dir) * 64) * W + h * 64;
        for (int i = tid; i < 4096; i += 512) { const int l = i >> 6, c = i & 63; W2T[c * 72 + l] = f2bf(w2[l * W + c]); A2T[c * 72 + l] = f2bf(a2[l * W + c]); }
        for (int i = tid; i < 4608; i += 512) ((LAS unsigned*)S0s)[i] = 0u;
    }
    const int ch = h * 64 + lane;
    const float mu_r = a.rw_mu[(layer * 3 + 0) * W + ch], mu_k = a.rw_mu[(layer * 3 + 1) * W + ch], mu_v = a.rw_mu[(layer * 3 + 2) * W + ch];
    const float w0 = a.rw_w0[(layer * 2 + dir) * W + ch], a0 = a.rw_a0[(layer * 2 + dir) * W + ch];
    const float kk_c = a.rw_k_k[layer * W + ch], ka_c = a.rw_k_a[layer * W + ch], rk_c = a.rw_r_k[layer * W + ch];
    f32x4 Sacc[2];
    Sacc[0] = (f32x4){0.f, 0.f, 0.f, 0.f}; Sacc[1] = (f32x4){0.f, 0.f, 0.f, 0.f};
    int cur = 0;
    const int tt = wv >> 2, it = wv & 3;
    const bf16x8 zfrag = (bf16x8){0, 0, 0, 0, 0, 0, 0, 0};
#define SBAR() do { asm volatile("s_waitcnt lgkmcnt(0)" ::: "memory"); __builtin_amdgcn_s_barrier(); asm volatile("" ::: "memory"); } while (0)
#define SCAN_LOAD(dst, gcx) do { const int g_ = (gcx) < 136 ? (gcx) : 135; const int sg_ = g_ >= 8; const int sl_ = sg_ ? T : LC; const int rb_ = b * TT + (sg_ ? LC : 0); const int ck_ = sg_ ? g_ - 8 : g_; \
        const int tlo_ = dir ? (sl_ - 32 * (ck_ + 1)) : 32 * ck_; \
        _Pragma("unroll") for (int k = 0; k < 3; ++k) { const int pc_ = tid + 512 * k; int row_ = pc_ >> 3; row_ = row_ < 170 ? row_ : 169; const int arr_ = row_ / 34, ri_ = row_ - arr_ * 34; \
            int tok_ = tlo_ - 1 + ri_; tok_ = tok_ < 0 ? 0 : (tok_ > sl_ - 1 ? sl_ - 1 : tok_); \
            const int col_ = (arr_ == 0) ? C_LW : ((arr_ == 1) ? C_LA : ((arr_ == 2 ? C_RR : (arr_ == 3 ? C_RK : C_RV)) + h * 64)); \
            dst[k] = *(const u32x4*)(P + (size_t)(rb_ + tok_) * NP + col_ + (pc_ & 7) * 8); } } while (0)
    u32x4 nr[3];
    SCAN_LOAD(nr, 0);
    SBAR();
    for (int gc = 0; gc < 136; ++gc) {
        {
            int lane_v = lane; asm volatile("" : "+v"(lane_v));
            const int lane = lane_v, fr = lane & 15, fq = lane >> 4, tid = (wv << 6) | lane;
            const int seg = gc >= 8; const int slen = seg ? T : LC; const int rowbase = b * TT + (seg ? LC : 0); const int ck = seg ? gc - 8 : gc;
            const int tlo = dir ? (slen - 32 * (ck + 1)) : 32 * ck;
#pragma unroll
            for (int k = 0; k < 3; ++k) { const int pc = tid + 512 * k; if (pc < 1360) *(LAS u32x4*)(RAW + pc * 8) = nr[k]; }
            SBAR();
            SCAN_LOAD(nr, gc + 1);
            if (gc > 0) {
                const int gp = gc - 1; const int sgp = gp >= 8; const int slp = sgp ? T : LC; const int rbp = b * TT + (sgp ? LC : 0); const int ckp = sgp ? gp - 8 : gp;
                const int p = tid >> 4, pi = ckp * 32 + p, t = dir ? (slp - 1 - pi) : pi;
                const f32x4 yv = *(const LAS f32x4*)(Ys + p * 68 + (tid & 15) * 4);
                *(f32x4*)(ybuf + ((size_t)dir * M + rbp + t) * W + h * 64 + (tid & 15) * 4) = yv;
            }
            float r_[4], kd_[4], kk_[4], av_[4], v_[4], ld_[4];
#pragma unroll
            for (int q = 0; q < 4; ++q) {
                const int p = wv * 4 + q, pi = ck * 32 + p, t = dir ? (slen - 1 - pi) : pi;
                const int ri = t - tlo + 1;
                const LAS bf16_t* rw = RAW + ri * 64 + lane;
                { const float x2 = __expf(2.f * bf2f(rw[0])); LWb[p * 72 + lane] = f2bf(1.f - 2.f / (1.f + x2)); } LAb[p * 72 + lane] = rw[34 * 64];
                const float r0 = bf2f(rw[68 * 64]), k0 = bf2f(rw[102 * 64]), v0 = bf2f(rw[136 * 64]);
                const float mp = (t > 0) ? 1.f : 0.f, mn = (t < slen - 1) ? 1.f : 0.f;
                const float rs = mp * bf2f(rw[67 * 64]) + mn * bf2f(rw[69 * 64]), ks = mp * bf2f(rw[101 * 64]) + mn * bf2f(rw[103 * 64]), vs = mp * bf2f(rw[135 * 64]) + mn * bf2f(rw[137 * 64]);
                r_[q] = r0 + mu_r * (0.5f * rs - r0); kd_[q] = k0 + mu_k * (0.5f * ks - k0); v_[q] = v0 + mu_v * (0.5f * vs - v0);
                const float kku = kd_[q] * kk_c; const float ss = wsum(kku * kku);
                kk_[q] = kku / fmaxf(sqrtf(ss), 1e-12f);
                asm volatile("" ::: "memory");
            }
            SBAR();
            {
                const LAS bf16_t* Aw = LWb + (tt * 16 + fr) * 72 + fq * 8; const LAS bf16_t* Bw = W2T + (it * 16 + fr) * 72 + fq * 8;
                const LAS bf16_t* Aa = LAb + (tt * 16 + fr) * 72 + fq * 8; const LAS bf16_t* Ba = A2T + (it * 16 + fr) * 72 + fq * 8;
                f32x4 cw = (f32x4){0.f, 0.f, 0.f, 0.f}, ca = (f32x4){0.f, 0.f, 0.f, 0.f};
                cw = MFMA16(ldsfrag(Aw), ldsfrag(Bw), cw); cw = MFMA16(ldsfrag(Aw + 32), ldsfrag(Bw + 32), cw);
                ca = MFMA16(ldsfrag(Aa), ldsfrag(Ba), ca); ca = MFMA16(ldsfrag(Aa + 32), ldsfrag(Ba + 32), ca);
#pragma unroll
                for (int rg = 0; rg < 4; ++rg) { WPs[(tt * 16 + fq * 4 + rg) * 68 + it * 16 + fr] = cw[rg]; APs[(tt * 16 + fq * 4 + rg) * 68 + it * 16 + fr] = ca[rg]; }
            }
            SBAR();
#pragma unroll
            for (int q = 0; q < 4; ++q) {
                const int p = wv * 4 + q, pi = ck * 32 + p, t = dir ? (slen - 1 - pi) : pi;
                const float wp = w0 + WPs[p * 68 + lane], ap = a0 + APs[p * 68 + lane];
                ld_[q] = -0.6065306597f / (1.f + __expf(-wp));
                av_[q] = 1.f / (1.f + __expf(-ap));
                kd_[q] = kd_[q] * (1.f + (av_[q] - 1.f) * ka_c);
                LD[p * 64 + lane] = ld_[q];
                const float bs = wsum(r_[q] * kd_[q] * rk_c);
                if (lane == 0) bonus[((size_t)dir * M + rowbase + t) * 16 + h] = bs;
            }
            SBAR();
            {
                float cprev = 0.f;
                for (int p2 = 0; p2 < wv * 4; ++p2) cprev += LD[p2 * 64 + lane];
                float ctot = cprev;
                for (int p2 = wv * 4; p2 < 32; ++p2) ctot += LD[p2 * 64 + lane];
                float cum = cprev;
#pragma unroll
                for (int q = 0; q < 4; ++q) {
                    const int p = wv * 4 + q;
                    cum += ld_[q];
                    const float eg = __expf(cum), egi = __expf(-cum), egm = __expf(cum - ld_[q]), egc = __expf(ctot - cum);
                    const float bq = kk_[q] * av_[q];
                    At[p * 72 + lane] = f2bf(-kk_[q] * egm); Bn[p * 72 + lane] = f2bf(bq * egi); Kn[p * 72 + lane] = f2bf(kd_[q] * egi); Rt[p * 72 + lane] = f2bf(r_[q] * eg);
                    BpT[lane * 40 + p] = f2bf(bq * egc); KpT[lane * 40 + p] = f2bf(kd_[q] * egc); Vt[lane * 40 + p] = f2bf(v_[q]);
                }
                if (wv == 0) gC[lane] = __expf(ctot);
            }
            SBAR();
#pragma unroll
            for (int k2 = 0; k2 < 2; ++k2) {
                const int tile = wv * 2 + k2, mi = tile >> 2, st = (tile >> 1) & 1, t2 = tile & 1;
                const LAS bf16_t* Ap = ((mi & 1) ? Kn : Bn) + (st * 16 + fr) * 72 + fq * 8;
                const LAS bf16_t* Bp = ((mi >> 1) ? Rt : At) + (t2 * 16 + fr) * 72 + fq * 8;
                f32x4 acc = (f32x4){0.f, 0.f, 0.f, 0.f};
                acc = MFMA16(ldsfrag(Ap), ldsfrag(Bp), acc); acc = MFMA16(ldsfrag(Ap + 32), ldsfrag(Bp + 32), acc);
                const int t = t2 * 16 + fr, s0 = st * 16 + fq * 4;
#pragma unroll
                for (int rg = 0; rg < 4; ++rg) { const int s = s0 + rg; const bool keep = (mi < 2) ? (s < t) : (s <= t); if (!keep) acc[rg] = 0.f; }
                if (mi == 0) { *(LAS f32x4*)(N1t + t * 36 + s0) = acc;
                    if (tile == 1) {
#pragma unroll
                        for (int rg = 0; rg < 4; ++rg) N1b[(fq * 4 + rg) * 40 + fr] = f2bf(acc[rg]); } }
                else { LAS bf16_t* Mp = (mi == 1 ? M2t : (mi == 2 ? M3t : M4t)) + t * 40 + s0; u32x2 o; o.x = pk2(acc[0], acc[1]); o.y = pk2(acc[2], acc[3]); *(LAS u32x2*)Mp = o; }
            }
            SBAR();
            const LAS bf16_t* S0c = S0s + cur * 4608;
            {
                const LAS bf16_t* Ap = At + (tt * 16 + fr) * 72 + fq * 8; const LAS bf16_t* Bp = S0c + (it * 16 + fr) * 72 + fq * 8;
                f32x4 acc = (f32x4){0.f, 0.f, 0.f, 0.f};
                acc = MFMA16(ldsfrag(Ap), ldsfrag(Bp), acc); acc = MFMA16(ldsfrag(Ap + 32), ldsfrag(Bp + 32), acc);
                acc = MFMA16(ldsfrag(M2t + (tt * 16 + fr) * 40 + fq * 8), ldsfrag(Vt + (it * 16 + fr) * 40 + fq * 8), acc);
                u32x2 o; o.x = pk2(acc[0], acc[1]); o.y = pk2(acc[2], acc[3]);
                *(LAS u32x2*)(Xs + (it * 16 + fr) * 40 + tt * 16 + fq * 4) = o;
            }
            if (wv == 0) {
                if (lane < 32) {
                    const int blk = lane >> 4, r = lane & 15;
                    float Tr[16];
#pragma unroll
                    for (int t = 0; t < 16; ++t) {
                        float acc = (r == t) ? 1.f : 0.f;
#pragma unroll
                        for (int s4 = 0; s4 < (t + 3) / 4; ++s4) { const f32x4 n4 = *(const LAS f32x4*)(N1t + (blk * 16 + t) * 36 + blk * 16 + s4 * 4);
#pragma unroll
                            for (int u = 0; u < 4; ++u) if (s4 * 4 + u < t) acc += Tr[s4 * 4 + u] * n4[u]; }
                        Tr[t] = acc;
                        if ((t & 3) == 3) asm volatile("" ::: "memory");
                    }
#pragma unroll
                    for (int t = 0; t < 16; ++t) { Tmt[(blk * 16 + t) * 40 + blk * 16 + r] = f2bf(Tr[t]); if (blk == 1) Tmt[t * 40 + 16 + r] = 0; }
                    if (blk == 0) {
#pragma unroll
                        for (int s2 = 0; s2 < 8; ++s2) *(LAS unsigned*)(T11r + r * 40 + s2 * 2) = pk2(Tr[2 * s2], Tr[2 * s2 + 1]);
                    }
                }
                lds_wait();
                {
                    const bf16x8 af = (fq < 2) ? ldsfrag(Tmt + (16 + fr) * 40 + 16 + fq * 8) : zfrag;
                    const bf16x8 bf = (fq < 2) ? ldsfrag(N1b + fr * 40 + fq * 8) : zfrag;
                    f32x4 g = (f32x4){0.f, 0.f, 0.f, 0.f};
                    g = MFMA16(af, bf, g);
#pragma unroll
                    for (int rg = 0; rg < 4; ++rg) Gt[(fq * 4 + rg) * 40 + fr] = f2bf(g[rg]);
                }
                lds_wait();
                {
                    const bf16x8 af = (fq < 2) ? ldsfrag(Gt + fr * 40 + fq * 8) : zfrag;
                    const bf16x8 bf = (fq < 2) ? ldsfrag(T11r + fr * 40 + fq * 8) : zfrag;
                    f32x4 g = (f32x4){0.f, 0.f, 0.f, 0.f};
                    g = MFMA16(af, bf, g);
#pragma unroll
                    for (int rg = 0; rg < 4; ++rg) Tmt[(16 + fq * 4 + rg) * 40 + fr] = f2bf(g[rg]);
                }
            }
            SBAR();
            {
                f32x4 acc = (f32x4){0.f, 0.f, 0.f, 0.f};
                acc = MFMA16(ldsfrag(Tmt + (tt * 16 + fr) * 40 + fq * 8), ldsfrag(Xs + (it * 16 + fr) * 40 + fq * 8), acc);
                u32x2 o; o.x = pk2(acc[0], acc[1]); o.y = pk2(acc[2], acc[3]);
                *(LAS u32x2*)(Us + (it * 16 + fr) * 40 + tt * 16 + fq * 4) = o;
            }
            SBAR();
            {
                const LAS bf16_t* Ap = S0c + (it * 16 + fr) * 72 + fq * 8; const LAS bf16_t* Bp = Rt + (tt * 16 + fr) * 72 + fq * 8;
                f32x4 acc = (f32x4){0.f, 0.f, 0.f, 0.f};
                acc = MFMA16(ldsfrag(Ap), ldsfrag(Bp), acc); acc = MFMA16(ldsfrag(Ap + 32), ldsfrag(Bp + 32), acc);
                const bf16x8 uf = ldsfrag(Us + (it * 16 + fr) * 40 + fq * 8), vf = ldsfrag(Vt + (it * 16 + fr) * 40 + fq * 8);
                acc = MFMA16(uf, ldsfrag(M3t + (tt * 16 + fr) * 40 + fq * 8), acc);
                acc = MFMA16(vf, ldsfrag(M4t + (tt * 16 + fr) * 40 + fq * 8), acc);
                *(LAS f32x4*)(Ys + (tt * 16 + fr) * 68 + it * 16 + fq * 4) = acc;
                LAS bf16_t* S0n = S0s + (cur ^ 1) * 4608;
#pragma unroll
                for (int k2 = 0; k2 < 2; ++k2) {
                    const int jt = tt * 2 + k2;
                    const f32x4 g4 = *(const LAS f32x4*)(gC + jt * 16 + fq * 4);
                    f32x4 s = Sacc[k2] * g4;
                    s = MFMA16(ldsfrag(BpT + (jt * 16 + fr) * 40 + fq * 8), uf, s);
                    s = MFMA16(ldsfrag(KpT + (jt * 16 + fr) * 40 + fq * 8), vf, s);
                    Sacc[k2] = s;
                    u32x2 o; o.x = pk2(s[0], s[1]); o.y = pk2(s[2], s[3]);
                    *(LAS u32x2*)(S0n + (it * 16 + fr) * 72 + jt * 16 + fq * 4) = o;
                }
            }
            cur ^= 1;
        }
    }
    SBAR();
    {
        const int p = tid >> 4, pi = 127 * 32 + p, t = dir ? (T - 1 - pi) : pi;
        const f32x4 yv = *(const LAS f32x4*)(Ys + p * 68 + (tid & 15) * 4);
        *(f32x4*)(ybuf + ((size_t)dir * M + b * TT + LC + t) * W + h * 64 + (tid & 15) * 4) = yv;
    }
#undef SCAN_LOAD
#undef SBAR
}


__device__ __forceinline__ int clampi(int v, int lo, int hi) { return v < lo ? lo : (v > hi ? hi : v); }

__device__ __forceinline__ void attn_unit(const Args& a, int layer, int unit, bool isctx, LAS unsigned char* lds) {
    const int tid = otid(), lane = tid & 63, wv = tid >> 6, fr = lane & 15, fq = lane >> 4;
    constexpr int VS = 840;
    LAS bf16_t* Vt = (LAS bf16_t*)lds;
    LAS float* rpbs = (LAS float*)(lds + 64 * VS * 2);
    const bf16_t* P = (const bf16_t*)(a.ws + WS_P);
    bf16_t* bna = (bf16_t*)(a.ws + WS_BB);
    int b, h, rp = 0, half = 0;
    if (!isctx) { b = unit >> 9; h = (unit >> 5) & 15; rp = unit & 31; } else { b = unit >> 5; h = (unit >> 1) & 15; half = unit & 1; }
    int r0a = 0, nloc = 0;
    if (!isctx) { r0a = clampi(2 * rp - 4, 0, 56); const int r0b = clampi(2 * rp - 3, 0, 56); nloc = (r0b + 8 - r0a) * 64; }
    __syncthreads();
    {
        const int nk8 = (nloc + 256) * 8;
        u32x4 vv[13];
#pragma unroll
        for (int i = 0; i < 13; ++i) { const int cidx = tid + i * 512; const int key = cidx >> 3, dc = cidx & 7;
            const int srow = (key < nloc) ? (b * TT + LC + r0a * 64 + key) : (b * TT + min(key - nloc, 255));
            if (cidx < nk8) vv[i] = *(const u32x4*)(P + (size_t)srow * NP + C_V + h * 64 + dc * 8); }
#pragma unroll
        for (int i = 0; i < 13; ++i) { const int cidx = tid + i * 512; const int key = cidx >> 3, dc = cidx & 7;
            const int dcol = (key < nloc) ? key : (576 + key - nloc);
            if (cidx < nk8) { const u32x4 v = vv[i]; LAS bf16_t* d = Vt + (dc * 8) * VS + dcol;
                d[0] = (bf16_t)(v.x & 0xffff); d[VS] = (bf16_t)(v.x >> 16); d[2 * VS] = (bf16_t)(v.y & 0xffff); d[3 * VS] = (bf16_t)(v.y >> 16);
                d[4 * VS] = (bf16_t)(v.z & 0xffff); d[5 * VS] = (bf16_t)(v.z >> 16); d[6 * VS] = (bf16_t)(v.w & 0xffff); d[7 * VS] = (bf16_t)(v.w >> 16); } }
    }
    if (!isctx) for (int i = tid; i < 465; i += 512) rpbs[i] = a.na_rpb[(size_t)(layer * 16 + h) * 465 + i];
    __syncthreads();

    int qtok, r = 0, qc = 0, cs = 0, r0 = 0;
    if (!isctx) { r = 2 * rp + (wv >> 2); const int g = wv & 3; qc = g * 16 + fr; cs = (g == 0) ? 0 : (g == 1 ? 8 : (g == 2 ? 24 : 32)); r0 = clampi(r - 4, 0, 56); qtok = b * TT + LC + r * 64 + qc; }
    else qtok = b * TT + half * 128 + wv * 16 + fr;
    bf16x8 qf[2];
    qf[0] = *(const bf16x8*)(P + (size_t)qtok * NP + C_Q + h * 64 + fq * 8);
    qf[1] = *(const bf16x8*)(P + (size_t)qtok * NP + C_Q + h * 64 + 32 + fq * 8);
    const int cstart = clampi(qc - 8, 0, 48);
    float mrun = -1e30f, lrun = 0.f;
    f32x4 o[4];
#pragma unroll
    for (int dt = 0; dt < 4; ++dt) o[dt] = (f32x4){0.f, 0.f, 0.f, 0.f};
    const int nblk = isctx ? 8 : 16;
#define ATT_KLOAD(dst, blkx) do { const int bx_ = (blkx) < nblk ? (blkx) : nblk - 1; const bool lc_ = (!isctx) && (bx_ < 8); \
        _Pragma("unroll") for (int ti = 0; ti < 2; ++ti) { const size_t ktok_ = lc_ ? (size_t)(b * TT + LC + (r0 + bx_) * 64 + cs + ti * 16 + fr) : (size_t)(b * TT + ((bx_ & 7) * 32) + ti * 16 + fr); \
            const bf16_t* kp_ = P + ktok_ * NP + C_K + h * 64 + fq * 8; dst[ti][0] = *(const bf16x8*)kp_; dst[ti][1] = *(const bf16x8*)(kp_ + 32); } } while (0)
    bf16x8 kf[2][2];
    ATT_KLOAD(kf, 0);
    for (int blk = 0; blk < nblk; ++blk) {
        const bool loc = (!isctx) && (blk < 8);
        const int gr = r0 + blk;
        bf16x8 kn[2][2];
        ATT_KLOAD(kn, blk + 1);
        f32x4 s[2];
#pragma unroll
        for (int ti = 0; ti < 2; ++ti) {
            f32x4 z = (f32x4){0.f, 0.f, 0.f, 0.f};
            z = __builtin_amdgcn_mfma_f32_16x16x32_bf16(kf[ti][0], qf[0], z, 0, 0, 0);
            s[ti] = __builtin_amdgcn_mfma_f32_16x16x32_bf16(kf[ti][1], qf[1], z, 0, 0, 0);
        }
        float sv[8];
        if (loc) {
            const LAS float* brow = rpbs + (gr - r + 7) * 31;
#pragma unroll
            for (int ti = 0; ti < 2; ++ti)
#pragma unroll
                for (int rg = 0; rg < 4; ++rg) { const int kc = cs + ti * 16 + fq * 4 + rg; const bool valid = (kc >= cstart) && (kc < cstart + 16);
                    const int co = clampi(kc - qc + 15, 0, 30); sv[ti * 4 + rg] = valid ? (s[ti][rg] * 0.125f + brow[co]) : -1e30f; }
        } else {
#pragma unroll
            for (int ti = 0; ti < 2; ++ti)
#pragma unroll
                for (int rg = 0; rg < 4; ++rg) sv[ti * 4 + rg] = s[ti][rg] * 0.125f;
        }
        float mx = fmaxf(fmaxf(fmaxf(sv[0], sv[1]), fmaxf(sv[2], sv[3])), fmaxf(fmaxf(sv[4], sv[5]), fmaxf(sv[6], sv[7])));
        mx = fmaxf(mx, __shfl_xor(mx, 16)); mx = fmaxf(mx, __shfl_xor(mx, 32));
        const float mnew = fmaxf(mrun, mx); const float alpha = __expf(mrun - mnew); mrun = mnew;
        float ps = 0.f; float pv[8];
#pragma unroll
        for (int i = 0; i < 8; ++i) { pv[i] = __expf(sv[i] - mnew); ps += pv[i]; }
        lrun = lrun * alpha + ps;
#pragma unroll
        for (int dt = 0; dt < 4; ++dt) o[dt] *= alpha;
        u32x4 pp; pp.x = pk2(pv[0], pv[1]); pp.y = pk2(pv[2], pv[3]); pp.z = pk2(pv[4], pv[5]); pp.w = pk2(pv[6], pv[7]);
        const bf16x8 pf = __builtin_bit_cast(bf16x8, pp);
        const int kbase = loc ? ((gr - r0a) * 64 + cs) : (576 + (blk & 7) * 32);
#pragma unroll
        for (int dt = 0; dt < 4; ++dt) { const LAS bf16_t* vp = Vt + (dt * 16 + fr) * VS + kbase + fq * 4;
            const u32x2 lo = *(const LAS u32x2*)vp, hi = *(const LAS u32x2*)(vp + 16);
            u32x4 vv; vv.x = lo.x; vv.y = lo.y; vv.z = hi.x; vv.w = hi.y;
            o[dt] = __builtin_amdgcn_mfma_f32_16x16x32_bf16(__builtin_bit_cast(bf16x8, vv), pf, o[dt], 0, 0, 0); }
#pragma unroll
        for (int ti = 0; ti < 2; ++ti) { kf[ti][0] = kn[ti][0]; kf[ti][1] = kn[ti][1]; }
    }
#undef ATT_KLOAD
    lrun += __shfl_xor(lrun, 16); lrun += __shfl_xor(lrun, 32);
    const float inv = 1.f / lrun;
#pragma unroll
    for (int dt = 0; dt < 4; ++dt) { const int dcol = h * 64 + dt * 16 + fq * 4;
        const u32x2 gt = *(const u32x2*)(P + (size_t)qtok * NP + C_NAG + dcol);
        u32x2 ov; ov.x = pk2(o[dt][0] * inv * siluf(bflo(gt.x)), o[dt][1] * inv * siluf(bfhi(gt.x))); ov.y = pk2(o[dt][2] * inv * siluf(bflo(gt.y)), o[dt][3] * inv * siluf(bfhi(gt.y)));
        *(u32x2*)(bna + (size_t)qtok * W + dcol) = ov; }
}

__device__ __forceinline__ void pool_unit(const Args& a, int unit) {
    const int tid = otid();
    const bf16_t* P = (const bf16_t*)(a.ws + WS_P);
    bf16_t* diff = (bf16_t*)(a.ws + WS_DIFF);
    const int cc = tid & 127, g = cc >> 5, hw = 1 << g;
    for (int pass = 0; pass < 8; ++pass) {
        const int row = unit * 32 + pass * 4 + (tid >> 7); const int b = row / TT, t = row % TT;
        int s0, slen, tl; if (t < LC) { s0 = b * TT; slen = LC; tl = t; } else { s0 = b * TT + LC; slen = T; tl = t - LC; }
        const int lo = max(tl - hw, 0), hi = min(tl + hw, slen);
        float sm[8];
#pragma unroll
        for (int j = 0; j < 8; ++j) sm[j] = 0.f;
        u32x4 wv4[16];
#pragma unroll
        for (int k = 0; k < 16; ++k) { const int sx = tl - hw + k; const bool ok = (k < 2 * hw) && (sx >= 0) && (sx < slen); const int sc = ok ? sx : tl;
            wv4[k] = *(const u32x4*)(P + (size_t)(s0 + sc) * NP + C_PU + cc * 8); }
#pragma unroll
        for (int k = 0; k < 16; ++k) { const int sx = tl - hw + k; const bool ok = (k < 2 * hw) && (sx >= 0) && (sx < slen); const float mk = ok ? 1.f : 0.f; const u32x4 v = wv4[k];
            sm[0] += mk * bflo(v.x); sm[1] += mk * bfhi(v.x); sm[2] += mk * bflo(v.y); sm[3] += mk * bfhi(v.y); sm[4] += mk * bflo(v.z); sm[5] += mk * bfhi(v.z); sm[6] += mk * bflo(v.w); sm[7] += mk * bfhi(v.w); }
        const float inv = 1.f / (float)(hi - lo);
        const u32x4 u = *(const u32x4*)(P + (size_t)row * NP + C_PU + cc * 8);
        u32x4 o; o.x = pk2(sm[0] * inv - bflo(u.x), sm[1] * inv - bfhi(u.x)); o.y = pk2(sm[2] * inv - bflo(u.y), sm[3] * inv - bfhi(u.y));
        o.z = pk2(sm[4] * inv - bflo(u.z), sm[5] * inv - bfhi(u.z)); o.w = pk2(sm[6] * inv - bflo(u.w), sm[7] * inv - bfhi(u.w));
        *(u32x4*)(diff + (size_t)row * W + cc * 8) = o;
    }
}

__device__ __forceinline__ void phase_mixers(const Args& a, int layer, LAS unsigned char* lds) {
    const int G = gridDim.x, bid = blockIdx.x;
    const int nsc = (G >= 192) ? 128 : 0;
    if (PH_MASK & 0x200) { const int sstep = nsc ? nsc : G; if (!nsc || bid < nsc) { for (int it = bid; it < 128; it += sstep) scan_item(a, layer, it, lds); } if (nsc && bid < nsc) return; }
    const int w = nsc ? bid - nsc : bid, nw = nsc ? G - nsc : G;
    const int n_lat = 2048, n_ctx = (layer == 0) ? 128 : 0, n_pool = 544;
    for (int u = w; u < n_lat + n_ctx + n_pool; u += nw) {
        if (u < n_lat) { if (PH_MASK & 0x400) attn_unit(a, layer, u, false, lds); }
        else if (u < n_lat + n_ctx) { if (PH_MASK & 0x400) attn_unit(a, layer, u - n_lat, true, lds); }
        else if (PH_MASK & 0x800) pool_unit(a, u - n_lat - n_ctx);
    }
}

__device__ __forceinline__ void phase_readout(const Args& a, int layer) {
    const int tid = otid(), lane = tid & 63, wv = tid >> 6;
    const int gw = blockIdx.x * 8 + wv, NGW = gridDim.x * 8;
    const bf16_t* P = (const bf16_t*)(a.ws + WS_P);
    const float* ybuf = (const float*)(a.ws + WS_Y);
    const float* bonus = (const float*)(a.ws + WS_BONUS);
    bf16_t* brw = (bf16_t*)(a.ws + WS_BB) + (size_t)2 * M * W;
    const int c0 = lane * 16, h = lane >> 2;
    const float* gp = a.rw_lnx_g + layer * W + c0; const float* bp = a.rw_lnx_b + layer * W + c0; const float* mp = a.rw_mu + (layer * 3 + 2) * W + c0;
    const int nrows = layer ? NB * T : M;
    for (int ri = gw; ri < nrows; ri += NGW) {
        const int row = layer ? ((ri >> 12) * TT + LC + (ri & 4095)) : ri;
        const int t = row % TT;
        int tl, slen; if (t < LC) { tl = t; slen = LC; } else { tl = t - LC; slen = T; }
        const float* y0 = ybuf + (size_t)row * W + c0; const float* y1 = ybuf + ((size_t)M + row) * W + c0;
        f32x4 y[4];
#pragma unroll
        for (int j = 0; j < 4; ++j) y[j] = *(const f32x4*)(y0 + 4 * j) + *(const f32x4*)(y1 + 4 * j);
        const bf16_t* pr = P + (size_t)row * NP;
        const int dp = (tl > 0) ? -NP : 0, dn = (tl < slen - 1) ? NP : 0;
        const float mpv = (tl > 0) ? 1.f : 0.f, mnv = (tl < slen - 1) ? 1.f : 0.f;
        u32x4 vc[2], vp[2], vn[2], gt[2];
#pragma unroll
        for (int j = 0; j < 2; ++j) { vc[j] = *(const u32x4*)(pr + C_RV + c0 + 8 * j); vp[j] = *(const u32x4*)(pr + dp + C_RV + c0 + 8 * j); vn[j] = *(const u32x4*)(pr + dn + C_RV + c0 + 8 * j); gt[j] = *(const u32x4*)(pr + C_RG + c0 + 8 * j); }
        const float bs = bonus[(size_t)row * 16 + h] + bonus[((size_t)M + row) * 16 + h];
        float sm = 0.f;
#pragma unroll
        for (int j = 0; j < 4; ++j) sm += (y[j][0] + y[j][1]) + (y[j][2] + y[j][3]);
        sm += dppmov<0xB1>(sm); sm += dppmov<0x4E>(sm);
        const float mean = sm * (1.f / 64.f);
        float sq = 0.f;
#pragma unroll
        for (int j = 0; j < 4; ++j) { y[j] = y[j] - mean; sq += (y[j][0] * y[j][0] + y[j][1] * y[j][1]) + (y[j][2] * y[j][2] + y[j][3] * y[j][3]); }
        sq += dppmov<0xB1>(sq); sq += dppmov<0x4E>(sq);
        const float rstd = rsqrtf(sq * (1.f / 64.f) + 64e-5f);
        u32x4 ov[2];
#pragma unroll
        for (int j = 0; j < 2; ++j) {
            float o8[8];
#pragma unroll
            for (int e = 0; e < 4; ++e) {
                const unsigned uc = vc[j][e], up = vp[j][e], un = vn[j][e], ug = gt[j][e];
                const int cc = 8 * j + 2 * e;
                const float g0 = gp[cc], g1 = gp[cc + 1], b0 = bp[cc], b1 = bp[cc + 1], m0 = mp[cc], m1 = mp[cc + 1];
                const float v0c = bflo(uc), v1c = bfhi(uc);
                const float v0 = v0c + m0 * (0.5f * (mpv * bflo(up) + mnv * bflo(un)) - v0c), v1 = v1c + m1 * (0.5f * (mpv * bfhi(up) + mnv * bfhi(un)) - v1c);
                const float ya = y[(cc >> 2)][cc & 3] * rstd * g0 + b0, yb = y[((cc + 1) >> 2)][(cc + 1) & 3] * rstd * g1 + b1;
                o8[2 * e] = (ya + bs * v0) * siluf(bflo(ug)); o8[2 * e + 1] = (yb + bs * v1) * siluf(bfhi(ug));
            }
            ov[j].x = pk2(o8[0], o8[1]); ov[j].y = pk2(o8[2], o8[3]); ov[j].z = pk2(o8[4], o8[5]); ov[j].w = pk2(o8[6], o8[7]);
        }
        *(u32x4*)(brw + (size_t)row * W + c0) = ov[0]; *(u32x4*)(brw + (size_t)row * W + c0 + 8) = ov[1];
    }
}

__device__ __forceinline__ void phase_final(const Args& a) {
    const int tid = otid(), lane = tid & 63, wv = tid >> 6;
    const int gw = blockIdx.x * 8 + wv, NGW = gridDim.x * 8;
    for (int row = gw; row < NB * T; row += NGW) {
        float* xr = a.out + (size_t)row * D;
        f32x4 v[8]; float ss = 0.f;
#pragma unroll
        for (int j = 0; j < 8; ++j) { v[j] = *(const f32x4*)(xr + 4 * lane + 256 * j); ss += (v[j][0] * v[j][0] + v[j][1] * v[j][1]) + (v[j][2] * v[j][2] + v[j][3] * v[j][3]); }
        ss = wave_sum(ss); const float rstd = rsqrtf(ss * (1.f / D) + 1e-6f);
#pragma unroll
        for (int j = 0; j < 8; ++j) { const int col = 4 * lane + 256 * j; const f32x4 g4 = *(const f32x4*)(a.final_g + col); *(f32x4*)(xr + col) = (v[j] * rstd) * g4; }
    }
}

__global__ void __launch_bounds__(512, 2) fwd_kernel(Args a) {
    extern __shared__ __attribute__((aligned(16))) unsigned char smem[];
    LAS unsigned char* lds = (LAS unsigned char*)smem;
    cg::grid_group grid = cg::this_grid();
    const int G = gridDim.x, c = blockIdx.x;
    for (int ph = a.ph_lo; ph < a.ph_hi; ++ph) {
        if (ph > a.ph_lo) grid.sync();
        if (ph == 0) { if (PH_MASK & 1) phase_mod(a, lds); continue; }
        if (ph == 13) { if (PH_MASK & 128) phase_final(a); continue; }
        const int layer = (ph - 1) / 6, sub = (ph - 1) % 6;
        int nrep = 1;
#ifdef REP_SUB
        if (sub == REP_SUB && ((REP_LAYERS >> layer) & 1)) nrep = 2;
#endif
        for (int rep = 0; rep < nrep; ++rep) {
        if (rep) grid.sync();
        bf16_t* P = (bf16_t*)(a.ws + WS_P);
        if (sub == 0) { if (PH_MASK & 2) phase_norm_convert(a, layer, lds); }
        else if (sub == 1) {
            Gemm g; g.A = (const bf16_t*)(a.ws + WS_H); g.Bt = (const bf16_t*)(a.ws + WS_WTIN); g.lda = D; g.ldb = D; g.K = D; g.a_z = 0; g.b_z = 0;
            g.nM = 68; g.nN = 65; g.nz = 1; g.latent_only = 0; g.G = G; g.c = c;
            EpiP e; e.P = P; if (PH_MASK & 4) gemm_phase(lds, g, e);
        } else if (sub == 2) { if (PH_MASK & 8) phase_mixers(a, layer, lds); }
        else if (sub == 3) {
            if (PH_MASK & 256) phase_readout(a, layer);
            Gemm g; g.A = (const bf16_t*)(a.ws + WS_DIFF); g.Bt = (const bf16_t*)(a.ws + WS_WTPL); g.lda = W; g.ldb = 256; g.K = 256; g.a_z = 256; g.b_z = 65536;
            g.nM = layer ? 64 : 68; g.nN = 1; g.nz = 4; g.latent_only = layer; g.G = G; g.c = c;
            EpiPool e; e.P = P; e.out = (bf16_t*)(a.ws + WS_BB) + (size_t)M * W; e.scale = a.pool_scale + layer * W; if (PH_MASK & 16) gemm_phase(lds, g, e);
        } else if (sub == 4) {
            Gemm g; g.A = (const bf16_t*)(a.ws + WS_BB); g.Bt = (const bf16_t*)(a.ws + WS_WTBR); g.lda = W; g.ldb = W; g.K = W; g.a_z = (size_t)M * W; g.b_z = (size_t)D * W;
            g.nM = layer ? 64 : 68; g.nN = 8; g.nz = 3; g.latent_only = layer; g.G = G; g.c = c;
            EpiMerge e; e.P = P; e.mf = (float*)(a.ws + WS_Y); e.mb = (bf16_t*)(a.ws + WS_H); if (PH_MASK & 32) gemm_phase(lds, g, e);
        } else {
            Gemm g; g.A = (const bf16_t*)(a.ws + WS_H); g.Bt = (const bf16_t*)(a.ws + WS_WTOUT); g.lda = D; g.ldb = D; g.K = D; g.a_z = 0; g.b_z = 0;
            g.nM = layer ? 64 : 68; g.nN = 8; g.nz = 1; g.latent_only = layer; g.G = G; g.c = c;
            EpiOut e; e.xl_old = layer ? (const float*)a.out : a.x; e.xc_old = layer ? (const float*)(a.ws + WS_XCTX) : a.ctx; e.xl_new = a.out; e.xc_new = (float*)(a.ws + WS_XCTX);
            e.mod = (const float*)(a.ws + WS_MOD) + layer * 5 * 6144; if (PH_MASK & 64) gemm_phase(lds, g, e);
        }
        }
    }
}

extern "C" void kernel_launch(void* const* d_in, const int* in_sizes, int n_in, void* d_out, int out_size, void* d_ws, size_t ws_size, hipStream_t stream) {
    static int grid = 0;
    if (grid == 0) {
        if (n_in != 24 || ws_size < WS_END) { fprintf(stderr, "kernel_launch: unexpected n_in %d or ws_size %zu (< %zu)\n", n_in, ws_size, (size_t)WS_END); grid = -1; return; }
        int dev = 0, cus = 0, per_cu = 0;
        hipGetDevice(&dev); hipDeviceGetAttribute(&cus, hipDeviceAttributeMultiprocessorCount, dev);
        if (hipFuncSetAttribute((const void*)fwd_kernel, hipFuncAttributeMaxDynamicSharedMemorySize, LDS_BYTES) != hipSuccess) { fprintf(stderr, "kernel_launch: hipFuncSetAttribute failed\n"); grid = -1; return; }
        hipOccupancyMaxActiveBlocksPerMultiprocessor(&per_cu, (const void*)fwd_kernel, 512, LDS_BYTES);
        if (per_cu < 1) { fprintf(stderr, "kernel_launch: occupancy query says %d\n", per_cu); per_cu = 1; }
        (void)hipGetLastError();
        grid = cus;
    }
    if (grid < 0) return;
    hipMemsetAsync((char*)d_ws + WS_MOD, 0, WS_MOD_BYTES, stream);
    Args a{};
    const float** pp = (const float**)&a;
    for (int i = 0; i < 24; ++i) pp[i] = (const float*)d_in[i];
    a.out = (float*)d_out; a.ws = (unsigned char*)d_ws;
#if N_LAUNCH_PER_PHASE
    for (int ph = 0; ph < NPHASE; ++ph) {
        a.ph_lo = ph; a.ph_hi = ph + 1;
        void* args[] = {&a};
        hipError_t e = hipLaunchCooperativeKernel((const void*)fwd_kernel, dim3(grid), dim3(512), args, LDS_BYTES, stream);
        if (e != hipSuccess) { fprintf(stderr, "cooperative launch failed: %s\n", hipGetErrorString(e)); break; }
    }
#else
    a.ph_lo = 0; a.ph_hi = NPHASE;
    void* args[] = {&a};
    hipError_t e = hipLaunchCooperativeKernel((const void*)fwd_kernel, dim3(grid), dim3(512), args, LDS_BYTES, stream);
    if (e != hipSuccess) fprintf(stderr, "cooperative launch failed: %s (grid %d)\n", hipGetErrorString(e), grid);
#endif
}
```

```cpp
#include <hip/hip_runtime.h>
#include <hip/hip_cooperative_groups.h>
#include <cstdio>
namespace cg = cooperative_groups;

#ifndef N_LAUNCH_PER_PHASE
#define N_LAUNCH_PER_PHASE 0
#endif

#ifndef REP_LAYERS
#define REP_LAYERS 3
#endif
#ifndef PH_MASK
#define PH_MASK 0xffff
#endif
#define LAS __attribute__((address_space(3)))
typedef unsigned short bf16_t;
typedef short bf16x8 __attribute__((ext_vector_type(8)));
typedef float f32x4 __attribute__((ext_vector_type(4)));
typedef unsigned u32x4 __attribute__((ext_vector_type(4)));
typedef unsigned u32x2 __attribute__((ext_vector_type(2)));

constexpr int D = 2048, NB = 4, T = 4096, LC = 256, TT = 4352, M = 17408, W = 1024, NP = 16640;
constexpr int C_Q = 0, C_K = 1024, C_V = 2048, C_NAG = 3072, C_PU = 4096, C_PG = 5120, C_RR = 6144, C_RK = 7168, C_RV = 8192, C_RG = 9216,
              C_MG = 10240, C_LW = 16384, C_LA = 16448;
constexpr int NPHASE = 14;
constexpr int LDS_BYTES = 163840;

constexpr size_t WS_MOD = 0, WS_MOD_BYTES = 262144;
constexpr size_t WS_BONUS = WS_MOD + WS_MOD_BYTES;
constexpr size_t WS_XCTX = WS_BONUS + 2359296;
constexpr size_t WS_WTIN = WS_XCTX + (size_t)NB * LC * D * 4;
constexpr size_t WS_WTBR = WS_WTIN + (size_t)NP * D * 2;
constexpr size_t WS_WTOUT = WS_WTBR + (size_t)3 * D * W * 2;
constexpr size_t WS_WTPL = WS_WTOUT + (size_t)D * D * 2;
constexpr size_t WS_H = WS_WTPL + (size_t)4 * 256 * 256 * 2;
constexpr size_t WS_Y = WS_H + (size_t)M * D * 2;
constexpr size_t WS_BB = WS_Y + (size_t)2 * M * W * 4;
constexpr size_t WS_DIFF = WS_BB + (size_t)3 * M * W * 2;
constexpr size_t WS_P = WS_DIFF + (size_t)M * W * 2;
constexpr size_t WS_END = WS_P + (size_t)M * NP * 2;

struct Args {
    const float *x, *c, *ctx, *c_ctx, *norm_g, *w_mod, *b_mod, *w_in, *na_rpb, *pool_w, *pool_scale, *rw_mu, *rw_w0, *rw_w2, *rw_a0, *rw_a2, *rw_k_k,
        *rw_k_a, *rw_r_k, *rw_lnx_g, *rw_lnx_b, *w_branch, *w_out, *final_g;
    float* out;
    unsigned char* ws;
    int ph_lo, ph_hi;
};

__device__ __forceinline__ float bf2f(bf16_t v) { return __uint_as_float(((unsigned)v) << 16); }
__device__ __forceinline__ float bflo(unsigned u) { return __uint_as_float(u << 16); }
__device__ __forceinline__ float bfhi(unsigned u) { return __uint_as_float(u & 0xffff0000u); }
typedef float f32x2 __attribute__((ext_vector_type(2)));
typedef __bf16 bf16x2_t __attribute__((ext_vector_type(2)));
__device__ __forceinline__ unsigned pk2(float lo, float hi) { const f32x2 v = {lo, hi}; const bf16x2_t b = __builtin_convertvector(v, bf16x2_t); return __builtin_bit_cast(unsigned, b); }
__device__ __forceinline__ float wave_sum(float v) {
#pragma unroll
    for (int o = 1; o < 64; o <<= 1) v += __shfl_xor(v, o);
    return v;
}
template <int CTRL> __device__ __forceinline__ float dppmov(float v) { return __int_as_float(__builtin_amdgcn_update_dpp(0, __float_as_int(v), CTRL, 0xF, 0xF, true)); }
__device__ __forceinline__ float sum8(float v) { v += dppmov<0xB1>(v); v += dppmov<0x4E>(v); v += dppmov<0x141>(v); return v; }
__device__ __forceinline__ float frcp(float x) { return __builtin_amdgcn_rcpf(x); }
__device__ __forceinline__ float siluf(float x) { return x * frcp(1.f + __expf(-x)); }
__device__ __forceinline__ float sigmf(float x) { return frcp(1.f + __expf(-x)); }
__device__ __forceinline__ int otid() { int t = threadIdx.x; asm volatile("" : "+v"(t)); return t; }
__device__ __forceinline__ void lds_wait() { asm volatile("s_waitcnt lgkmcnt(0)" ::: "memory"); }

constexpr int BM = 256, BK = 64, HALF = 128, HTB = HALF * BK * 2, NXCD = 8, WGM = 8;
__device__ __forceinline__ int lds_byte(int r, int c) { const int st = (r >> 4) * 2 + (c >> 5), rr = r & 15, cc = c & 31, ob = rr * 64 + cc * 2; return st * 1024 + (ob ^ (((ob >> 9) & 1) << 5)); }
__device__ __forceinline__ void stage_rc(int b, int& R, int& C) { const int st = b / 1024, sb = b % 1024, swz = sb ^ (((sb >> 9) & 1) << 5); R = (st >> 1) * 16 + swz / 64; C = (st & 1) * 32 + (swz % 64) / 2; }
__device__ __forceinline__ int perm32(int rho) { const int n = rho >> 4, i = rho & 15; return 8 * (i >> 2) + 4 * n + (i & 3); }

struct Unit { int pm, pn, z; };
struct Gemm {
    const bf16_t* A; const bf16_t* Bt; int lda, ldb, K; size_t a_z, b_z;
    int nM, nN, nz, latent_only, G, c;
    __device__ bool next(int i, Unit& u) const {
        const int zi = i % nz, r = i / nz; const long L = (long)r * G + c; const int nwg = nM * nN; if (L >= nwg) return false;
        int wgid = (int)L; { const int q = nwg / NXCD, rr = nwg % NXCD, xcd = wgid % NXCD, off = wgid / NXCD; wgid = (xcd < rr ? xcd * (q + 1) : rr * (q + 1) + (xcd - rr) * q) + off; }
        const int nig = WGM * nN, gid = wgid / nig, fm = gid * WGM, gsz = (nM - fm) < WGM ? (nM - fm) : WGM;
        int pm = fm + ((wgid % nig) % gsz); u.pn = (wgid % nig) / gsz; u.z = zi;
        u.pm = latent_only ? (pm / 16) * 17 + 1 + (pm % 16) : pm; return true;
    }
};

template <class Epi>
__device__ __forceinline__ void gemm_phase(LAS unsigned char* lds, const Gemm g, const Epi& E) {
    const int tid = otid(), wid = __builtin_amdgcn_readfirstlane(tid >> 6), lane = tid & 63, wr = wid >> 2, wc = wid & 3, fr = lane & 15, fq = lane >> 4;
    const int K = g.K, nt = K / BK;
    unsigned voffA[2], voffB[2];
#pragma unroll
    for (int i = 0; i < 2; ++i) { int R, C; stage_rc(tid * 16 + i * 8192, R, C); const int Rb = Epi::PERM ? ((R & ~31) + perm32(R & 31)) : R;
        voffA[i] = (unsigned)(R * g.lda + C) * 2u; voffB[i] = (unsigned)(Rb * g.ldb + C) * 2u; }
    const size_t kstep = (size_t)(BK * 2);
    const size_t hstepA = (size_t)HALF * g.lda * 2, hstepB = (size_t)HALF * g.ldb * 2;
    const unsigned ldsw = (unsigned)wid * 1024u;
    const int aoff = lds_byte(wr * 64 + fr, fq * 8), boff = lds_byte(wc * 32 + fr, fq * 8);
#define PG8_SA(b, h) (((b) * 2 + (h)) * HTB)
#define PG8_SB(b, h) ((4 + (b) * 2 + (h)) * HTB)
#define PG8_STAGE(bufoff, gbase, voff) do { _Pragma("unroll") for (int _i = 0; _i < 2; ++_i) \
        __builtin_amdgcn_global_load_lds((const unsigned*)((const char*)(gbase) + (voff)[_i]), (LAS unsigned*)(lds + (bufoff) + ldsw + _i * 8192), 16, 0, 0); } while (0)
#define PG8_LDA(dst, b, h) do { _Pragma("unroll") for (int m = 0; m < 4; ++m) _Pragma("unroll") for (int k = 0; k < 2; ++k) dst[m][k] = *(const LAS bf16x8*)(lds + PG8_SA(b, h) + aoff + m * 2048 + k * 1024); } while (0)
#define PG8_LDB(dst, b, h) do { _Pragma("unroll") for (int n = 0; n < 2; ++n) _Pragma("unroll") for (int k = 0; k < 2; ++k) dst[n][k] = *(const LAS bf16x8*)(lds + PG8_SB(b, h) + boff + n * 2048 + k * 1024); } while (0)
#define PG8_MMA(ai, bj, At, Bt) do { __builtin_amdgcn_s_setprio(1); _Pragma("unroll") for (int m = 0; m < 4; ++m) _Pragma("unroll") for (int n = 0; n < 2; ++n) _Pragma("unroll") for (int k = 0; k < 2; ++k) \
        acc[ai][bj][m][n] = __builtin_amdgcn_mfma_f32_16x16x32_bf16(Bt[n][k], At[m][k], acc[ai][bj][m][n], 0, 0, 0); __builtin_amdgcn_s_setprio(0); } while (0)
#define PG8_WAIT_V(n) asm volatile("s_waitcnt vmcnt(" #n ")" ::: "memory")
#define PG8_WAIT_L(n) asm volatile("s_waitcnt lgkmcnt(" #n ")" ::: "memory")
#define PG8_BAR __builtin_amdgcn_s_barrier()
#define PG8_SCHED __builtin_amdgcn_sched_barrier(0)
    Unit cur, nxt; int ui = 0;
    if (!g.next(0, cur)) return;
    f32x4 acc[2][2][4][2];
#pragma unroll
    for (int a = 0; a < 2; ++a)
#pragma unroll
        for (int b = 0; b < 2; ++b)
#pragma unroll
            for (int m = 0; m < 4; ++m)
#pragma unroll
                for (int n = 0; n < 2; ++n) acc[a][b][m][n] = (f32x4){0.f, 0.f, 0.f, 0.f};
    bf16x8 At[4][2], B0[2][2], B1[2][2];
    const char* cA = (const char*)(g.A + cur.z * g.a_z + (size_t)cur.pm * BM * g.lda); const char* cB = (const char*)(g.Bt + cur.z * g.b_z + (size_t)cur.pn * BM * g.ldb);
    PG8_STAGE(PG8_SB(0, 0), cB, voffB); PG8_STAGE(PG8_SA(0, 0), cA, voffA); PG8_STAGE(PG8_SB(0, 1), cB + hstepB, voffB); PG8_STAGE(PG8_SA(0, 1), cA + hstepA, voffA);
    if (wr == 1) PG8_BAR;
    PG8_WAIT_V(4); PG8_BAR;
    PG8_STAGE(PG8_SB(1, 0), cB + kstep, voffB); PG8_STAGE(PG8_SA(1, 0), cA + kstep, voffA); PG8_STAGE(PG8_SB(1, 1), cB + hstepB + kstep, voffB);
    PG8_WAIT_V(6); PG8_BAR;
    for (;;) {
        const bool has_next = g.next(ui + 1, nxt);
        const char* nA = has_next ? (const char*)(g.A + nxt.z * g.a_z + (size_t)nxt.pm * BM * g.lda) : cA;
        const char* nB = has_next ? (const char*)(g.Bt + nxt.z * g.b_z + (size_t)nxt.pn * BM * g.ldb) : cB;
        for (int t = 0; t < nt; t += 2) {
            const bool last = (t == nt - 2);
            const char* a1 = cA + (size_t)(t + 1) * kstep;
            const char* a2 = last ? nA : cA + (size_t)(t + 2) * kstep; const char* b2 = last ? nB : cB + (size_t)(t + 2) * kstep;
            const char* a3 = a2 + kstep; const char* b3 = b2 + kstep;
            PG8_LDB(B0, 0, 0); PG8_SCHED; PG8_LDA(At, 0, 0); PG8_STAGE(PG8_SA(1, 1), a1 + hstepA, voffA);
            PG8_WAIT_L(8); PG8_BAR; PG8_WAIT_L(0); PG8_MMA(0, 0, At, B0); PG8_BAR; PG8_SCHED;
            PG8_LDB(B1, 0, 1); PG8_STAGE(PG8_SB(0, 0), b2, voffB);
            PG8_BAR; PG8_WAIT_L(0); PG8_MMA(0, 1, At, B1); PG8_BAR;
            PG8_LDA(At, 0, 1); PG8_STAGE(PG8_SA(0, 0), a2, voffA);
            PG8_BAR; PG8_WAIT_L(0); PG8_MMA(1, 0, At, B0); PG8_BAR; PG8_SCHED;
            PG8_STAGE(PG8_SB(0, 1), b2 + hstepB, voffB);
            PG8_WAIT_V(6); PG8_BAR; PG8_MMA(1, 1, At, B1); PG8_BAR;
            PG8_LDB(B0, 1, 0); PG8_SCHED; PG8_LDA(At, 1, 0); PG8_STAGE(PG8_SA(0, 1), a2 + hstepA, voffA);
            PG8_WAIT_L(8); PG8_BAR; PG8_WAIT_L(0); PG8_MMA(0, 0, At, B0); PG8_BAR; PG8_SCHED;
            PG8_LDB(B1, 1, 1); PG8_STAGE(PG8_SB(1, 0), b3, voffB);
            PG8_BAR; PG8_WAIT_L(0); PG8_MMA(0, 1, At, B1); PG8_BAR;
            PG8_LDA(At, 1, 1); PG8_STAGE(PG8_SA(1, 0), a3, voffA);
            PG8_BAR; PG8_WAIT_L(0); PG8_MMA(1, 0, At, B0); PG8_BAR; PG8_SCHED;
            PG8_STAGE(PG8_SB(1, 1), b3 + hstepB, voffB);
            PG8_WAIT_V(6); PG8_BAR; PG8_MMA(1, 1, At, B1); PG8_BAR;
        }
        E(acc, cur, wr, wc, fr, fq);
        if (!has_next) break;
#pragma unroll
        for (int a = 0; a < 2; ++a)
#pragma unroll
            for (int b = 0; b < 2; ++b)
#pragma unroll
                for (int m = 0; m < 4; ++m)
#pragma unroll
                    for (int n = 0; n < 2; ++n) acc[a][b][m][n] = (f32x4){0.f, 0.f, 0.f, 0.f};
        cur = nxt; cA = nA; cB = nB; ++ui;
    }
    PG8_WAIT_V(0);
    if (wr == 0) PG8_BAR;
    PG8_BAR;
#undef PG8_SA
#undef PG8_SB
#undef PG8_STAGE
#undef PG8_LDA
#undef PG8_LDB
#undef PG8_MMA
#undef PG8_WAIT_V
#undef PG8_WAIT_L
#undef PG8_BAR
#undef PG8_SCHED
}

struct EpiP {
    static constexpr bool PERM = true;
    bf16_t* P;
    __device__ __forceinline__ void operator()(const f32x4 (&acc)[2][2][4][2], const Unit& u, int wr, int wc, int fr, int fq) const {
        const int row0 = u.pm * BM + wr * 64 + fr, col0 = u.pn * BM + wc * 32 + 8 * fq;
#pragma unroll
        for (int ai = 0; ai < 2; ++ai)
#pragma unroll
            for (int m = 0; m < 4; ++m) { bf16_t* rowp = P + (size_t)(row0 + ai * HALF + m * 16) * NP + col0;
#pragma unroll
                for (int bj = 0; bj < 2; ++bj) { const f32x4 v0 = acc[ai][bj][m][0], v1 = acc[ai][bj][m][1];
                    u32x4 o; o.x = pk2(v0[0], v0[1]); o.y = pk2(v0[2], v0[3]); o.z = pk2(v1[0], v1[1]); o.w = pk2(v1[2], v1[3]);
                    *(u32x4*)(rowp + bj * HALF) = o; } }
    }
};
struct EpiPool {
    static constexpr bool PERM = true;
    const bf16_t* P; bf16_t* out; const float* scale;
    __device__ __forceinline__ void operator()(const f32x4 (&acc)[2][2][4][2], const Unit& u, int wr, int wc, int fr, int fq) const {
        const int row0 = u.pm * BM + wr * 64 + fr, col0 = u.z * 256 + wc * 32 + 8 * fq;
#pragma unroll
        for (int ai = 0; ai < 2; ++ai)
#pragma unroll
            for (int m = 0; m < 4; ++m) { const size_t row = (size_t)(row0 + ai * HALF + m * 16);
#pragma unroll
                for (int bj = 0; bj < 2; ++bj) { const int col = col0 + bj * HALF; const f32x4 v0 = acc[ai][bj][m][0], v1 = acc[ai][bj][m][1];
                    const u32x4 gt = *(const u32x4*)(P + row * NP + C_PG + col);
                    const f32x4 s0 = *(const f32x4*)(scale + col), s1 = *(const f32x4*)(scale + col + 4);
                    u32x4 o;
                    o.x = pk2(v0[0] * s0[0] * siluf(bflo(gt.x)), v0[1] * s0[1] * siluf(bfhi(gt.x)));
                    o.y = pk2(v0[2] * s0[2] * siluf(bflo(gt.y)), v0[3] * s0[3] * siluf(bfhi(gt.y)));
                    o.z = pk2(v1[0] * s1[0] * siluf(bflo(gt.z)), v1[1] * s1[1] * siluf(bfhi(gt.z)));
                    o.w = pk2(v1[2] * s1[2] * siluf(bflo(gt.w)), v1[3] * s1[3] * siluf(bfhi(gt.w)));
                    *(u32x4*)(out + row * W + col) = o; } }
    }
};
struct EpiMerge {
    static constexpr bool PERM = false;
    const bf16_t* P; float* mf; bf16_t* mb;
    __device__ __forceinline__ void operator()(const f32x4 (&acc)[2][2][4][2], const Unit& u, int wr, int wc, int fr, int fq) const {
        const int row0 = u.pm * BM + wr * 64 + fr, col0 = u.pn * BM + wc * 32 + 4 * fq;
        const bool hasold = u.z > 0;
        f32x4 old[4]; u32x2 lg[4];
#define EM_LOAD(it_, old_, lg_) do { const size_t row_ = (size_t)(row0 + ((it_) >> 2) * HALF + ((it_) & 3) * 16); \
            _Pragma("unroll") for (int q_ = 0; q_ < 4; ++q_) { const int col_ = col0 + (q_ >> 1) * HALF + (q_ & 1) * 16; \
                lg_[q_] = *(const u32x2*)(P + row_ * NP + C_MG + u.z * D + col_); \
                old_[q_] = hasold ? *(const f32x4*)(mf + row_ * D + col_) : (f32x4){0.f, 0.f, 0.f, 0.f}; } } while (0)
        EM_LOAD(0, old, lg);
#pragma unroll
        for (int it = 0; it < 8; ++it) {
            f32x4 oldn[4]; u32x2 lgn[4];
            if (it < 7) EM_LOAD(it + 1, oldn, lgn);
            const int ai = it >> 2, m = it & 3; const size_t row = (size_t)(row0 + ai * HALF + m * 16);
#pragma unroll
            for (int q = 0; q < 4; ++q) { const int bj = q >> 1, n = q & 1; const int col = col0 + bj * HALF + n * 16; const f32x4 v = acc[ai][bj][m][n];
                f32x4 r; r[0] = v[0] * sigmf(bflo(lg[q].x)); r[1] = v[1] * sigmf(bfhi(lg[q].x)); r[2] = v[2] * sigmf(bflo(lg[q].y)); r[3] = v[3] * sigmf(bfhi(lg[q].y));
                r += old[q];
                if (u.z < 2) *(f32x4*)(mf + row * D + col) = r;
                else { u32x2 o; o.x = pk2(r[0], r[1]); o.y = pk2(r[2], r[3]); *(u32x2*)(mb + row * D + col) = o; } }
            if (it < 7) {
#pragma unroll
                for (int q = 0; q < 4; ++q) { old[q] = oldn[q]; lg[q] = lgn[q]; } }
        }
#undef EM_LOAD
    }
};
struct EpiOut {
    static constexpr bool PERM = false;
    const float* xl_old; const float* xc_old; float* xl_new; float* xc_new; const float* mod;
    __device__ __forceinline__ void operator()(const f32x4 (&acc)[2][2][4][2], const Unit& u, int wr, int wc, int fr, int fq) const {
        const int b = u.pm / 17, tl = u.pm % 17; const bool isc = (tl == 0);
        const float* xo = isc ? xc_old + (size_t)b * LC * D : xl_old + ((size_t)b * T + (tl - 1) * 256) * D;
        float* xn = isc ? xc_new + (size_t)b * LC * D : xl_new + ((size_t)b * T + (tl - 1) * 256) * D;
        const float* gp = mod + (isc ? 4 : b) * 6144 + 4096;
        const int row0 = wr * 64 + fr, col0 = u.pn * BM + wc * 32 + 4 * fq;
        f32x4 gt[4];
#pragma unroll
        for (int q = 0; q < 4; ++q) gt[q] = *(const f32x4*)(gp + col0 + (q >> 1) * HALF + (q & 1) * 16);
        f32x4 old[4];
#define EO_LOAD(it_, old_) do { const size_t off_ = (size_t)(row0 + ((it_) >> 2) * HALF + ((it_) & 3) * 16) * D + col0; \
            _Pragma("unroll") for (int q_ = 0; q_ < 4; ++q_) old_[q_] = *(const f32x4*)(xo + off_ + (q_ >> 1) * HALF + (q_ & 1) * 16); } while (0)
        EO_LOAD(0, old);
#pragma unroll
        for (int it = 0; it < 8; ++it) {
            f32x4 oldn[4];
            if (it < 7) EO_LOAD(it + 1, oldn);
            const int ai = it >> 2, m = it & 3; const size_t off = (size_t)(row0 + ai * HALF + m * 16) * D + col0;
#pragma unroll
            for (int q = 0; q < 4; ++q) *(f32x4*)(xn + off + (q >> 1) * HALF + (q & 1) * 16) = old[q] + gt[q] * acc[ai][q >> 1][m][q & 1];
            if (it < 7) {
#pragma unroll
                for (int q = 0; q < 4; ++q) old[q] = oldn[q]; }
        }
#undef EO_LOAD
    }
};

__device__ __forceinline__ void phase_mod(const Args& a, LAS unsigned char* lds) {
    const int tidm = otid();
    LAS float* s = (LAS float*)lds;
    float* modp = (float*)(a.ws + WS_MOD);
    for (int task = blockIdx.x; task < 192; task += gridDim.x) {
        const int l = task / 96, rem = task % 96, cb = rem >> 3, kc = rem & 7, k0 = kc * 256;
        __syncthreads();
        for (int i = tidm; i < 5 * 256; i += 512) { const int r = i >> 8, k = i & 255; const float c = (r < 4) ? a.c[r * D + k0 + k] : a.c_ctx[k0 + k]; s[i] = c / (1.f + expf(-c)); }
        __syncthreads();
        const int n = cb * 512 + tidm;
        const float* w = a.w_mod + (size_t)l * D * 6144 + (size_t)k0 * 6144 + n;
        float a0 = 0.f, a1 = 0.f, a2 = 0.f, a3 = 0.f, a4 = 0.f;
#pragma unroll 8
        for (int k = 0; k < 256; ++k) { const float wv = w[(size_t)k * 6144]; a0 += s[k] * wv; a1 += s[256 + k] * wv; a2 += s[512 + k] * wv; a3 += s[768 + k] * wv; a4 += s[1024 + k] * wv; }
        float* mo = modp + l * 5 * 6144 + n;
        const float bias = (kc == 0) ? a.b_mod[l * 6144 + n] : 0.f;
        atomicAdd(mo, a0 + bias); atomicAdd(mo + 6144, a1 + bias); atomicAdd(mo + 2 * 6144, a2 + bias); atomicAdd(mo + 3 * 6144, a3 + bias); atomicAdd(mo + 4 * 6144, a4 + bias);
    }
}

__device__ __forceinline__ void transpose_item(const float* Wsrc, int ldsrc, int k0, int nsrc0, bf16_t* dst, int ldd, LAS float* scr, int lane) {
    if (nsrc0 >= 0) {
#pragma unroll 8
        for (int i = 0; i < 32; ++i) { const int kk = 2 * i + (lane >> 5); scr[kk * 33 + (lane & 31)] = Wsrc[(size_t)(k0 + kk) * ldsrc + nsrc0 + (lane & 31)]; }
    } else {
#pragma unroll 8
        for (int i = 0; i < 32; ++i) { const int kk = 2 * i + (lane >> 5); scr[kk * 33 + (lane & 31)] = 0.f; }
    }
    lds_wait();
    const int c = lane & 7;
#pragma unroll
    for (int j = 0; j < 4; ++j) { const int n = (lane >> 3) + 8 * j; const LAS float* s = scr + (8 * c) * 33 + n;
        u32x4 o; o.x = pk2(s[0 * 33], s[1 * 33]); o.y = pk2(s[2 * 33], s[3 * 33]); o.z = pk2(s[4 * 33], s[5 * 33]); o.w = pk2(s[6 * 33], s[7 * 33]);
        *(u32x4*)(dst + (size_t)n * ldd + k0 + 8 * c) = o; }
    lds_wait();
}
__device__ __forceinline__ void phase_norm_convert(const Args& a, int layer, LAS unsigned char* lds) {
    const int tid = otid(), lane = tid & 63, wv = tid >> 6;
    const int gw = blockIdx.x * 8 + wv, NGW = gridDim.x * 8;
    {
        LAS float* scr = (LAS float*)(lds + wv * 8448);
        bf16_t* wtin = (bf16_t*)(a.ws + WS_WTIN); bf16_t* wtbr = (bf16_t*)(a.ws + WS_WTBR); bf16_t* wtout = (bf16_t*)(a.ws + WS_WTOUT); bf16_t* wtpl = (bf16_t*)(a.ws + WS_WTPL);
        constexpr int I_IN = 32 * 520, I_BR = 16 * 64, I_OUT = 32 * 64, I_PL = 4 * 8;
        constexpr int NIT = I_IN + 3 * I_BR + I_OUT + 4 * I_PL;
        for (int it = gw; it < NIT; it += NGW) {
            int r = it;
            if (r < I_IN) { const int kb = r / 520, nb = r % 520, n0 = nb * 32; const int ns = n0 < 10240 ? n0 : (n0 < 16384 ? n0 + 128 : (n0 < 16512 ? n0 - 6144 : -1));
                transpose_item(a.w_in + (size_t)layer * D * 16512, 16512, kb * 64, ns, wtin + (size_t)n0 * D, D, scr, lane); continue; }
            r -= I_IN;
            if (r < 3 * I_BR) { const int z = r / I_BR, q = r % I_BR, kb = q / 64, nb = q % 64;
                transpose_item(a.w_branch + ((size_t)layer * 3 + z) * W * D, D, kb * 64, nb * 32, wtbr + (size_t)z * D * W + (size_t)nb * 32 * W, W, scr, lane); continue; }
            r -= 3 * I_BR;
            if (r < I_OUT) { const int kb = r / 64, nb = r % 64;
                transpose_item(a.w_out + (size_t)layer * D * D, D, kb * 64, nb * 32, wtout + (size_t)nb * 32 * D, D, scr, lane); continue; }
            r -= I_OUT;
            { const int z = r / I_PL, q = r % I_PL, kb = q / 8, nb = q % 8;
                transpose_item(a.pool_w + ((size_t)layer * 4 + z) * 65536, 256, kb * 64, nb * 32, wtpl + (size_t)z * 65536 + (size_t)nb * 32 * 256, 256, scr, lane); }
        }
    }
    const float* ng = a.norm_g + layer * D;
    const float* mo = (const float*)(a.ws + WS_MOD) + layer * 5 * 6144;
    const float* xctx = (const float*)(a.ws + WS_XCTX);
    bf16_t* h = (bf16_t*)(a.ws + WS_H);
    for (int row = gw; row < M; row += NGW) {
        const int b = row / TT, t = row % TT; const float* xr; int mr;
        if (t < LC) { xr = (layer == 0 ? a.ctx : xctx) + (size_t)(b * LC + t) * D; mr = 4; }
        else { xr = (layer == 0 ? a.x : (const float*)a.out) + (size_t)(b * T + t - LC) * D; mr = b; }
        f32x4 v[8]; float ss = 0.f;
#pragma unroll
        for (int j = 0; j < 8; ++j) { v[j] = *(const f32x4*)(xr + 4 * lane + 256 * j); ss += (v[j][0] * v[j][0] + v[j][1] * v[j][1]) + (v[j][2] * v[j][2] + v[j][3] * v[j][3]); }
        ss = wave_sum(ss); const float rstd = rsqrtf(ss * (1.f / D) + 1e-6f);
        const float* mrow = mo + mr * 6144;
#pragma unroll
        for (int j = 0; j < 8; ++j) { const int col = 4 * lane + 256 * j; const f32x4 g4 = *(const f32x4*)(ng + col), sh = *(const f32x4*)(mrow + col), sc = *(const f32x4*)(mrow + 2048 + col);
            f32x4 o = (v[j] * rstd) * g4; o = o * (sc + 1.f) + sh;
            u32x2 pk; pk.x = pk2(o[0], o[1]); pk.y = pk2(o[2], o[3]); *(u32x2*)(h + (size_t)row * D + col) = pk; }
    }
}

__device__ __forceinline__ float wsum(float v) {
    v += dppmov<0xB1>(v); v += dppmov<0x4E>(v); v += dppmov<0x141>(v); v += dppmov<0x140>(v);
    const int iv = __float_as_int(v);
    return (__int_as_float(__builtin_amdgcn_readlane(iv, 0)) + __int_as_float(__builtin_amdgcn_readlane(iv, 16))) +
           (__int_as_float(__builtin_amdgcn_readlane(iv, 32)) + __int_as_float(__builtin_amdgcn_readlane(iv, 48)));
}
__device__ __forceinline__ bf16_t f2bf(float x) { return (bf16_t)(pk2(x, x) & 0xffffu); }
__device__ __forceinline__ bf16x8 ldsfrag(const LAS bf16_t* p) { return *(const LAS bf16x8*)p; }
#define MFMA16(a_, b_, c_) __builtin_amdgcn_mfma_f32_16x16x32_bf16(a_, b_, c_, 0, 0, 0)

__device__ __forceinline__ void scan_item(const Args& a, int layer, int item, LAS unsigned char* lds) {
    const int tid = otid(), lane = tid & 63, wv = __builtin_amdgcn_readfirstlane(tid >> 6), fr = lane & 15, fq = lane >> 4;
    const int b = item >> 5, h = (item >> 1) & 15, dir = item & 1;
    LAS float* N1t = (LAS float*)lds;
    LAS float* gC = N1t + 1152;
    LAS bf16_t* N1b = (LAS bf16_t*)(gC + 64);
    LAS bf16_t* T11r = N1b + 640;
    LAS bf16_t* Gt = T11r + 640;
    LAS bf16_t* At = Gt + 640;
    LAS bf16_t* Bn = At + 2304;
    LAS bf16_t* Kn = Bn + 2304;
    LAS bf16_t* Rt = Kn + 2304;
    LAS bf16_t* BpT = Rt + 2304;
    LAS bf16_t* KpT = BpT + 2560;
    LAS bf16_t* Vt = KpT + 2560;
    LAS bf16_t* M2t = Vt + 2560;
    LAS bf16_t* M3t = M2t + 1280;
    LAS bf16_t* M4t = M3t + 1280;
    LAS bf16_t* Tmt = M4t + 1280;
    LAS bf16_t* Xs = Tmt + 1280;
    LAS bf16_t* Us = Xs + 2560;
    LAS float* WPs = (LAS float*)(Us + 2560);
    LAS float* APs = WPs + 2176;
    LAS float* LD = APs + 2176;
    LAS bf16_t* W2T = (LAS bf16_t*)(LD + 2048);
    LAS bf16_t* A2T = W2T + 4608;
    LAS bf16_t* LWb = A2T + 4608;
    LAS bf16_t* LAb = LWb + 2304;
    LAS bf16_t* S0s = LAb + 2304;
    LAS bf16_t* RAW = S0s + 9216;
    LAS float* Ys = WPs;
    const bf16_t* P = (const bf16_t*)(a.ws + WS_P);
    float* ybuf = (float*)(a.ws + WS_Y);
    float* bonus = (float*)(a.ws + WS_BONUS);
    __syncthreads();
    {
        const float* w2 = a.rw_w2 + ((size_t)(layer * 2 + dir) * 64) * W + h * 64;
        const float* a2 = a.rw_a2 + ((size_t)(layer * 2 + dir) * 64) * W + h * 64;
        for (int i = tid; i < 4096; i += 512) { const int l = i >> 6, c = i & 63; W2T[c * 72 + l] = f2bf(w2[l * W + c]); A2T[c * 72 + l] = f2bf(a2[l * W + c]); }
        for (int i = tid; i < 4608; i += 512) ((LAS unsigned*)S0s)[i] = 0u;
    }
    const int ch = h * 64 + lane;
    const float mu_r = a.rw_mu[(layer * 3 + 0) * W + ch], mu_k = a.rw_mu[(layer * 3 + 1) * W + ch], mu_v = a.rw_mu[(layer * 3 + 2) * W + ch];
    const float w0 = a.rw_w0[(layer * 2 + dir) * W + ch], a0 = a.rw_a0[(layer * 2 + dir) * W + ch];
    const float kk_c = a.rw_k_k[layer * W + ch], ka_c = a.rw_k_a[layer * W + ch], rk_c = a.rw_r_k[layer * W + ch];
    f32x4 Sacc[2];
    Sacc[0] = (f32x4){0.f, 0.f, 0.f, 0.f}; Sacc[1] = (f32x4){0.f, 0.f, 0.f, 0.f};
    int cur = 0;
    const int tt = wv >> 2, it = wv & 3;
    const bf16x8 zfrag = (bf16x8){0, 0, 0, 0, 0, 0, 0, 0};
#define SBAR() do { asm volatile("s_waitcnt lgkmcnt(0)" ::: "memory"); __builtin_amdgcn_s_barrier(); asm volatile("" ::: "memory"); } while (0)
#define SCAN_LOAD(dst, gcx) do { const int g_ = (gcx) < 136 ? (gcx) : 135; const int sg_ = g_ >= 8; const int sl_ = sg_ ? T : LC; const int rb_ = b * TT + (sg_ ? LC : 0); const int ck_ = sg_ ? g_ - 8 : g_; \
        const int tlo_ = dir ? (sl_ - 32 * (ck_ + 1)) : 32 * ck_; \
        _Pragma("unroll") for (int k = 0; k < 3; ++k) { const int pc_ = tid + 512 * k; int row_ = pc_ >> 3; row_ = row_ < 170 ? row_ : 169; const int arr_ = row_ / 34, ri_ = row_ - arr_ * 34; \
            int tok_ = tlo_ - 1 + ri_; tok_ = tok_ < 0 ? 0 : (tok_ > sl_ - 1 ? sl_ - 1 : tok_); \
            const int col_ = (arr_ == 0) ? C_LW : ((arr_ == 1) ? C_LA : ((arr_ == 2 ? C_RR : (arr_ == 3 ? C_RK : C_RV)) + h * 64)); \
            dst[k] = *(const u32x4*)(P + (size_t)(rb_ + tok_) * NP + col_ + (pc_ & 7) * 8); } } while (0)
    u32x4 nr[3];
    SCAN_LOAD(nr, 0);
    SBAR();
    for (int gc = 0; gc < 136; ++gc) {
        {
            int lane_v = lane; asm volatile("" : "+v"(lane_v));
            const int lane = lane_v, fr = lane & 15, fq = lane >> 4, tid = (wv << 6) | lane;
            const int seg = gc >= 8; const int slen = seg ? T : LC; const int rowbase = b * TT + (seg ? LC : 0); const int ck = seg ? gc - 8 : gc;
            const int tlo = dir ? (slen - 32 * (ck + 1)) : 32 * ck;
#pragma unroll
            for (int k = 0; k < 3; ++k) { const int pc = tid + 512 * k; if (pc < 1360) *(LAS u32x4*)(RAW + pc * 8) = nr[k]; }
            SBAR();
            SCAN_LOAD(nr, gc + 1);
            if (gc > 0) {
                const int gp = gc - 1; const int sgp = gp >= 8; const int slp = sgp ? T : LC; const int rbp = b * TT + (sgp ? LC : 0); const int ckp = sgp ? gp - 8 : gp;
                const int p = tid >> 4, pi = ckp * 32 + p, t = dir ? (slp - 1 - pi) : pi;
                const f32x4 yv = *(const LAS f32x4*)(Ys + p * 68 + (tid & 15) * 4);
                *(f32x4*)(ybuf + ((size_t)dir * M + rbp + t) * W + h * 64 + (tid & 15) * 4) = yv;
            }
            float r_[4], kd_[4], kk_[4], av_[4], v_[4], ld_[4];
#pragma unroll
            for (int q = 0; q < 4; ++q) {
                const int p = wv * 4 + q, pi = ck * 32 + p, t = dir ? (slen - 1 - pi) : pi;
                const int ri = t - tlo + 1;
                const LAS bf16_t* rw = RAW + ri * 64 + lane;
                { const float x2 = __expf(2.f * bf2f(rw[0])); LWb[p * 72 + lane] = f2bf(1.f - 2.f * frcp(1.f + x2)); } LAb[p * 72 + lane] = rw[34 * 64];
                const float r0 = bf2f(rw[68 * 64]), k0 = bf2f(rw[102 * 64]), v0 = bf2f(rw[136 * 64]);
                const float mp = (t > 0) ? 1.f : 0.f, mn = (t < slen - 1) ? 1.f : 0.f;
                const float rs = mp * bf2f(rw[67 * 64]) + mn * bf2f(rw[69 * 64]), ks = mp * bf2f(rw[101 * 64]) + mn * bf2f(rw[103 * 64]), vs = mp * bf2f(rw[135 * 64]) + mn * bf2f(rw[137 * 64]);
                r_[q] = r0 + mu_r * (0.5f * rs - r0); kd_[q] = k0 + mu_k * (0.5f * ks - k0); v_[q] = v0 + mu_v * (0.5f * vs - v0);
                const float kku = kd_[q] * kk_c; const float ss = wsum(kku * kku);
                kk_[q] = kku * frcp(fmaxf(__builtin_amdgcn_sqrtf(ss), 1e-12f));
                asm volatile("" ::: "memory");
            }
            SBAR();
            {
                const LAS bf16_t* Aw = LWb + (tt * 16 + fr) * 72 + fq * 8; const LAS bf16_t* Bw = W2T + (it * 16 + fr) * 72 + fq * 8;
                const LAS bf16_t* Aa = LAb + (tt * 16 + fr) * 72 + fq * 8; const LAS bf16_t* Ba = A2T + (it * 16 + fr) * 72 + fq * 8;
                f32x4 cw = (f32x4){0.f, 0.f, 0.f, 0.f}, ca = (f32x4){0.f, 0.f, 0.f, 0.f};
                cw = MFMA16(ldsfrag(Aw), ldsfrag(Bw), cw); cw = MFMA16(ldsfrag(Aw + 32), ldsfrag(Bw + 32), cw);
                ca = MFMA16(ldsfrag(Aa), ldsfrag(Ba), ca); ca = MFMA16(ldsfrag(Aa + 32), ldsfrag(Ba + 32), ca);
#pragma unroll
                for (int rg = 0; rg < 4; ++rg) { WPs[(tt * 16 + fq * 4 + rg) * 68 + it * 16 + fr] = cw[rg]; APs[(tt * 16 + fq * 4 + rg) * 68 + it * 16 + fr] = ca[rg]; }
            }
            SBAR();
#pragma unroll
            for (int q = 0; q < 4; ++q) {
                const int p = wv * 4 + q, pi = ck * 32 + p, t = dir ? (slen - 1 - pi) : pi;
                const float wp = w0 + WPs[p * 68 + lane], ap = a0 + APs[p * 68 + lane];
                ld_[q] = -0.6065306597f * frcp(1.f + __expf(-wp));
                av_[q] = frcp(1.f + __expf(-ap));
                kd_[q] = kd_[q] * (1.f + (av_[q] - 1.f) * ka_c);
                LD[p * 64 + lane] = ld_[q];
                const float bs = wsum(r_[q] * kd_[q] * rk_c);
                if (lane == 0) bonus[((size_t)dir * M + rowbase + t) * 16 + h] = bs;
            }
            SBAR();
            {
                float cprev = 0.f;
                for (int p2 = 0; p2 < wv * 4; ++p2) cprev += LD[p2 * 64 + lane];
                float ctot = cprev;
                for (int p2 = wv * 4; p2 < 32; ++p2) ctot += LD[p2 * 64 + lane];
                float cum = cprev;
#pragma unroll
                for (int q = 0; q < 4; ++q) {
                    const int p = wv * 4 + q;
                    cum += ld_[q];
                    const float eg = __expf(cum), egi = __expf(-cum), egm = __expf(cum - ld_[q]), egc = __expf(ctot - cum);
                    const float bq = kk_[q] * av_[q];
                    At[p * 72 + lane] = f2bf(-kk_[q] * egm); Bn[p * 72 + lane] = f2bf(bq * egi); Kn[p * 72 + lane] = f2bf(kd_[q] * egi); Rt[p * 72 + lane] = f2bf(r_[q] * eg);
                    BpT[lane * 40 + p] = f2bf(bq * egc); KpT[lane * 40 + p] = f2bf(kd_[q] * egc); Vt[lane * 40 + p] = f2bf(v_[q]);
                }
                if (wv == 0) gC[lane] = __expf(ctot);
            }
            SBAR();
#pragma unroll
            for (int k2 = 0; k2 < 2; ++k2) {
                const int tile = wv * 2 + k2, mi = tile >> 2, st = (tile >> 1) & 1, t2 = tile & 1;
                const LAS bf16_t* Ap = ((mi & 1) ? Kn : Bn) + (st * 16 + fr) * 72 + fq * 8;
                const LAS bf16_t* Bp = ((mi >> 1) ? Rt : At) + (t2 * 16 + fr) * 72 + fq * 8;
                f32x4 acc = (f32x4){0.f, 0.f, 0.f, 0.f};
                acc = MFMA16(ldsfrag(Ap), ldsfrag(Bp), acc); acc = MFMA16(ldsfrag(Ap + 32), ldsfrag(Bp + 32), acc);
                const int t = t2 * 16 + fr, s0 = st * 16 + fq * 4;
#pragma unroll
                for (int rg = 0; rg < 4; ++rg) { const int s = s0 + rg; const bool keep = (mi < 2) ? (s < t) : (s <= t); if (!keep) acc[rg] = 0.f; }
                if (mi == 0) { *(LAS f32x4*)(N1t + t * 36 + s0) = acc;
                    if (tile == 1) {
#pragma unroll
                        for (int rg = 0; rg < 4; ++rg) N1b[(fq * 4 + rg) * 40 + fr] = f2bf(acc[rg]); } }
                else { LAS bf16_t* Mp = (mi == 1 ? M2t : (mi == 2 ? M3t : M4t)) + t * 40 + s0; u32x2 o; o.x = pk2(acc[0], acc[1]); o.y = pk2(acc[2], acc[3]); *(LAS u32x2*)Mp = o; }
            }
            SBAR();
            const LAS bf16_t* S0c = S0s + cur * 4608;
            {
                const LAS bf16_t* Ap = At + (tt * 16 + fr) * 72 + fq * 8; const LAS bf16_t* Bp = S0c + (it * 16 + fr) * 72 + fq * 8;
                f32x4 acc = (f32x4){0.f, 0.f, 0.f, 0.f};
                acc = MFMA16(ldsfrag(Ap), ldsfrag(Bp), acc); acc = MFMA16(ldsfrag(Ap + 32), ldsfrag(Bp + 32), acc);
                acc = MFMA16(ldsfrag(M2t + (tt * 16 + fr) * 40 + fq * 8), ldsfrag(Vt + (it * 16 + fr) * 40 + fq * 8), acc);
                u32x2 o; o.x = pk2(acc[0], acc[1]); o.y = pk2(acc[2], acc[3]);
                *(LAS u32x2*)(Xs + (it * 16 + fr) * 40 + tt * 16 + fq * 4) = o;
            }
            if (wv == 0) {
                if (lane < 32) {
                    const int blk = lane >> 4, r = lane & 15;
                    float Tr[16];
#pragma unroll
                    for (int t = 0; t < 16; ++t) {
                        float acc = (r == t) ? 1.f : 0.f;
#pragma unroll
                        for (int s4 = 0; s4 < (t + 3) / 4; ++s4) { const f32x4 n4 = *(const LAS f32x4*)(N1t + (blk * 16 + t) * 36 + blk * 16 + s4 * 4);
#pragma unroll
                            for (int u = 0; u < 4; ++u) if (s4 * 4 + u < t) acc += Tr[s4 * 4 + u] * n4[u]; }
                        Tr[t] = acc;
                        if ((t & 3) == 3) asm volatile("" ::: "memory");
                    }
#pragma unroll
                    for (int t = 0; t < 16; ++t) { Tmt[(blk * 16 + t) * 40 + blk * 16 + r] = f2bf(Tr[t]); if (blk == 1) Tmt[t * 40 + 16 + r] = 0; }
                    if (blk == 0) {
#pragma unroll
                        for (int s2 = 0; s2 < 8; ++s2) *(LAS unsigned*)(T11r + r * 40 + s2 * 2) = pk2(Tr[2 * s2], Tr[2 * s2 + 1]);
                    }
                }
                lds_wait();
                {
                    const bf16x8 af = (fq < 2) ? ldsfrag(Tmt + (16 + fr) * 40 + 16 + fq * 8) : zfrag;
                    const bf16x8 bf = (fq < 2) ? ldsfrag(N1b + fr * 40 + fq * 8) : zfrag;
                    f32x4 g = (f32x4){0.f, 0.f, 0.f, 0.f};
                    g = MFMA16(af, bf, g);
#pragma unroll
                    for (int rg = 0; rg < 4; ++rg) Gt[(fq * 4 + rg) * 40 + fr] = f2bf(g[rg]);
                }
                lds_wait();
                {
                    const bf16x8 af = (fq < 2) ? ldsfrag(Gt + fr * 40 + fq * 8) : zfrag;
                    const bf16x8 bf = (fq < 2) ? ldsfrag(T11r + fr * 40 + fq * 8) : zfrag;
                    f32x4 g = (f32x4){0.f, 0.f, 0.f, 0.f};
                    g = MFMA16(af, bf, g);
#pragma unroll
                    for (int rg = 0; rg < 4; ++rg) Tmt[(16 + fq * 4 + rg) * 40 + fr] = f2bf(g[rg]);
                }
            }
            SBAR();
            {
                f32x4 acc = (f32x4){0.f, 0.f, 0.f, 0.f};
                acc = MFMA16(ldsfrag(Tmt + (tt * 16 + fr) * 40 + fq * 8), ldsfrag(Xs + (it * 16 + fr) * 40 + fq * 8), acc);
                u32x2 o; o.x = pk2(acc[0], acc[1]); o.y = pk2(acc[2], acc[3]);
                *(LAS u32x2*)(Us + (it * 16 + fr) * 40 + tt * 16 + fq * 4) = o;
            }
            SBAR();
            {
                const LAS bf16_t* Ap = S0c + (it * 16 + fr) * 72 + fq * 8; const LAS bf16_t* Bp = Rt + (tt * 16 + fr) * 72 + fq * 8;
                f32x4 acc = (f32x4){0.f, 0.f, 0.f, 0.f};
                acc = MFMA16(ldsfrag(Ap), ldsfrag(Bp), acc); acc = MFMA16(ldsfrag(Ap + 32), ldsfrag(Bp + 32), acc);
                const bf16x8 uf = ldsfrag(Us + (it * 16 + fr) * 40 + fq * 8), vf = ldsfrag(Vt + (it * 16 + fr) * 40 + fq * 8);
                acc = MFMA16(uf, ldsfrag(M3t + (tt * 16 + fr) * 40 + fq * 8), acc);
                acc = MFMA16(vf, ldsfrag(M4t + (tt * 16 + fr) * 40 + fq * 8), acc);
                *(LAS f32x4*)(Ys + (tt * 16 + fr) * 68 + it * 16 + fq * 4) = acc;
                LAS bf16_t* S0n = S0s + (cur ^ 1) * 4608;
#pragma unroll
                for (int k2 = 0; k2 < 2; ++k2) {
                    const int jt = tt * 2 + k2;
                    const f32x4 g4 = *(const LAS f32x4*)(gC + jt * 16 + fq * 4);
                    f32x4 s = Sacc[k2] * g4;
                    s = MFMA16(ldsfrag(BpT + (jt * 16 + fr) * 40 + fq * 8), uf, s);
                    s = MFMA16(ldsfrag(KpT + (jt * 16 + fr) * 40 + fq * 8), vf, s);
                    Sacc[k2] = s;
                    u32x2 o; o.x = pk2(s[0], s[1]); o.y = pk2(s[2], s[3]);
                    *(LAS u32x2*)(S0n + (it * 16 + fr) * 72 + jt * 16 + fq * 4) = o;
                }
            }
            cur ^= 1;
        }
    }
    SBAR();
    {
        const int p = tid >> 4, pi = 127 * 32 + p, t = dir ? (T - 1 - pi) : pi;
        const f32x4 yv = *(const LAS f32x4*)(Ys + p * 68 + (tid & 15) * 4);
        *(f32x4*)(ybuf + ((size_t)dir * M + b * TT + LC + t) * W + h * 64 + (tid & 15) * 4) = yv;
    }
#undef SCAN_LOAD
#undef SBAR
}


__device__ __forceinline__ int clampi(int v, int lo, int hi) { return v < lo ? lo : (v > hi ? hi : v); }

__device__ __forceinline__ void attn_unit(const Args& a, int layer, int unit, bool isctx, LAS unsigned char* lds) {
    const int tid = otid(), lane = tid & 63, wv = tid >> 6, fr = lane & 15, fq = lane >> 4;
    constexpr int VS = 840;
    LAS bf16_t* Vt = (LAS bf16_t*)lds;
    LAS float* rpbs = (LAS float*)(lds + 64 * VS * 2);
    const bf16_t* P = (const bf16_t*)(a.ws + WS_P);
    bf16_t* bna = (bf16_t*)(a.ws + WS_BB);
    int b, h, rp = 0, half = 0;
    if (!isctx) { b = unit >> 9; h = (unit >> 5) & 15; rp = unit & 31; } else { b = unit >> 5; h = (unit >> 1) & 15; half = unit & 1; }
    int r0a = 0, nloc = 0;
    if (!isctx) { r0a = clampi(2 * rp - 4, 0, 56); const int r0b = clampi(2 * rp - 3, 0, 56); nloc = (r0b + 8 - r0a) * 64; }
    __syncthreads();
    {
        const int nk8 = (nloc + 256) * 8;
        u32x4 vv[13];
#pragma unroll
        for (int i = 0; i < 13; ++i) { const int cidx = tid + i * 512; const int key = cidx >> 3, dc = cidx & 7;
            const int srow = (key < nloc) ? (b * TT + LC + r0a * 64 + key) : (b * TT + min(key - nloc, 255));
            if (cidx < nk8) vv[i] = *(const u32x4*)(P + (size_t)srow * NP + C_V + h * 64 + dc * 8); }
#pragma unroll
        for (int i = 0; i < 13; ++i) { const int cidx = tid + i * 512; const int key = cidx >> 3, dc = cidx & 7;
            const int dcol = (key < nloc) ? key : (576 + key - nloc);
            if (cidx < nk8) { const u32x4 v = vv[i]; LAS bf16_t* d = Vt + (dc * 8) * VS + dcol;
                d[0] = (bf16_t)(v.x & 0xffff); d[VS] = (bf16_t)(v.x >> 16); d[2 * VS] = (bf16_t)(v.y & 0xffff); d[3 * VS] = (bf16_t)(v.y >> 16);
                d[4 * VS] = (bf16_t)(v.z & 0xffff); d[5 * VS] = (bf16_t)(v.z >> 16); d[6 * VS] = (bf16_t)(v.w & 0xffff); d[7 * VS] = (bf16_t)(v.w >> 16); } }
    }
    if (!isctx) for (int i = tid; i < 465; i += 512) rpbs[i] = a.na_rpb[(size_t)(layer * 16 + h) * 465 + i];
    __syncthreads();

    int qtok, r = 0, qc = 0, cs = 0, r0 = 0;
    if (!isctx) { r = 2 * rp + (wv >> 2); const int g = wv & 3; qc = g * 16 + fr; cs = (g == 0) ? 0 : (g == 1 ? 8 : (g == 2 ? 24 : 32)); r0 = clampi(r - 4, 0, 56); qtok = b * TT + LC + r * 64 + qc; }
    else qtok = b * TT + half * 128 + wv * 16 + fr;
    bf16x8 qf[2];
    qf[0] = *(const bf16x8*)(P + (size_t)qtok * NP + C_Q + h * 64 + fq * 8);
    qf[1] = *(const bf16x8*)(P + (size_t)qtok * NP + C_Q + h * 64 + 32 + fq * 8);
    const int cstart = clampi(qc - 8, 0, 48);
    float mrun = -1e30f, lrun = 0.f;
    f32x4 o[4];
#pragma unroll
    for (int dt = 0; dt < 4; ++dt) o[dt] = (f32x4){0.f, 0.f, 0.f, 0.f};
    const int nblk = isctx ? 8 : 16;
#define ATT_KLOAD(dst, blkx) do { const int bx_ = (blkx) < nblk ? (blkx) : nblk - 1; const bool lc_ = (!isctx) && (bx_ < 8); \
        _Pragma("unroll") for (int ti = 0; ti < 2; ++ti) { const size_t ktok_ = lc_ ? (size_t)(b * TT + LC + (r0 + bx_) * 64 + cs + ti * 16 + fr) : (size_t)(b * TT + ((bx_ & 7) * 32) + ti * 16 + fr); \
            const bf16_t* kp_ = P + ktok_ * NP + C_K + h * 64 + fq * 8; dst[ti][0] = *(const bf16x8*)kp_; dst[ti][1] = *(const bf16x8*)(kp_ + 32); } } while (0)
    bf16x8 kf[2][2];
    ATT_KLOAD(kf, 0);
    for (int blk = 0; blk < nblk; ++blk) {
        const bool loc = (!isctx) && (blk < 8);
        const int gr = r0 + blk;
        bf16x8 kn[2][2];
        ATT_KLOAD(kn, blk + 1);
        f32x4 s[2];
#pragma unroll
        for (int ti = 0; ti < 2; ++ti) {
            f32x4 z = (f32x4){0.f, 0.f, 0.f, 0.f};
            z = __builtin_amdgcn_mfma_f32_16x16x32_bf16(kf[ti][0], qf[0], z, 0, 0, 0);
            s[ti] = __builtin_amdgcn_mfma_f32_16x16x32_bf16(kf[ti][1], qf[1], z, 0, 0, 0);
        }
        float sv[8];
        if (loc) {
            const LAS float* brow = rpbs + (gr - r + 7) * 31;
#pragma unroll
            for (int ti = 0; ti < 2; ++ti)
#pragma unroll
                for (int rg = 0; rg < 4; ++rg) { const int kc = cs + ti * 16 + fq * 4 + rg; const bool valid = (kc >= cstart) && (kc < cstart + 16);
                    const int co = clampi(kc - qc + 15, 0, 30); sv[ti * 4 + rg] = valid ? (s[ti][rg] * 0.125f + brow[co]) : -1e30f; }
        } else {
#pragma unroll
            for (int ti = 0; ti < 2; ++ti)
#pragma unroll
                for (int rg = 0; rg < 4; ++rg) sv[ti * 4 + rg] = s[ti][rg] * 0.125f;
        }
        float mx = fmaxf(fmaxf(fmaxf(sv[0], sv[1]), fmaxf(sv[2], sv[3])), fmaxf(fmaxf(sv[4], sv[5]), fmaxf(sv[6], sv[7])));
        mx = fmaxf(mx, __shfl_xor(mx, 16)); mx = fmaxf(mx, __shfl_xor(mx, 32));
        const float mnew = fmaxf(mrun, mx); const float alpha = __expf(mrun - mnew); mrun = mnew;
        float ps = 0.f; float pv[8];
#pragma unroll
        for (int i = 0; i < 8; ++i) { pv[i] = __expf(sv[i] - mnew); ps += pv[i]; }
        lrun = lrun * alpha + ps;
#pragma unroll
        for (int dt = 0; dt < 4; ++dt) o[dt] *= alpha;
        u32x4 pp; pp.x = pk2(pv[0], pv[1]); pp.y = pk2(pv[2], pv[3]); pp.z = pk2(pv[4], pv[5]); pp.w = pk2(pv[6], pv[7]);
        const bf16x8 pf = __builtin_bit_cast(bf16x8, pp);
        const int kbase = loc ? ((gr - r0a) * 64 + cs) : (576 + (blk & 7) * 32);
#pragma unroll
        for (int dt = 0; dt < 4; ++dt) { const LAS bf16_t* vp = Vt + (dt * 16 + fr) * VS + kbase + fq * 4;
            const u32x2 lo = *(const LAS u32x2*)vp, hi = *(const LAS u32x2*)(vp + 16);
            u32x4 vv; vv.x = lo.x; vv.y = lo.y; vv.z = hi.x; vv.w = hi.y;
            o[dt] = __builtin_amdgcn_mfma_f32_16x16x32_bf16(__builtin_bit_cast(bf16x8, vv), pf, o[dt], 0, 0, 0); }
#pragma unroll
        for (int ti = 0; ti < 2; ++ti) { kf[ti][0] = kn[ti][0]; kf[ti][1] = kn[ti][1]; }
    }
#undef ATT_KLOAD
    lrun += __shfl_xor(lrun, 16); lrun += __shfl_xor(lrun, 32);
    const float inv = frcp(lrun);
#pragma unroll
    for (int dt = 0; dt < 4; ++dt) { const int dcol = h * 64 + dt * 16 + fq * 4;
        const u32x2 gt = *(const u32x2*)(P + (size_t)qtok * NP + C_NAG + dcol);
        u32x2 ov; ov.x = pk2(o[dt][0] * inv * siluf(bflo(gt.x)), o[dt][1] * inv * siluf(bfhi(gt.x))); ov.y = pk2(o[dt][2] * inv * siluf(bflo(gt.y)), o[dt][3] * inv * siluf(bfhi(gt.y)));
        *(u32x2*)(bna + (size_t)qtok * W + dcol) = ov; }
}

__device__ __forceinline__ void pool_unit(const Args& a, int unit) {
    const int tid = otid();
    const bf16_t* P = (const bf16_t*)(a.ws + WS_P);
    bf16_t* diff = (bf16_t*)(a.ws + WS_DIFF);
    const int cc = tid & 127, g = cc >> 5, hw = 1 << g;
    for (int pass = 0; pass < 8; ++pass) {
        const int row = unit * 32 + pass * 4 + (tid >> 7); const int b = row / TT, t = row % TT;
        int s0, slen, tl; if (t < LC) { s0 = b * TT; slen = LC; tl = t; } else { s0 = b * TT + LC; slen = T; tl = t - LC; }
        const int lo = max(tl - hw, 0), hi = min(tl + hw, slen);
        float sm[8];
#pragma unroll
        for (int j = 0; j < 8; ++j) sm[j] = 0.f;
        u32x4 wv4[16];
#pragma unroll
        for (int k = 0; k < 16; ++k) { const int sx = tl - hw + k; const bool ok = (k < 2 * hw) && (sx >= 0) && (sx < slen); const int sc = ok ? sx : tl;
            wv4[k] = *(const u32x4*)(P + (size_t)(s0 + sc) * NP + C_PU + cc * 8); }
#pragma unroll
        for (int k = 0; k < 16; ++k) { const int sx = tl - hw + k; const bool ok = (k < 2 * hw) && (sx >= 0) && (sx < slen); const float mk = ok ? 1.f : 0.f; const u32x4 v = wv4[k];
            sm[0] += mk * bflo(v.x); sm[1] += mk * bfhi(v.x); sm[2] += mk * bflo(v.y); sm[3] += mk * bfhi(v.y); sm[4] += mk * bflo(v.z); sm[5] += mk * bfhi(v.z); sm[6] += mk * bflo(v.w); sm[7] += mk * bfhi(v.w); }
        const float inv = 1.f / (float)(hi - lo);
        const u32x4 u = *(const u32x4*)(P + (size_t)row * NP + C_PU + cc * 8);
        u32x4 o; o.x = pk2(sm[0] * inv - bflo(u.x), sm[1] * inv - bfhi(u.x)); o.y = pk2(sm[2] * inv - bflo(u.y), sm[3] * inv - bfhi(u.y));
        o.z = pk2(sm[4] * inv - bflo(u.z), sm[5] * inv - bfhi(u.z)); o.w = pk2(sm[6] * inv - bflo(u.w), sm[7] * inv - bfhi(u.w));
        *(u32x4*)(diff + (size_t)row * W + cc * 8) = o;
    }
}

__device__ __forceinline__ void phase_mixers(const Args& a, int layer, LAS unsigned char* lds) {
    const int G = gridDim.x, bid = blockIdx.x;
    const int nsc = (G >= 192) ? 128 : 0;
    if (PH_MASK & 0x200) { const int sstep = nsc ? nsc : G; if (!nsc || bid < nsc) { for (int it = bid; it < 128; it += sstep) scan_item(a, layer, it, lds); } if (nsc && bid < nsc) return; }
    const int w = nsc ? bid - nsc : bid, nw = nsc ? G - nsc : G;
    const int n_lat = 2048, n_ctx = (layer == 0) ? 128 : 0, n_pool = 544;
    for (int u = w; u < n_lat + n_ctx + n_pool; u += nw) {
        if (u < n_lat) { if (PH_MASK & 0x400) attn_unit(a, layer, u, false, lds); }
        else if (u < n_lat + n_ctx) { if (PH_MASK & 0x400) attn_unit(a, layer, u - n_lat, true, lds); }
        else if (PH_MASK & 0x800) pool_unit(a, u - n_lat - n_ctx);
    }
}

__device__ __forceinline__ void phase_readout(const Args& a, int layer) {
    const int tid = otid(), lane = tid & 63, wv = tid >> 6;
    const int gw = blockIdx.x * 8 + wv, NGW = gridDim.x * 8;
    const bf16_t* P = (const bf16_t*)(a.ws + WS_P);
    const float* ybuf = (const float*)(a.ws + WS_Y);
    const float* bonus = (const float*)(a.ws + WS_BONUS);
    bf16_t* brw = (bf16_t*)(a.ws + WS_BB) + (size_t)2 * M * W;
    const int c0 = lane * 16, h = lane >> 2;
    const float* gp = a.rw_lnx_g + layer * W + c0; const float* bp = a.rw_lnx_b + layer * W + c0; const float* mp = a.rw_mu + (layer * 3 + 2) * W + c0;
    const int nrows = layer ? NB * T : M;
    for (int ri = gw; ri < nrows; ri += NGW) {
        const int row = layer ? ((ri >> 12) * TT + LC + (ri & 4095)) : ri;
        const int t = row % TT;
        int tl, slen; if (t < LC) { tl = t; slen = LC; } else { tl = t - LC; slen = T; }
        const float* y0 = ybuf + (size_t)row * W + c0; const float* y1 = ybuf + ((size_t)M + row) * W + c0;
        f32x4 y[4];
#pragma unroll
        for (int j = 0; j < 4; ++j) y[j] = *(const f32x4*)(y0 + 4 * j) + *(const f32x4*)(y1 + 4 * j);
        const bf16_t* pr = P + (size_t)row * NP;
        const int dp = (tl > 0) ? -NP : 0, dn = (tl < slen - 1) ? NP : 0;
        const float mpv = (tl > 0) ? 1.f : 0.f, mnv = (tl < slen - 1) ? 1.f : 0.f;
        u32x4 vc[2], vp[2], vn[2], gt[2];
#pragma unroll
        for (int j = 0; j < 2; ++j) { vc[j] = *(const u32x4*)(pr + C_RV + c0 + 8 * j); vp[j] = *(const u32x4*)(pr + dp + C_RV + c0 + 8 * j); vn[j] = *(const u32x4*)(pr + dn + C_RV + c0 + 8 * j); gt[j] = *(const u32x4*)(pr + C_RG + c0 + 8 * j); }
        const float bs = bonus[(size_t)row * 16 + h] + bonus[((size_t)M + row) * 16 + h];
        float sm = 0.f;
#pragma unroll
        for (int j = 0; j < 4; ++j) sm += (y[j][0] + y[j][1]) + (y[j][2] + y[j][3]);
        sm += dppmov<0xB1>(sm); sm += dppmov<0x4E>(sm);
        const float mean = sm * (1.f / 64.f);
        float sq = 0.f;
#pragma unroll
        for (int j = 0; j < 4; ++j) { y[j] = y[j] - mean; sq += (y[j][0] * y[j][0] + y[j][1] * y[j][1]) + (y[j][2] * y[j][2] + y[j][3] * y[j][3]); }
        sq += dppmov<0xB1>(sq); sq += dppmov<0x4E>(sq);
        const float rstd = rsqrtf(sq * (1.f / 64.f) + 64e-5f);
        u32x4 ov[2];
#pragma unroll
        for (int j = 0; j < 2; ++j) {
            float o8[8];
#pragma unroll
            for (int e = 0; e < 4; ++e) {
                const unsigned uc = vc[j][e], up = vp[j][e], un = vn[j][e], ug = gt[j][e];
                const int cc = 8 * j + 2 * e;
                const float g0 = gp[cc], g1 = gp[cc + 1], b0 = bp[cc], b1 = bp[cc + 1], m0 = mp[cc], m1 = mp[cc + 1];
                const float v0c = bflo(uc), v1c = bfhi(uc);
                const float v0 = v0c + m0 * (0.5f * (mpv * bflo(up) + mnv * bflo(un)) - v0c), v1 = v1c + m1 * (0.5f * (mpv * bfhi(up) + mnv * bfhi(un)) - v1c);
                const float ya = y[(cc >> 2)][cc & 3] * rstd * g0 + b0, yb = y[((cc + 1) >> 2)][(cc + 1) & 3] * rstd * g1 + b1;
                o8[2 * e] = (ya + bs * v0) * siluf(bflo(ug)); o8[2 * e + 1] = (yb + bs * v1) * siluf(bfhi(ug));
            }
            ov[j].x = pk2(o8[0], o8[1]); ov[j].y = pk2(o8[2], o8[3]); ov[j].z = pk2(o8[4], o8[5]); ov[j].w = pk2(o8[6], o8[7]);
        }
        *(u32x4*)(brw + (size_t)row * W + c0) = ov[0]; *(u32x4*)(brw + (size_t)row * W + c0 + 8) = ov[1];
    }
}

__device__ __forceinline__ void phase_final(const Args& a) {
    const int tid = otid(), lane = tid & 63, wv = tid >> 6;
    const int gw = blockIdx.x * 8 + wv, NGW = gridDim.x * 8;
    for (int row = gw; row < NB * T; row += NGW) {
        float* xr = a.out + (size_t)row * D;
        f32x4 v[8]; float ss = 0.f;
#pragma unroll
        for (int j = 0; j < 8; ++j) { v[j] = *(const f32x4*)(xr + 4 * lane + 256 * j); ss += (v[j][0] * v[j][0] + v[j][1] * v[j][1]) + (v[j][2] * v[j][2] + v[j][3] * v[j][3]); }
        ss = wave_sum(ss); const float rstd = rsqrtf(ss * (1.f / D) + 1e-6f);
#pragma unroll
        for (int j = 0; j < 8; ++j) { const int col = 4 * lane + 256 * j; const f32x4 g4 = *(const f32x4*)(a.final_g + col); *(f32x4*)(xr + col) = (v[j] * rstd) * g4; }
    }
}

__global__ void __launch_bounds__(512, 2) fwd_kernel(Args a) {
    extern __shared__ __attribute__((aligned(16))) unsigned char smem[];
    LAS unsigned char* lds = (LAS unsigned char*)smem;
    cg::grid_group grid = cg::this_grid();
    const int G = gridDim.x, c = blockIdx.x;
    for (int ph = a.ph_lo; ph < a.ph_hi; ++ph) {
        if (ph > a.ph_lo) grid.sync();
        if (ph == 0) { if (PH_MASK & 1) phase_mod(a, lds); continue; }
        if (ph == 13) { if (PH_MASK & 128) phase_final(a); continue; }
        const int layer = (ph - 1) / 6, sub = (ph - 1) % 6;
        int nrep = 1;
#ifdef REP_SUB
        if (sub == REP_SUB && ((REP_LAYERS >> layer) & 1)) nrep = 2;
#endif
        for (int rep = 0; rep < nrep; ++rep) {
        if (rep) grid.sync();
        bf16_t* P = (bf16_t*)(a.ws + WS_P);
        if (sub == 0) { if (PH_MASK & 2) phase_norm_convert(a, layer, lds); }
        else if (sub == 1) {
            Gemm g; g.A = (const bf16_t*)(a.ws + WS_H); g.Bt = (const bf16_t*)(a.ws + WS_WTIN); g.lda = D; g.ldb = D; g.K = D; g.a_z = 0; g.b_z = 0;
            g.nM = 68; g.nN = 65; g.nz = 1; g.latent_only = 0; g.G = G; g.c = c;
            EpiP e; e.P = P; if (PH_MASK & 4) gemm_phase(lds, g, e);
        } else if (sub == 2) { if (PH_MASK & 8) phase_mixers(a, layer, lds); }
        else if (sub == 3) {
            if (PH_MASK & 256) phase_readout(a, layer);
            Gemm g; g.A = (const bf16_t*)(a.ws + WS_DIFF); g.Bt = (const bf16_t*)(a.ws + WS_WTPL); g.lda = W; g.ldb = 256; g.K = 256; g.a_z = 256; g.b_z = 65536;
            g.nM = layer ? 64 : 68; g.nN = 1; g.nz = 4; g.latent_only = layer; g.G = G; g.c = c;
            EpiPool e; e.P = P; e.out = (bf16_t*)(a.ws + WS_BB) + (size_t)M * W; e.scale = a.pool_scale + layer * W; if (PH_MASK & 16) gemm_phase(lds, g, e);
        } else if (sub == 4) {
            Gemm g; g.A = (const bf16_t*)(a.ws + WS_BB); g.Bt = (const bf16_t*)(a.ws + WS_WTBR); g.lda = W; g.ldb = W; g.K = W; g.a_z = (size_t)M * W; g.b_z = (size_t)D * W;
            g.nM = layer ? 64 : 68; g.nN = 8; g.nz = 3; g.latent_only = layer; g.G = G; g.c = c;
            EpiMerge e; e.P = P; e.mf = (float*)(a.ws + WS_Y); e.mb = (bf16_t*)(a.ws + WS_H); if (PH_MASK & 32) gemm_phase(lds, g, e);
        } else {
            Gemm g; g.A = (const bf16_t*)(a.ws + WS_H); g.Bt = (const bf16_t*)(a.ws + WS_WTOUT); g.lda = D; g.ldb = D; g.K = D; g.a_z = 0; g.b_z = 0;
            g.nM = layer ? 64 : 68; g.nN = 8; g.nz = 1; g.latent_only = layer; g.G = G; g.c = c;
            EpiOut e; e.xl_old = layer ? (const float*)a.out : a.x; e.xc_old = layer ? (const float*)(a.ws + WS_XCTX) : a.ctx; e.xl_new = a.out; e.xc_new = (float*)(a.ws + WS_XCTX);
            e.mod = (const float*)(a.ws + WS_MOD) + layer * 5 * 6144; if (PH_MASK & 64) gemm_phase(lds, g, e);
        }
        }
    }
}

extern "C" void kernel_launch(void* const* d_in, const int* in_sizes, int n_in, void* d_out, int out_size, void* d_ws, size_t ws_size, hipStream_t stream) {
    static int grid = 0;
    if (grid == 0) {
        if (n_in != 24 || ws_size < WS_END) { fprintf(stderr, "kernel_launch: unexpected n_in %d or ws_size %zu (< %zu)\n", n_in, ws_size, (size_t)WS_END); grid = -1; return; }
        int dev = 0, cus = 0, per_cu = 0;
        hipGetDevice(&dev); hipDeviceGetAttribute(&cus, hipDeviceAttributeMultiprocessorCount, dev);
        if (hipFuncSetAttribute((const void*)fwd_kernel, hipFuncAttributeMaxDynamicSharedMemorySize, LDS_BYTES) != hipSuccess) { fprintf(stderr, "kernel_launch: hipFuncSetAttribute failed\n"); grid = -1; return; }
        hipOccupancyMaxActiveBlocksPerMultiprocessor(&per_cu, (const void*)fwd_kernel, 512, LDS_BYTES);
        if (per_cu < 1) { fprintf(stderr, "kernel_launch: occupancy query says %d\n", per_cu); per_cu = 1; }
        (void)hipGetLastError();
        grid = cus;
    }
    if (grid < 0) return;
    hipMemsetAsync((char*)d_ws + WS_MOD, 0, WS_MOD_BYTES, stream);
    Args a{};
    const float** pp = (const float**)&a;
    for (int i = 0; i < 24; ++i) pp[i] = (const float*)d_in[i];
    a.out = (float*)d_out; a.ws = (unsigned char*)d_ws;
#if N_LAUNCH_PER_PHASE
    for (int ph = 0; ph < NPHASE; ++ph) {
        a.ph_lo = ph; a.ph_hi = ph + 1;
        void* args[] = {&a};
        hipError_t e = hipLaunchCooperativeKernel((const void*)fwd_kernel, dim3(grid), dim3(512), args, LDS_BYTES, stream);
        if (e != hipSuccess) { fprintf(stderr, "cooperative launch failed: %s\n", hipGetErrorString(e)); break; }
    }
#else
    a.ph_lo = 0; a.ph_hi = NPHASE;
    void* args[] = {&a};
    hipError_t e = hipLaunchCooperativeKernel((const void*)fwd_kernel, dim3(grid), dim3(512), args, LDS_BYTES, stream);
    if (e != hipSuccess) fprintf(stderr, "cooperative launch failed: %s (grid %d)\n", hipGetErrorString(e), grid);
#endif
}
```

```cpp
#include <hip/hip_runtime.h>
#include <hip/hip_cooperative_groups.h>
#include <cstdio>
namespace cg = cooperative_groups;

#ifndef N_LAUNCH_PER_PHASE
#define N_LAUNCH_PER_PHASE 0
#endif

#ifndef REP_LAYERS
#define REP_LAYERS 3
#endif
#ifndef PH_MASK
#define PH_MASK 0xffff
#endif
#define LAS __attribute__((address_space(3)))
typedef unsigned short bf16_t;
typedef short bf16x8 __attribute__((ext_vector_type(8)));
typedef float f32x4 __attribute__((ext_vector_type(4)));
typedef unsigned u32x4 __attribute__((ext_vector_type(4)));
typedef unsigned u32x2 __attribute__((ext_vector_type(2)));

constexpr int D = 2048, NB = 4, T = 4096, LC = 256, TT = 4352, M = 17408, W = 1024, NP = 16640;
constexpr int C_Q = 0, C_K = 1024, C_V = 2048, C_NAG = 3072, C_PU = 4096, C_PG = 5120, C_RR = 6144, C_RK = 7168, C_RV = 8192, C_RG = 9216,
              C_MG = 10240, C_LW = 16384, C_LA = 16448;
constexpr int NPHASE = 14;
constexpr int LDS_BYTES = 163840;

constexpr size_t WS_MOD = 0, WS_MOD_BYTES = 262144;
constexpr size_t WS_BONUS = WS_MOD + WS_MOD_BYTES;
constexpr size_t WS_XCTX = WS_BONUS + 2359296;
constexpr size_t WS_WTIN = WS_XCTX + (size_t)NB * LC * D * 4;
constexpr size_t WS_WTBR = WS_WTIN + (size_t)NP * D * 2;
constexpr size_t WS_WTOUT = WS_WTBR + (size_t)3 * D * W * 2;
constexpr size_t WS_WTPL = WS_WTOUT + (size_t)D * D * 2;
constexpr size_t WS_H = WS_WTPL + (size_t)4 * 256 * 256 * 2;
constexpr size_t WS_Y = WS_H + (size_t)M * D * 2;
constexpr size_t WS_BB = WS_Y + (size_t)2 * M * W * 4;
constexpr size_t WS_DIFF = WS_BB + (size_t)3 * M * W * 2;
constexpr size_t WS_P = WS_DIFF + (size_t)M * W * 2;
constexpr size_t WS_END = WS_P + (size_t)M * NP * 2;

struct Args {
    const float *x, *c, *ctx, *c_ctx, *norm_g, *w_mod, *b_mod, *w_in, *na_rpb, *pool_w, *pool_scale, *rw_mu, *rw_w0, *rw_w2, *rw_a0, *rw_a2, *rw_k_k,
        *rw_k_a, *rw_r_k, *rw_lnx_g, *rw_lnx_b, *w_branch, *w_out, *final_g;
    float* out;
    unsigned char* ws;
    int ph_lo, ph_hi;
};

__device__ __forceinline__ float bf2f(bf16_t v) { return __uint_as_float(((unsigned)v) << 16); }
__device__ __forceinline__ float bflo(unsigned u) { return __uint_as_float(u << 16); }
__device__ __forceinline__ float bfhi(unsigned u) { return __uint_as_float(u & 0xffff0000u); }
typedef float f32x2 __attribute__((ext_vector_type(2)));
typedef __bf16 bf16x2_t __attribute__((ext_vector_type(2)));
__device__ __forceinline__ unsigned pk2(float lo, float hi) { const f32x2 v = {lo, hi}; const bf16x2_t b = __builtin_convertvector(v, bf16x2_t); return __builtin_bit_cast(unsigned, b); }
__device__ __forceinline__ float wave_sum(float v) {
#pragma unroll
    for (int o = 1; o < 64; o <<= 1) v += __shfl_xor(v, o);
    return v;
}
template <int CTRL> __device__ __forceinline__ float dppmov(float v) { return __int_as_float(__builtin_amdgcn_update_dpp(0, __float_as_int(v), CTRL, 0xF, 0xF, true)); }
__device__ __forceinline__ float sum8(float v) { v += dppmov<0xB1>(v); v += dppmov<0x4E>(v); v += dppmov<0x141>(v); return v; }
__device__ __forceinline__ float frcp(float x) { return __builtin_amdgcn_rcpf(x); }
__device__ __forceinline__ float siluf(float x) { return x * frcp(1.f + __expf(-x)); }
__device__ __forceinline__ float sigmf(float x) { return frcp(1.f + __expf(-x)); }
__device__ __forceinline__ int otid() { int t = threadIdx.x; asm volatile("" : "+v"(t)); return t; }
__device__ __forceinline__ void lds_wait() { asm volatile("s_waitcnt lgkmcnt(0)" ::: "memory"); }

constexpr int BM = 256, BK = 64, HALF = 128, HTB = HALF * BK * 2, NXCD = 8, WGM = 8;
__device__ __forceinline__ int lds_byte(int r, int c) { const int st = (r >> 4) * 2 + (c >> 5), rr = r & 15, cc = c & 31, ob = rr * 64 + cc * 2; return st * 1024 + (ob ^ (((ob >> 9) & 1) << 5)); }
__device__ __forceinline__ void stage_rc(int b, int& R, int& C) { const int st = b / 1024, sb = b % 1024, swz = sb ^ (((sb >> 9) & 1) << 5); R = (st >> 1) * 16 + swz / 64; C = (st & 1) * 32 + (swz % 64) / 2; }
__device__ __forceinline__ int perm32(int rho) { const int n = rho >> 4, i = rho & 15; return 8 * (i >> 2) + 4 * n + (i & 3); }

struct Unit { int pm, pn, z; };
struct Gemm {
    const bf16_t* A; const bf16_t* Bt; int lda, ldb, K; size_t a_z, b_z;
    int nM, nN, nz, latent_only, G, c;
    int zmul, zadd;
    int chain, chain_pm, chain_n, chain_zvar;
    __device__ bool next(int i, Unit& u) const {
        if (chain) { if (i >= chain_n) return false; u.pm = chain_pm; u.pn = chain_zvar ? 0 : i; u.z = chain_zvar ? i : zadd; return true; }
        const int zi0 = i % nz, r = i / nz; const int zi = zi0 * zmul + zadd; const long L = (long)r * G + c; const int nwg = nM * nN; if (L >= nwg) return false;
        int wgid = (int)L; { const int q = nwg / NXCD, rr = nwg % NXCD, xcd = wgid % NXCD, off = wgid / NXCD; wgid = (xcd < rr ? xcd * (q + 1) : rr * (q + 1) + (xcd - rr) * q) + off; }
        const int nig = WGM * nN, gid = wgid / nig, fm = gid * WGM, gsz = (nM - fm) < WGM ? (nM - fm) : WGM;
        int pm = fm + ((wgid % nig) % gsz); u.pn = (wgid % nig) / gsz; u.z = zi;
        u.pm = latent_only ? (pm / 16) * 17 + 1 + (pm % 16) : pm; return true;
    }
};

template <class Epi>
__device__ __forceinline__ void gemm_phase(LAS unsigned char* lds, const Gemm g, const Epi& E) {
    const int tid = otid(), wid = __builtin_amdgcn_readfirstlane(tid >> 6), lane = tid & 63, wr = wid >> 2, wc = wid & 3, fr = lane & 15, fq = lane >> 4;
    const int K = g.K, nt = K / BK;
    unsigned voffA[2], voffB[2];
#pragma unroll
    for (int i = 0; i < 2; ++i) { int R, C; stage_rc(tid * 16 + i * 8192, R, C); const int Rb = Epi::PERM ? ((R & ~31) + perm32(R & 31)) : R;
        voffA[i] = (unsigned)(R * g.lda + C) * 2u; voffB[i] = (unsigned)(Rb * g.ldb + C) * 2u; }
    const size_t kstep = (size_t)(BK * 2);
    const size_t hstepA = (size_t)HALF * g.lda * 2, hstepB = (size_t)HALF * g.ldb * 2;
    const unsigned ldsw = (unsigned)wid * 1024u;
    const int aoff = lds_byte(wr * 64 + fr, fq * 8), boff = lds_byte(wc * 32 + fr, fq * 8);
#define PG8_SA(b, h) (((b) * 2 + (h)) * HTB)
#define PG8_SB(b, h) ((4 + (b) * 2 + (h)) * HTB)
#define PG8_STAGE(bufoff, gbase, voff) do { _Pragma("unroll") for (int _i = 0; _i < 2; ++_i) \
        __builtin_amdgcn_global_load_lds((const unsigned*)((const char*)(gbase) + (voff)[_i]), (LAS unsigned*)(lds + (bufoff) + ldsw + _i * 8192), 16, 0, 0); } while (0)
#define PG8_LDA(dst, b, h) do { _Pragma("unroll") for (int m = 0; m < 4; ++m) _Pragma("unroll") for (int k = 0; k < 2; ++k) dst[m][k] = *(const LAS bf16x8*)(lds + PG8_SA(b, h) + aoff + m * 2048 + k * 1024); } while (0)
#define PG8_LDB(dst, b, h) do { _Pragma("unroll") for (int n = 0; n < 2; ++n) _Pragma("unroll") for (int k = 0; k < 2; ++k) dst[n][k] = *(const LAS bf16x8*)(lds + PG8_SB(b, h) + boff + n * 2048 + k * 1024); } while (0)
#define PG8_MMA(ai, bj, At, Bt) do { __builtin_amdgcn_s_setprio(1); _Pragma("unroll") for (int m = 0; m < 4; ++m) _Pragma("unroll") for (int n = 0; n < 2; ++n) _Pragma("unroll") for (int k = 0; k < 2; ++k) \
        acc[ai][bj][m][n] = __builtin_amdgcn_mfma_f32_16x16x32_bf16(Bt[n][k], At[m][k], acc[ai][bj][m][n], 0, 0, 0); __builtin_amdgcn_s_setprio(0); } while (0)
#define PG8_WAIT_V(n) asm volatile("s_waitcnt vmcnt(" #n ")" ::: "memory")
#define PG8_WAIT_L(n) asm volatile("s_waitcnt lgkmcnt(" #n ")" ::: "memory")
#define PG8_BAR __builtin_amdgcn_s_barrier()
#define PG8_SCHED __builtin_amdgcn_sched_barrier(0)
    Unit cur, nxt; int ui = 0;
    if (!g.next(0, cur)) return;
    f32x4 acc[2][2][4][2];
#pragma unroll
    for (int a = 0; a < 2; ++a)
#pragma unroll
        for (int b = 0; b < 2; ++b)
#pragma unroll
            for (int m = 0; m < 4; ++m)
#pragma unroll
                for (int n = 0; n < 2; ++n) acc[a][b][m][n] = (f32x4){0.f, 0.f, 0.f, 0.f};
    bf16x8 At[4][2], B0[2][2], B1[2][2];
    const char* cA = (const char*)(g.A + cur.z * g.a_z + (size_t)cur.pm * BM * g.lda); const char* cB = (const char*)(g.Bt + cur.z * g.b_z + (size_t)cur.pn * BM * g.ldb);
    PG8_STAGE(PG8_SB(0, 0), cB, voffB); PG8_STAGE(PG8_SA(0, 0), cA, voffA); PG8_STAGE(PG8_SB(0, 1), cB + hstepB, voffB); PG8_STAGE(PG8_SA(0, 1), cA + hstepA, voffA);
    if (wr == 1) PG8_BAR;
    PG8_WAIT_V(4); PG8_BAR;
    PG8_STAGE(PG8_SB(1, 0), cB + kstep, voffB); PG8_STAGE(PG8_SA(1, 0), cA + kstep, voffA); PG8_STAGE(PG8_SB(1, 1), cB + hstepB + kstep, voffB);
    PG8_WAIT_V(6); PG8_BAR;
    for (;;) {
        const bool has_next = g.next(ui + 1, nxt);
        const char* nA = has_next ? (const char*)(g.A + nxt.z * g.a_z + (size_t)nxt.pm * BM * g.lda) : cA;
        const char* nB = has_next ? (const char*)(g.Bt + nxt.z * g.b_z + (size_t)nxt.pn * BM * g.ldb) : cB;
        for (int t = 0; t < nt; t += 2) {
            const bool last = (t == nt - 2);
            const char* a1 = cA + (size_t)(t + 1) * kstep;
            const char* a2 = last ? nA : cA + (size_t)(t + 2) * kstep; const char* b2 = last ? nB : cB + (size_t)(t + 2) * kstep;
            const char* a3 = a2 + kstep; const char* b3 = b2 + kstep;
            PG8_LDB(B0, 0, 0); PG8_SCHED; PG8_LDA(At, 0, 0); PG8_STAGE(PG8_SA(1, 1), a1 + hstepA, voffA);
            PG8_WAIT_L(8); PG8_BAR; PG8_WAIT_L(0); PG8_MMA(0, 0, At, B0); PG8_BAR; PG8_SCHED;
            PG8_LDB(B1, 0, 1); PG8_STAGE(PG8_SB(0, 0), b2, voffB);
            PG8_BAR; PG8_WAIT_L(0); PG8_MMA(0, 1, At, B1); PG8_BAR;
            PG8_LDA(At, 0, 1); PG8_STAGE(PG8_SA(0, 0), a2, voffA);
            PG8_BAR; PG8_WAIT_L(0); PG8_MMA(1, 0, At, B0); PG8_BAR; PG8_SCHED;
            PG8_STAGE(PG8_SB(0, 1), b2 + hstepB, voffB);
            PG8_WAIT_V(6); PG8_BAR; PG8_MMA(1, 1, At, B1); PG8_BAR;
            PG8_LDB(B0, 1, 0); PG8_SCHED; PG8_LDA(At, 1, 0); PG8_STAGE(PG8_SA(0, 1), a2 + hstepA, voffA);
            PG8_WAIT_L(8); PG8_BAR; PG8_WAIT_L(0); PG8_MMA(0, 0, At, B0); PG8_BAR; PG8_SCHED;
            PG8_LDB(B1, 1, 1); PG8_STAGE(PG8_SB(1, 0), b3, voffB);
            PG8_BAR; PG8_WAIT_L(0); PG8_MMA(0, 1, At, B1); PG8_BAR;
            PG8_LDA(At, 1, 1); PG8_STAGE(PG8_SA(1, 0), a3, voffA);
            PG8_BAR; PG8_WAIT_L(0); PG8_MMA(1, 0, At, B0); PG8_BAR; PG8_SCHED;
            PG8_STAGE(PG8_SB(1, 1), b3 + hstepB, voffB);
            PG8_WAIT_V(6); PG8_BAR; PG8_MMA(1, 1, At, B1); PG8_BAR;
        }
        E(acc, cur, wr, wc, fr, fq);
        if (!has_next) break;
#pragma unroll
        for (int a = 0; a < 2; ++a)
#pragma unroll
            for (int b = 0; b < 2; ++b)
#pragma unroll
                for (int m = 0; m < 4; ++m)
#pragma unroll
                    for (int n = 0; n < 2; ++n) acc[a][b][m][n] = (f32x4){0.f, 0.f, 0.f, 0.f};
        cur = nxt; cA = nA; cB = nB; ++ui;
    }
    PG8_WAIT_V(0);
    if (wr == 0) PG8_BAR;
    PG8_BAR;
#undef PG8_SA
#undef PG8_SB
#undef PG8_STAGE
#undef PG8_LDA
#undef PG8_LDB
#undef PG8_MMA
#undef PG8_WAIT_V
#undef PG8_WAIT_L
#undef PG8_BAR
#undef PG8_SCHED
}

struct EpiP {
    static constexpr bool PERM = true;
    bf16_t* P;
    __device__ __forceinline__ void operator()(const f32x4 (&acc)[2][2][4][2], const Unit& u, int wr, int wc, int fr, int fq) const {
        const int row0 = u.pm * BM + wr * 64 + fr, col0 = u.pn * BM + wc * 32 + 8 * fq;
#pragma unroll
        for (int ai = 0; ai < 2; ++ai)
#pragma unroll
            for (int m = 0; m < 4; ++m) { bf16_t* rowp = P + (size_t)(row0 + ai * HALF + m * 16) * NP + col0;
#pragma unroll
                for (int bj = 0; bj < 2; ++bj) { const f32x4 v0 = acc[ai][bj][m][0], v1 = acc[ai][bj][m][1];
                    u32x4 o; o.x = pk2(v0[0], v0[1]); o.y = pk2(v0[2], v0[3]); o.z = pk2(v1[0], v1[1]); o.w = pk2(v1[2], v1[3]);
                    *(u32x4*)(rowp + bj * HALF) = o; } }
    }
};
struct EpiPool {
    static constexpr bool PERM = true;
    const bf16_t* P; bf16_t* out; const float* scale;
    __device__ __forceinline__ void operator()(const f32x4 (&acc)[2][2][4][2], const Unit& u, int wr, int wc, int fr, int fq) const {
        const int row0 = u.pm * BM + wr * 64 + fr, col0 = u.z * 256 + wc * 32 + 8 * fq;
#pragma unroll
        for (int ai = 0; ai < 2; ++ai)
#pragma unroll
            for (int m = 0; m < 4; ++m) { const size_t row = (size_t)(row0 + ai * HALF + m * 16);
#pragma unroll
                for (int bj = 0; bj < 2; ++bj) { const int col = col0 + bj * HALF; const f32x4 v0 = acc[ai][bj][m][0], v1 = acc[ai][bj][m][1];
                    const u32x4 gt = *(const u32x4*)(P + row * NP + C_PG + col);
                    const f32x4 s0 = *(const f32x4*)(scale + col), s1 = *(const f32x4*)(scale + col + 4);
                    u32x4 o;
                    o.x = pk2(v0[0] * s0[0] * siluf(bflo(gt.x)), v0[1] * s0[1] * siluf(bfhi(gt.x)));
                    o.y = pk2(v0[2] * s0[2] * siluf(bflo(gt.y)), v0[3] * s0[3] * siluf(bfhi(gt.y)));
                    o.z = pk2(v1[0] * s1[0] * siluf(bflo(gt.z)), v1[1] * s1[1] * siluf(bfhi(gt.z)));
                    o.w = pk2(v1[2] * s1[2] * siluf(bflo(gt.w)), v1[3] * s1[3] * siluf(bfhi(gt.w)));
                    *(u32x4*)(out + row * W + col) = o; } }
    }
};
struct EpiMerge {
    static constexpr bool PERM = false;
    const bf16_t* P; float* mf; bf16_t* mb;
    __device__ __forceinline__ void operator()(const f32x4 (&acc)[2][2][4][2], const Unit& u, int wr, int wc, int fr, int fq) const {
        const int row0 = u.pm * BM + wr * 64 + fr, col0 = u.pn * BM + wc * 32 + 4 * fq;
        const int zz = u.z;
        f32x4 old[4]; u32x2 lg[4];
#define EM_LOAD(it_, old_, lg_) do { const size_t row_ = (size_t)(row0 + ((it_) >> 2) * HALF + ((it_) & 3) * 16); \
            _Pragma("unroll") for (int q_ = 0; q_ < 4; ++q_) { const int col_ = col0 + (q_ >> 1) * HALF + (q_ & 1) * 16; \
                lg_[q_] = *(const u32x2*)(P + row_ * NP + C_MG + zz * D + col_); \
                if (zz == 2) old_[q_] = *(const f32x4*)(mf + row_ * D + col_); \
                else if (zz == 0) { const u32x2 ob_ = *(const u32x2*)(mb + row_ * D + col_); old_[q_] = (f32x4){bflo(ob_.x), bfhi(ob_.x), bflo(ob_.y), bfhi(ob_.y)}; } \
                else old_[q_] = (f32x4){0.f, 0.f, 0.f, 0.f}; } } while (0)
        EM_LOAD(0, old, lg);
#pragma unroll
        for (int it = 0; it < 8; ++it) {
            f32x4 oldn[4]; u32x2 lgn[4];
            if (it < 7) EM_LOAD(it + 1, oldn, lgn);
            const int ai = it >> 2, m = it & 3; const size_t row = (size_t)(row0 + ai * HALF + m * 16);
#pragma unroll
            for (int q = 0; q < 4; ++q) { const int bj = q >> 1, n = q & 1; const int col = col0 + bj * HALF + n * 16; const f32x4 v = acc[ai][bj][m][n];
                f32x4 r; r[0] = v[0] * sigmf(bflo(lg[q].x)); r[1] = v[1] * sigmf(bfhi(lg[q].x)); r[2] = v[2] * sigmf(bflo(lg[q].y)); r[3] = v[3] * sigmf(bfhi(lg[q].y));
                r += old[q];
                if (zz == 0) *(f32x4*)(mf + row * D + col) = r;
                else { u32x2 o; o.x = pk2(r[0], r[1]); o.y = pk2(r[2], r[3]); *(u32x2*)(mb + row * D + col) = o; } }
            if (it < 7) {
#pragma unroll
                for (int q = 0; q < 4; ++q) { old[q] = oldn[q]; lg[q] = lgn[q]; } }
        }
#undef EM_LOAD
    }
};
struct EpiOut {
    static constexpr bool PERM = false;
    const float* xl_old; const float* xc_old; float* xl_new; float* xc_new; const float* mod;
    __device__ __forceinline__ void operator()(const f32x4 (&acc)[2][2][4][2], const Unit& u, int wr, int wc, int fr, int fq) const {
        const int b = u.pm / 17, tl = u.pm % 17; const bool isc = (tl == 0);
        const float* xo = isc ? xc_old + (size_t)b * LC * D : xl_old + ((size_t)b * T + (tl - 1) * 256) * D;
        float* xn = isc ? xc_new + (size_t)b * LC * D : xl_new + ((size_t)b * T + (tl - 1) * 256) * D;
        const float* gp = mod + (isc ? 4 : b) * 6144 + 4096;
        const int row0 = wr * 64 + fr, col0 = u.pn * BM + wc * 32 + 4 * fq;
        f32x4 gt[4];
#pragma unroll
        for (int q = 0; q < 4; ++q) gt[q] = *(const f32x4*)(gp + col0 + (q >> 1) * HALF + (q & 1) * 16);
        f32x4 old[4];
#define EO_LOAD(it_, old_) do { const size_t off_ = (size_t)(row0 + ((it_) >> 2) * HALF + ((it_) & 3) * 16) * D + col0; \
            _Pragma("unroll") for (int q_ = 0; q_ < 4; ++q_) old_[q_] = *(const f32x4*)(xo + off_ + (q_ >> 1) * HALF + (q_ & 1) * 16); } while (0)
        EO_LOAD(0, old);
#pragma unroll
        for (int it = 0; it < 8; ++it) {
            f32x4 oldn[4];
            if (it < 7) EO_LOAD(it + 1, oldn);
            const int ai = it >> 2, m = it & 3; const size_t off = (size_t)(row0 + ai * HALF + m * 16) * D + col0;
#pragma unroll
            for (int q = 0; q < 4; ++q) *(f32x4*)(xn + off + (q >> 1) * HALF + (q & 1) * 16) = old[q] + gt[q] * acc[ai][q >> 1][m][q & 1];
            if (it < 7) {
#pragma unroll
                for (int q = 0; q < 4; ++q) old[q] = oldn[q]; }
        }
#undef EO_LOAD
    }
};

__device__ __forceinline__ void phase_mod(const Args& a, LAS unsigned char* lds) {
    const int tidm = otid();
    LAS float* s = (LAS float*)lds;
    float* modp = (float*)(a.ws + WS_MOD);
    for (int task = blockIdx.x; task < 192; task += gridDim.x) {
        const int l = task / 96, rem = task % 96, cb = rem >> 3, kc = rem & 7, k0 = kc * 256;
        __syncthreads();
        for (int i = tidm; i < 5 * 256; i += 512) { const int r = i >> 8, k = i & 255; const float c = (r < 4) ? a.c[r * D + k0 + k] : a.c_ctx[k0 + k]; s[i] = c / (1.f + expf(-c)); }
        __syncthreads();
        const int n = cb * 512 + tidm;
        const float* w = a.w_mod + (size_t)l * D * 6144 + (size_t)k0 * 6144 + n;
        float a0 = 0.f, a1 = 0.f, a2 = 0.f, a3 = 0.f, a4 = 0.f;
#pragma unroll 8
        for (int k = 0; k < 256; ++k) { const float wv = w[(size_t)k * 6144]; a0 += s[k] * wv; a1 += s[256 + k] * wv; a2 += s[512 + k] * wv; a3 += s[768 + k] * wv; a4 += s[1024 + k] * wv; }
        float* mo = modp + l * 5 * 6144 + n;
        const float bias = (kc == 0) ? a.b_mod[l * 6144 + n] : 0.f;
        atomicAdd(mo, a0 + bias); atomicAdd(mo + 6144, a1 + bias); atomicAdd(mo + 2 * 6144, a2 + bias); atomicAdd(mo + 3 * 6144, a3 + bias); atomicAdd(mo + 4 * 6144, a4 + bias);
    }
}

__device__ __forceinline__ void transpose_item(const float* Wsrc, int ldsrc, int k0, int nsrc0, bf16_t* dst, int ldd, LAS float* scr, int lane) {
    if (nsrc0 >= 0) {
#pragma unroll 8
        for (int i = 0; i < 32; ++i) { const int kk = 2 * i + (lane >> 5); scr[kk * 33 + (lane & 31)] = Wsrc[(size_t)(k0 + kk) * ldsrc + nsrc0 + (lane & 31)]; }
    } else {
#pragma unroll 8
        for (int i = 0; i < 32; ++i) { const int kk = 2 * i + (lane >> 5); scr[kk * 33 + (lane & 31)] = 0.f; }
    }
    lds_wait();
    const int c = lane & 7;
#pragma unroll
    for (int j = 0; j < 4; ++j) { const int n = (lane >> 3) + 8 * j; const LAS float* s = scr + (8 * c) * 33 + n;
        u32x4 o; o.x = pk2(s[0 * 33], s[1 * 33]); o.y = pk2(s[2 * 33], s[3 * 33]); o.z = pk2(s[4 * 33], s[5 * 33]); o.w = pk2(s[6 * 33], s[7 * 33]);
        *(u32x4*)(dst + (size_t)n * ldd + k0 + 8 * c) = o; }
    lds_wait();
}
__device__ __forceinline__ void phase_norm_convert(const Args& a, int layer, LAS unsigned char* lds) {
    const int tid = otid(), lane = tid & 63, wv = tid >> 6;
    const int gw = blockIdx.x * 8 + wv, NGW = gridDim.x * 8;
    {
        LAS float* scr = (LAS float*)(lds + wv * 8448);
        bf16_t* wtin = (bf16_t*)(a.ws + WS_WTIN); bf16_t* wtbr = (bf16_t*)(a.ws + WS_WTBR); bf16_t* wtout = (bf16_t*)(a.ws + WS_WTOUT); bf16_t* wtpl = (bf16_t*)(a.ws + WS_WTPL);
        constexpr int I_IN = 32 * 520, I_BR = 16 * 64, I_OUT = 32 * 64, I_PL = 4 * 8;
        constexpr int NIT = I_IN + 3 * I_BR + I_OUT + 4 * I_PL;
        for (int it = gw; it < NIT; it += NGW) {
            int r = it;
            if (r < I_IN) { const int kb = r / 520, nb = r % 520, n0 = nb * 32; const int ns = n0 < 10240 ? n0 : (n0 < 16384 ? n0 + 128 : (n0 < 16512 ? n0 - 6144 : -1));
                transpose_item(a.w_in + (size_t)layer * D * 16512, 16512, kb * 64, ns, wtin + (size_t)n0 * D, D, scr, lane); continue; }
            r -= I_IN;
            if (r < 3 * I_BR) { const int z = r / I_BR, q = r % I_BR, kb = q / 64, nb = q % 64;
                transpose_item(a.w_branch + ((size_t)layer * 3 + z) * W * D, D, kb * 64, nb * 32, wtbr + (size_t)z * D * W + (size_t)nb * 32 * W, W, scr, lane); continue; }
            r -= 3 * I_BR;
            if (r < I_OUT) { const int kb = r / 64, nb = r % 64;
                transpose_item(a.w_out + (size_t)layer * D * D, D, kb * 64, nb * 32, wtout + (size_t)nb * 32 * D, D, scr, lane); continue; }
            r -= I_OUT;
            { const int z = r / I_PL, q = r % I_PL, kb = q / 8, nb = q % 8;
                transpose_item(a.pool_w + ((size_t)layer * 4 + z) * 65536, 256, kb * 64, nb * 32, wtpl + (size_t)z * 65536 + (size_t)nb * 32 * 256, 256, scr, lane); }
        }
    }
    const float* ng = a.norm_g + layer * D;
    const float* mo = (const float*)(a.ws + WS_MOD) + layer * 5 * 6144;
    const float* xctx = (const float*)(a.ws + WS_XCTX);
    bf16_t* h = (bf16_t*)(a.ws + WS_H);
    for (int row = gw; row < M; row += NGW) {
        const int b = row / TT, t = row % TT; const float* xr; int mr;
        if (t < LC) { xr = (layer == 0 ? a.ctx : xctx) + (size_t)(b * LC + t) * D; mr = 4; }
        else { xr = (layer == 0 ? a.x : (const float*)a.out) + (size_t)(b * T + t - LC) * D; mr = b; }
        f32x4 v[8]; float ss = 0.f;
#pragma unroll
        for (int j = 0; j < 8; ++j) { v[j] = *(const f32x4*)(xr + 4 * lane + 256 * j); ss += (v[j][0] * v[j][0] + v[j][1] * v[j][1]) + (v[j][2] * v[j][2] + v[j][3] * v[j][3]); }
        ss = wave_sum(ss); const float rstd = rsqrtf(ss * (1.f / D) + 1e-6f);
        const float* mrow = mo + mr * 6144;
#pragma unroll
        for (int j = 0; j < 8; ++j) { const int col = 4 * lane + 256 * j; const f32x4 g4 = *(const f32x4*)(ng + col), sh = *(const f32x4*)(mrow + col), sc = *(const f32x4*)(mrow + 2048 + col);
            f32x4 o = (v[j] * rstd) * g4; o = o * (sc + 1.f) + sh;
            u32x2 pk; pk.x = pk2(o[0], o[1]); pk.y = pk2(o[2], o[3]); *(u32x2*)(h + (size_t)row * D + col) = pk; }
    }
}

__device__ __forceinline__ float wsum(float v) {
    v += dppmov<0xB1>(v); v += dppmov<0x4E>(v); v += dppmov<0x141>(v); v += dppmov<0x140>(v);
    const int iv = __float_as_int(v);
    return (__int_as_float(__builtin_amdgcn_readlane(iv, 0)) + __int_as_float(__builtin_amdgcn_readlane(iv, 16))) +
           (__int_as_float(__builtin_amdgcn_readlane(iv, 32)) + __int_as_float(__builtin_amdgcn_readlane(iv, 48)));
}
__device__ __forceinline__ bf16_t f2bf(float x) { return (bf16_t)(pk2(x, x) & 0xffffu); }
__device__ __forceinline__ bf16x8 ldsfrag(const LAS bf16_t* p) { return *(const LAS bf16x8*)p; }
#define MFMA16(a_, b_, c_) __builtin_amdgcn_mfma_f32_16x16x32_bf16(a_, b_, c_, 0, 0, 0)

__device__ __forceinline__ void scan_item(const Args& a, int layer, int item, LAS unsigned char* lds) {
    const int tid = otid(), lane = tid & 63, wv = __builtin_amdgcn_readfirstlane(tid >> 6), fr = lane & 15, fq = lane >> 4;
    const int b = item >> 5, h = (item >> 1) & 15, dir = item & 1;
    LAS float* N1t = (LAS float*)lds;
    LAS float* gC = N1t + 1152;
    LAS bf16_t* N1b = (LAS bf16_t*)(gC + 64);
    LAS bf16_t* T11r = N1b + 640;
    LAS bf16_t* Gt = T11r + 640;
    LAS bf16_t* At = Gt + 640;
    LAS bf16_t* Bn = At + 2304;
    LAS bf16_t* Kn = Bn + 2304;
    LAS bf16_t* Rt = Kn + 2304;
    LAS bf16_t* BpT = Rt + 2304;
    LAS bf16_t* KpT = BpT + 2560;
    LAS bf16_t* Vt = KpT + 2560;
    LAS bf16_t* M2t = Vt + 2560;
    LAS bf16_t* M3t = M2t + 1280;
    LAS bf16_t* M4t = M3t + 1280;
    LAS bf16_t* Tmt = M4t + 1280;
    LAS bf16_t* Xs = Tmt + 1280;
    LAS bf16_t* Us = Xs + 2560;
    LAS float* WPs = (LAS float*)(Us + 2560);
    LAS float* APs = WPs + 2176;
    LAS float* LD = APs + 2176;
    LAS bf16_t* W2T = (LAS bf16_t*)(LD + 2048);
    LAS bf16_t* A2T = W2T + 4608;
    LAS bf16_t* LWb = A2T + 4608;
    LAS bf16_t* LAb = LWb + 2304;
    LAS bf16_t* S0s = LAb + 2304;
    LAS bf16_t* RAW = S0s + 9216;
    LAS float* Ys = WPs;
    const bf16_t* P = (const bf16_t*)(a.ws + WS_P);
    float* ybuf = (float*)(a.ws + WS_Y);
    float* bonus = (float*)(a.ws + WS_BONUS);
    __syncthreads();
    {
        const float* w2 = a.rw_w2 + ((size_t)(layer * 2 + dir) * 64) * W + h * 64;
        const float* a2 = a.rw_a2 + ((size_t)(layer * 2 + dir) * 64) * W + h * 64;
        for (int i = tid; i < 4096; i += 512) { const int l = i >> 6, c = i & 63; W2T[c * 72 + l] = f2bf(w2[l * W + c]); A2T[c * 72 + l] = f2bf(a2[l * W + c]); }
        for (int i = tid; i < 4608; i += 512) ((LAS unsigned*)S0s)[i] = 0u;
    }
    const int ch = h * 64 + lane;
    const float mu_r = a.rw_mu[(layer * 3 + 0) * W + ch], mu_k = a.rw_mu[(layer * 3 + 1) * W + ch], mu_v = a.rw_mu[(layer * 3 + 2) * W + ch];
    const float w0 = a.rw_w0[(layer * 2 + dir) * W + ch], a0 = a.rw_a0[(layer * 2 + dir) * W + ch];
    const float kk_c = a.rw_k_k[layer * W + ch], ka_c = a.rw_k_a[layer * W + ch], rk_c = a.rw_r_k[layer * W + ch];
    f32x4 Sacc[2];
    Sacc[0] = (f32x4){0.f, 0.f, 0.f, 0.f}; Sacc[1] = (f32x4){0.f, 0.f, 0.f, 0.f};
    int cur = 0;
    const int tt = wv >> 2, it = wv & 3;
    const bf16x8 zfrag = (bf16x8){0, 0, 0, 0, 0, 0, 0, 0};
#define SBAR() do { asm volatile("s_waitcnt lgkmcnt(0)" ::: "memory"); __builtin_amdgcn_s_barrier(); asm volatile("" ::: "memory"); } while (0)
#define SCAN_LOAD(dst, gcx) do { const int g_ = (gcx) < 136 ? (gcx) : 135; const int sg_ = g_ >= 8; const int sl_ = sg_ ? T : LC; const int rb_ = b * TT + (sg_ ? LC : 0); const int ck_ = sg_ ? g_ - 8 : g_; \
        const int tlo_ = dir ? (sl_ - 32 * (ck_ + 1)) : 32 * ck_; \
        _Pragma("unroll") for (int k = 0; k < 3; ++k) { const int pc_ = tid + 512 * k; int row_ = pc_ >> 3; row_ = row_ < 170 ? row_ : 169; const int arr_ = row_ / 34, ri_ = row_ - arr_ * 34; \
            int tok_ = tlo_ - 1 + ri_; tok_ = tok_ < 0 ? 0 : (tok_ > sl_ - 1 ? sl_ - 1 : tok_); \
            const int col_ = (arr_ == 0) ? C_LW : ((arr_ == 1) ? C_LA : ((arr_ == 2 ? C_RR : (arr_ == 3 ? C_RK : C_RV)) + h * 64)); \
            dst[k] = *(const u32x4*)(P + (size_t)(rb_ + tok_) * NP + col_ + (pc_ & 7) * 8); } } while (0)
    u32x4 nr[3];
    SCAN_LOAD(nr, 0);
    SBAR();
    for (int gc = 0; gc < 136; ++gc) {
        {
            int lane_v = lane; asm volatile("" : "+v"(lane_v));
            const int lane = lane_v, fr = lane & 15, fq = lane >> 4, tid = (wv << 6) | lane;
            const int seg = gc >= 8; const int slen = seg ? T : LC; const int rowbase = b * TT + (seg ? LC : 0); const int ck = seg ? gc - 8 : gc;
            const int tlo = dir ? (slen - 32 * (ck + 1)) : 32 * ck;
#pragma unroll
            for (int k = 0; k < 3; ++k) { const int pc = tid + 512 * k; if (pc < 1360) *(LAS u32x4*)(RAW + pc * 8) = nr[k]; }
            SBAR();
            SCAN_LOAD(nr, gc + 1);
            if (gc > 0) {
                const int gp = gc - 1; const int sgp = gp >= 8; const int slp = sgp ? T : LC; const int rbp = b * TT + (sgp ? LC : 0); const int ckp = sgp ? gp - 8 : gp;
                const int p = tid >> 4, pi = ckp * 32 + p, t = dir ? (slp - 1 - pi) : pi;
                const f32x4 yv = *(const LAS f32x4*)(Ys + p * 68 + (tid & 15) * 4);
                *(f32x4*)(ybuf + ((size_t)dir * M + rbp + t) * W + h * 64 + (tid & 15) * 4) = yv;
            }
            float r_[4], kd_[4], kk_[4], av_[4], v_[4], ld_[4];
#pragma unroll
            for (int q = 0; q < 4; ++q) {
                const int p = wv * 4 + q, pi = ck * 32 + p, t = dir ? (slen - 1 - pi) : pi;
                const int ri = t - tlo + 1;
                const LAS bf16_t* rw = RAW + ri * 64 + lane;
                { const float x2 = __expf(2.f * bf2f(rw[0])); LWb[p * 72 + lane] = f2bf(1.f - 2.f * frcp(1.f + x2)); } LAb[p * 72 + lane] = rw[34 * 64];
                const float r0 = bf2f(rw[68 * 64]), k0 = bf2f(rw[102 * 64]), v0 = bf2f(rw[136 * 64]);
                const float mp = (t > 0) ? 1.f : 0.f, mn = (t < slen - 1) ? 1.f : 0.f;
                const float rs = mp * bf2f(rw[67 * 64]) + mn * bf2f(rw[69 * 64]), ks = mp * bf2f(rw[101 * 64]) + mn * bf2f(rw[103 * 64]), vs = mp * bf2f(rw[135 * 64]) + mn * bf2f(rw[137 * 64]);
                r_[q] = r0 + mu_r * (0.5f * rs - r0); kd_[q] = k0 + mu_k * (0.5f * ks - k0); v_[q] = v0 + mu_v * (0.5f * vs - v0);
                const float kku = kd_[q] * kk_c; const float ss = wsum(kku * kku);
                kk_[q] = kku * frcp(fmaxf(__builtin_amdgcn_sqrtf(ss), 1e-12f));
                asm volatile("" ::: "memory");
            }
            SBAR();
            {
                const LAS bf16_t* Aw = LWb + (tt * 16 + fr) * 72 + fq * 8; const LAS bf16_t* Bw = W2T + (it * 16 + fr) * 72 + fq * 8;
                const LAS bf16_t* Aa = LAb + (tt * 16 + fr) * 72 + fq * 8; const LAS bf16_t* Ba = A2T + (it * 16 + fr) * 72 + fq * 8;
                f32x4 cw = (f32x4){0.f, 0.f, 0.f, 0.f}, ca = (f32x4){0.f, 0.f, 0.f, 0.f};
                cw = MFMA16(ldsfrag(Aw), ldsfrag(Bw), cw); cw = MFMA16(ldsfrag(Aw + 32), ldsfrag(Bw + 32), cw);
                ca = MFMA16(ldsfrag(Aa), ldsfrag(Ba), ca); ca = MFMA16(ldsfrag(Aa + 32), ldsfrag(Ba + 32), ca);
#pragma unroll
                for (int rg = 0; rg < 4; ++rg) { WPs[(tt * 16 + fq * 4 + rg) * 68 + it * 16 + fr] = cw[rg]; APs[(tt * 16 + fq * 4 + rg) * 68 + it * 16 + fr] = ca[rg]; }
            }
            SBAR();
#pragma unroll
            for (int q = 0; q < 4; ++q) {
                const int p = wv * 4 + q, pi = ck * 32 + p, t = dir ? (slen - 1 - pi) : pi;
                const float wp = w0 + WPs[p * 68 + lane], ap = a0 + APs[p * 68 + lane];
                ld_[q] = -0.6065306597f * frcp(1.f + __expf(-wp));
                av_[q] = frcp(1.f + __expf(-ap));
                kd_[q] = kd_[q] * (1.f + (av_[q] - 1.f) * ka_c);
                LD[p * 64 + lane] = ld_[q];
                const float bs = wsum(r_[q] * kd_[q] * rk_c);
                if (lane == 0) bonus[((size_t)dir * M + rowbase + t) * 16 + h] = bs;
            }
            SBAR();
            {
                float cprev = 0.f;
                for (int p2 = 0; p2 < wv * 4; ++p2) cprev += LD[p2 * 64 + lane];
                float ctot = cprev;
                for (int p2 = wv * 4; p2 < 32; ++p2) ctot += LD[p2 * 64 + lane];
                float cum = cprev;
#pragma unroll
                for (int q = 0; q < 4; ++q) {
                    const int p = wv * 4 + q;
                    cum += ld_[q];
                    const float eg = __expf(cum), egi = __expf(-cum), egm = __expf(cum - ld_[q]), egc = __expf(ctot - cum);
                    const float bq = kk_[q] * av_[q];
                    At[p * 72 + lane] = f2bf(-kk_[q] * egm); Bn[p * 72 + lane] = f2bf(bq * egi); Kn[p * 72 + lane] = f2bf(kd_[q] * egi); Rt[p * 72 + lane] = f2bf(r_[q] * eg);
                    BpT[lane * 40 + p] = f2bf(bq * egc); KpT[lane * 40 + p] = f2bf(kd_[q] * egc); Vt[lane * 40 + p] = f2bf(v_[q]);
                }
                if (wv == 0) gC[lane] = __expf(ctot);
            }
            SBAR();
#pragma unroll
            for (int k2 = 0; k2 < 2; ++k2) {
                const int tile = wv * 2 + k2, mi = tile >> 2, st = (tile >> 1) & 1, t2 = tile & 1;
                const LAS bf16_t* Ap = ((mi & 1) ? Kn : Bn) + (st * 16 + fr) * 72 + fq * 8;
                const LAS bf16_t* Bp = ((mi >> 1) ? Rt : At) + (t2 * 16 + fr) * 72 + fq * 8;
                f32x4 acc = (f32x4){0.f, 0.f, 0.f, 0.f};
                acc = MFMA16(ldsfrag(Ap), ldsfrag(Bp), acc); acc = MFMA16(ldsfrag(Ap + 32), ldsfrag(Bp + 32), acc);
                const int t = t2 * 16 + fr, s0 = st * 16 + fq * 4;
#pragma unroll
                for (int rg = 0; rg < 4; ++rg) { const int s = s0 + rg; const bool keep = (mi < 2) ? (s < t) : (s <= t); if (!keep) acc[rg] = 0.f; }
                if (mi == 0) { *(LAS f32x4*)(N1t + t * 36 + s0) = acc;
                    if (tile == 1) {
#pragma unroll
                        for (int rg = 0; rg < 4; ++rg) N1b[(fq * 4 + rg) * 40 + fr] = f2bf(acc[rg]); } }
                else { LAS bf16_t* Mp = (mi == 1 ? M2t : (mi == 2 ? M3t : M4t)) + t * 40 + s0; u32x2 o; o.x = pk2(acc[0], acc[1]); o.y = pk2(acc[2], acc[3]); *(LAS u32x2*)Mp = o; }
            }
            SBAR();
            const LAS bf16_t* S0c = S0s + cur * 4608;
            {
                const LAS bf16_t* Ap = At + (tt * 16 + fr) * 72 + fq * 8; const LAS bf16_t* Bp = S0c + (it * 16 + fr) * 72 + fq * 8;
                f32x4 acc = (f32x4){0.f, 0.f, 0.f, 0.f};
                acc = MFMA16(ldsfrag(Ap), ldsfrag(Bp), acc); acc = MFMA16(ldsfrag(Ap + 32), ldsfrag(Bp + 32), acc);
                acc = MFMA16(ldsfrag(M2t + (tt * 16 + fr) * 40 + fq * 8), ldsfrag(Vt + (it * 16 + fr) * 40 + fq * 8), acc);
                u32x2 o; o.x = pk2(acc[0], acc[1]); o.y = pk2(acc[2], acc[3]);
                *(LAS u32x2*)(Xs + (it * 16 + fr) * 40 + tt * 16 + fq * 4) = o;
            }
            if (wv == 0) {
                if (lane < 32) {
                    const int blk = lane >> 4, r = lane & 15;
                    float Tr[16];
#pragma unroll
                    for (int t = 0; t < 16; ++t) {
                        float acc = (r == t) ? 1.f : 0.f;
#pragma unroll
                        for (int s4 = 0; s4 < (t + 3) / 4; ++s4) { const f32x4 n4 = *(const LAS f32x4*)(N1t + (blk * 16 + t) * 36 + blk * 16 + s4 * 4);
#pragma unroll
                            for (int u = 0; u < 4; ++u) if (s4 * 4 + u < t) acc += Tr[s4 * 4 + u] * n4[u]; }
                        Tr[t] = acc;
                        if ((t & 3) == 3) asm volatile("" ::: "memory");
                    }
#pragma unroll
                    for (int t = 0; t < 16; ++t) { Tmt[(blk * 16 + t) * 40 + blk * 16 + r] = f2bf(Tr[t]); if (blk == 1) Tmt[t * 40 + 16 + r] = 0; }
                    if (blk == 0) {
#pragma unroll
                        for (int s2 = 0; s2 < 8; ++s2) *(LAS unsigned*)(T11r + r * 40 + s2 * 2) = pk2(Tr[2 * s2], Tr[2 * s2 + 1]);
                    }
                }
                lds_wait();
                {
                    const bf16x8 af = (fq < 2) ? ldsfrag(Tmt + (16 + fr) * 40 + 16 + fq * 8) : zfrag;
                    const bf16x8 bf = (fq < 2) ? ldsfrag(N1b + fr * 40 + fq * 8) : zfrag;
                    f32x4 g = (f32x4){0.f, 0.f, 0.f, 0.f};
                    g = MFMA16(af, bf, g);
#pragma unroll
                    for (int rg = 0; rg < 4; ++rg) Gt[(fq * 4 + rg) * 40 + fr] = f2bf(g[rg]);
                }
                lds_wait();
                {
                    const bf16x8 af = (fq < 2) ? ldsfrag(Gt + fr * 40 + fq * 8) : zfrag;
                    const bf16x8 bf = (fq < 2) ? ldsfrag(T11r + fr * 40 + fq * 8) : zfrag;
                    f32x4 g = (f32x4){0.f, 0.f, 0.f, 0.f};
                    g = MFMA16(af, bf, g);
#pragma unroll
                    for (int rg = 0; rg < 4; ++rg) Tmt[(16 + fq * 4 + rg) * 40 + fr] = f2bf(g[rg]);
                }
            }
            SBAR();
            {
                f32x4 acc = (f32x4){0.f, 0.f, 0.f, 0.f};
                acc = MFMA16(ldsfrag(Tmt + (tt * 16 + fr) * 40 + fq * 8), ldsfrag(Xs + (it * 16 + fr) * 40 + fq * 8), acc);
                u32x2 o; o.x = pk2(acc[0], acc[1]); o.y = pk2(acc[2], acc[3]);
                *(LAS u32x2*)(Us + (it * 16 + fr) * 40 + tt * 16 + fq * 4) = o;
            }
            SBAR();
            {
                const LAS bf16_t* Ap = S0c + (it * 16 + fr) * 72 + fq * 8; const LAS bf16_t* Bp = Rt + (tt * 16 + fr) * 72 + fq * 8;
                f32x4 acc = (f32x4){0.f, 0.f, 0.f, 0.f};
                acc = MFMA16(ldsfrag(Ap), ldsfrag(Bp), acc); acc = MFMA16(ldsfrag(Ap + 32), ldsfrag(Bp + 32), acc);
                const bf16x8 uf = ldsfrag(Us + (it * 16 + fr) * 40 + fq * 8), vf = ldsfrag(Vt + (it * 16 + fr) * 40 + fq * 8);
                acc = MFMA16(uf, ldsfrag(M3t + (tt * 16 + fr) * 40 + fq * 8), acc);
                acc = MFMA16(vf, ldsfrag(M4t + (tt * 16 + fr) * 40 + fq * 8), acc);
                *(LAS f32x4*)(Ys + (tt * 16 + fr) * 68 + it * 16 + fq * 4) = acc;
                LAS bf16_t* S0n = S0s + (cur ^ 1) * 4608;
#pragma unroll
                for (int k2 = 0; k2 < 2; ++k2) {
                    const int jt = tt * 2 + k2;
                    const f32x4 g4 = *(const LAS f32x4*)(gC + jt * 16 + fq * 4);
                    f32x4 s = Sacc[k2] * g4;
                    s = MFMA16(ldsfrag(BpT + (jt * 16 + fr) * 40 + fq * 8), uf, s);
                    s = MFMA16(ldsfrag(KpT + (jt * 16 + fr) * 40 + fq * 8), vf, s);
                    Sacc[k2] = s;
                    u32x2 o; o.x = pk2(s[0], s[1]); o.y = pk2(s[2], s[3]);
                    *(LAS u32x2*)(S0n + (it * 16 + fr) * 72 + jt * 16 + fq * 4) = o;
                }
            }
            cur ^= 1;
        }
    }
    SBAR();
    {
        const int p = tid >> 4, pi = 127 * 32 + p, t = dir ? (T - 1 - pi) : pi;
        const f32x4 yv = *(const LAS f32x4*)(Ys + p * 68 + (tid & 15) * 4);
        *(f32x4*)(ybuf + ((size_t)dir * M + b * TT + LC + t) * W + h * 64 + (tid & 15) * 4) = yv;
    }
#undef SCAN_LOAD
#undef SBAR
}


__device__ __forceinline__ int clampi(int v, int lo, int hi) { return v < lo ? lo : (v > hi ? hi : v); }

__device__ __forceinline__ void attn_unit(const Args& a, int layer, int unit, bool isctx, LAS unsigned char* lds) {
    const int tid = otid(), lane = tid & 63, wv = tid >> 6, fr = lane & 15, fq = lane >> 4;
    constexpr int VS = 840;
    LAS bf16_t* Vt = (LAS bf16_t*)lds;
    LAS float* rpbs = (LAS float*)(lds + 64 * VS * 2);
    const bf16_t* P = (const bf16_t*)(a.ws + WS_P);
    bf16_t* bna = (bf16_t*)(a.ws + WS_BB);
    int b, h, rp = 0, half = 0;
    if (!isctx) { b = unit >> 9; h = (unit >> 5) & 15; rp = unit & 31; } else { b = unit >> 5; h = (unit >> 1) & 15; half = unit & 1; }
    int r0a = 0, nloc = 0;
    if (!isctx) { r0a = clampi(2 * rp - 4, 0, 56); const int r0b = clampi(2 * rp - 3, 0, 56); nloc = (r0b + 8 - r0a) * 64; }
    __syncthreads();
    {
        const int nk8 = (nloc + 256) * 8;
        u32x4 vv[13];
#pragma unroll
        for (int i = 0; i < 13; ++i) { const int cidx = tid + i * 512; const int key = cidx >> 3, dc = cidx & 7;
            const int srow = (key < nloc) ? (b * TT + LC + r0a * 64 + key) : (b * TT + min(key - nloc, 255));
            if (cidx < nk8) vv[i] = *(const u32x4*)(P + (size_t)srow * NP + C_V + h * 64 + dc * 8); }
#pragma unroll
        for (int i = 0; i < 13; ++i) { const int cidx = tid + i * 512; const int key = cidx >> 3, dc = cidx & 7;
            const int dcol = (key < nloc) ? key : (576 + key - nloc);
            if (cidx < nk8) { const u32x4 v = vv[i]; LAS bf16_t* d = Vt + (dc * 8) * VS + dcol;
                d[0] = (bf16_t)(v.x & 0xffff); d[VS] = (bf16_t)(v.x >> 16); d[2 * VS] = (bf16_t)(v.y & 0xffff); d[3 * VS] = (bf16_t)(v.y >> 16);
                d[4 * VS] = (bf16_t)(v.z & 0xffff); d[5 * VS] = (bf16_t)(v.z >> 16); d[6 * VS] = (bf16_t)(v.w & 0xffff); d[7 * VS] = (bf16_t)(v.w >> 16); } }
    }
    if (!isctx) for (int i = tid; i < 465; i += 512) rpbs[i] = a.na_rpb[(size_t)(layer * 16 + h) * 465 + i];
    __syncthreads();

    int qtok, r = 0, qc = 0, cs = 0, r0 = 0;
    if (!isctx) { r = 2 * rp + (wv >> 2); const int g = wv & 3; qc = g * 16 + fr; cs = (g == 0) ? 0 : (g == 1 ? 8 : (g == 2 ? 24 : 32)); r0 = clampi(r - 4, 0, 56); qtok = b * TT + LC + r * 64 + qc; }
    else qtok = b * TT + half * 128 + wv * 16 + fr;
    bf16x8 qf[2];
    qf[0] = *(const bf16x8*)(P + (size_t)qtok * NP + C_Q + h * 64 + fq * 8);
    qf[1] = *(const bf16x8*)(P + (size_t)qtok * NP + C_Q + h * 64 + 32 + fq * 8);
    const int cstart = clampi(qc - 8, 0, 48);
    float mrun = -1e30f, lrun = 0.f;
    f32x4 o[4];
#pragma unroll
    for (int dt = 0; dt < 4; ++dt) o[dt] = (f32x4){0.f, 0.f, 0.f, 0.f};
    const int nblk = isctx ? 8 : 16;
#define ATT_KLOAD(dst, blkx) do { const int bx_ = (blkx) < nblk ? (blkx) : nblk - 1; const bool lc_ = (!isctx) && (bx_ < 8); \
        _Pragma("unroll") for (int ti = 0; ti < 2; ++ti) { const size_t ktok_ = lc_ ? (size_t)(b * TT + LC + (r0 + bx_) * 64 + cs + ti * 16 + fr) : (size_t)(b * TT + ((bx_ & 7) * 32) + ti * 16 + fr); \
            const bf16_t* kp_ = P + ktok_ * NP + C_K + h * 64 + fq * 8; dst[ti][0] = *(const bf16x8*)kp_; dst[ti][1] = *(const bf16x8*)(kp_ + 32); } } while (0)
    bf16x8 kf[2][2];
    ATT_KLOAD(kf, 0);
    for (int blk = 0; blk < nblk; ++blk) {
        const bool loc = (!isctx) && (blk < 8);
        const int gr = r0 + blk;
        bf16x8 kn[2][2];
        ATT_KLOAD(kn, blk + 1);
        f32x4 s[2];
#pragma unroll
        for (int ti = 0; ti < 2; ++ti) {
            f32x4 z = (f32x4){0.f, 0.f, 0.f, 0.f};
            z = __builtin_amdgcn_mfma_f32_16x16x32_bf16(kf[ti][0], qf[0], z, 0, 0, 0);
            s[ti] = __builtin_amdgcn_mfma_f32_16x16x32_bf16(kf[ti][1], qf[1], z, 0, 0, 0);
        }
        float sv[8];
        if (loc) {
            const LAS float* brow = rpbs + (gr - r + 7) * 31;
#pragma unroll
            for (int ti = 0; ti < 2; ++ti)
#pragma unroll
                for (int rg = 0; rg < 4; ++rg) { const int kc = cs + ti * 16 + fq * 4 + rg; const bool valid = (kc >= cstart) && (kc < cstart + 16);
                    const int co = clampi(kc - qc + 15, 0, 30); sv[ti * 4 + rg] = valid ? (s[ti][rg] * 0.125f + brow[co]) : -1e30f; }
        } else {
#pragma unroll
            for (int ti = 0; ti < 2; ++ti)
#pragma unroll
                for (int rg = 0; rg < 4; ++rg) sv[ti * 4 + rg] = s[ti][rg] * 0.125f;
        }
        float mx = fmaxf(fmaxf(fmaxf(sv[0], sv[1]), fmaxf(sv[2], sv[3])), fmaxf(fmaxf(sv[4], sv[5]), fmaxf(sv[6], sv[7])));
        mx = fmaxf(mx, __shfl_xor(mx, 16)); mx = fmaxf(mx, __shfl_xor(mx, 32));
        const float mnew = fmaxf(mrun, mx); const float alpha = __expf(mrun - mnew); mrun = mnew;
        float ps = 0.f; float pv[8];
#pragma unroll
        for (int i = 0; i < 8; ++i) { pv[i] = __expf(sv[i] - mnew); ps += pv[i]; }
        lrun = lrun * alpha + ps;
#pragma unroll
        for (int dt = 0; dt < 4; ++dt) o[dt] *= alpha;
        u32x4 pp; pp.x = pk2(pv[0], pv[1]); pp.y = pk2(pv[2], pv[3]); pp.z = pk2(pv[4], pv[5]); pp.w = pk2(pv[6], pv[7]);
        const bf16x8 pf = __builtin_bit_cast(bf16x8, pp);
        const int kbase = loc ? ((gr - r0a) * 64 + cs) : (576 + (blk & 7) * 32);
#pragma unroll
        for (int dt = 0; dt < 4; ++dt) { const LAS bf16_t* vp = Vt + (dt * 16 + fr) * VS + kbase + fq * 4;
            const u32x2 lo = *(const LAS u32x2*)vp, hi = *(const LAS u32x2*)(vp + 16);
            u32x4 vv; vv.x = lo.x; vv.y = lo.y; vv.z = hi.x; vv.w = hi.y;
            o[dt] = __builtin_amdgcn_mfma_f32_16x16x32_bf16(__builtin_bit_cast(bf16x8, vv), pf, o[dt], 0, 0, 0); }
#pragma unroll
        for (int ti = 0; ti < 2; ++ti) { kf[ti][0] = kn[ti][0]; kf[ti][1] = kn[ti][1]; }
    }
#undef ATT_KLOAD
    lrun += __shfl_xor(lrun, 16); lrun += __shfl_xor(lrun, 32);
    const float inv = frcp(lrun);
#pragma unroll
    for (int dt = 0; dt < 4; ++dt) { const int dcol = h * 64 + dt * 16 + fq * 4;
        const u32x2 gt = *(const u32x2*)(P + (size_t)qtok * NP + C_NAG + dcol);
        u32x2 ov; ov.x = pk2(o[dt][0] * inv * siluf(bflo(gt.x)), o[dt][1] * inv * siluf(bfhi(gt.x))); ov.y = pk2(o[dt][2] * inv * siluf(bflo(gt.y)), o[dt][3] * inv * siluf(bfhi(gt.y)));
        *(u32x2*)(bna + (size_t)qtok * W + dcol) = ov; }
}

__device__ __forceinline__ void pool_unit(const Args& a, int unit) {
    const int tid = otid();
    const bf16_t* P = (const bf16_t*)(a.ws + WS_P);
    bf16_t* diff = (bf16_t*)(a.ws + WS_DIFF);
    const int cc = tid & 127, g = cc >> 5, hw = 1 << g;
    for (int pass = 0; pass < 8; ++pass) {
        const int row = unit * 32 + pass * 4 + (tid >> 7); const int b = row / TT, t = row % TT;
        int s0, slen, tl; if (t < LC) { s0 = b * TT; slen = LC; tl = t; } else { s0 = b * TT + LC; slen = T; tl = t - LC; }
        const int lo = max(tl - hw, 0), hi = min(tl + hw, slen);
        float sm[8];
#pragma unroll
        for (int j = 0; j < 8; ++j) sm[j] = 0.f;
        u32x4 wv4[16];
#pragma unroll
        for (int k = 0; k < 16; ++k) { const int sx = tl - hw + k; const bool ok = (k < 2 * hw) && (sx >= 0) && (sx < slen); const int sc = ok ? sx : tl;
            wv4[k] = *(const u32x4*)(P + (size_t)(s0 + sc) * NP + C_PU + cc * 8); }
#pragma unroll
        for (int k = 0; k < 16; ++k) { const int sx = tl - hw + k; const bool ok = (k < 2 * hw) && (sx >= 0) && (sx < slen); const float mk = ok ? 1.f : 0.f; const u32x4 v = wv4[k];
            sm[0] += mk * bflo(v.x); sm[1] += mk * bfhi(v.x); sm[2] += mk * bflo(v.y); sm[3] += mk * bfhi(v.y); sm[4] += mk * bflo(v.z); sm[5] += mk * bfhi(v.z); sm[6] += mk * bflo(v.w); sm[7] += mk * bfhi(v.w); }
        const float inv = 1.f / (float)(hi - lo);
        const u32x4 u = *(const u32x4*)(P + (size_t)row * NP + C_PU + cc * 8);
        u32x4 o; o.x = pk2(sm[0] * inv - bflo(u.x), sm[1] * inv - bfhi(u.x)); o.y = pk2(sm[2] * inv - bflo(u.y), sm[3] * inv - bfhi(u.y));
        o.z = pk2(sm[4] * inv - bflo(u.z), sm[5] * inv - bfhi(u.z)); o.w = pk2(sm[6] * inv - bflo(u.w), sm[7] * inv - bfhi(u.w));
        *(u32x4*)(diff + (size_t)row * W + cc * 8) = o;
    }
}

__device__ __forceinline__ void phase_mixers(const Args& a, int layer, LAS unsigned char* lds) {
    const int G = gridDim.x, bid = blockIdx.x;
    const int nsc = (G >= 192) ? 128 : 0;
    if (PH_MASK & 0x200) { const int sstep = nsc ? nsc : G; if (!nsc || bid < nsc) { for (int it = bid; it < 128; it += sstep) scan_item(a, layer, it, lds); } if (nsc && bid < nsc) return; }
    const int tidq = otid();
    const int n_rt = layer ? 64 : 68, n_lat = 2048, n_ctx = (layer == 0) ? 128 : 0;
    const int total = n_rt + n_lat + n_ctx;
    unsigned* qctr = (unsigned*)(a.ws + WS_MOD + 253952) + layer * 64;
    LAS int* qslot = (LAS int*)(lds + 140000);
    bf16_t* P = (bf16_t*)(a.ws + WS_P);
    for (;;) {
        __syncthreads();
        if (tidq == 0) *qslot = (int)atomicAdd(qctr, 1u);
        __syncthreads();
        const int u = *qslot;
        if (u >= total) break;
        if (u < n_rt) {
            const int pm = layer ? (u / 16) * 17 + 1 + (u % 16) : u;
            if (PH_MASK & 0x800) { for (int k = 0; k < 8; ++k) pool_unit(a, pm * 8 + k); }
            __threadfence(); __syncthreads();
            Gemm g; g.nM = 1; g.nN = 1; g.nz = 1; g.latent_only = 0; g.G = 1; g.c = 0; g.zmul = 1; g.zadd = 0; g.chain = 1; g.chain_pm = pm;
            g.A = (const bf16_t*)(a.ws + WS_DIFF); g.Bt = (const bf16_t*)(a.ws + WS_WTPL); g.lda = W; g.ldb = 256; g.K = 256; g.a_z = 256; g.b_z = 65536; g.chain_n = 4; g.chain_zvar = 1;
            { EpiPool e; e.P = P; e.out = (bf16_t*)(a.ws + WS_BB) + (size_t)M * W; e.scale = a.pool_scale + layer * W; if (PH_MASK & 16) gemm_phase(lds, g, e); }
            __threadfence(); __syncthreads();
            g.A = (const bf16_t*)(a.ws + WS_BB); g.Bt = (const bf16_t*)(a.ws + WS_WTBR); g.lda = W; g.ldb = W; g.K = W; g.a_z = (size_t)M * W; g.b_z = (size_t)D * W; g.chain_n = 8; g.chain_zvar = 0; g.zadd = 1;
            { EpiMerge e; e.P = P; e.mf = (float*)(a.ws + WS_Y); e.mb = (bf16_t*)(a.ws + WS_H); if (PH_MASK & 32) gemm_phase(lds, g, e); }
        } else if (u < n_rt + n_lat) { if (PH_MASK & 0x400) attn_unit(a, layer, u - n_rt, false, lds); }
        else { if (PH_MASK & 0x400) attn_unit(a, layer, u - n_rt - n_lat, true, lds); }
    }
}

__device__ __forceinline__ void phase_readout(const Args& a, int layer) {
    const int tid = otid(), lane = tid & 63, wv = tid >> 6;
    const int gw = blockIdx.x * 8 + wv, NGW = gridDim.x * 8;
    const bf16_t* P = (const bf16_t*)(a.ws + WS_P);
    const float* ybuf = (const float*)(a.ws + WS_Y);
    const float* bonus = (const float*)(a.ws + WS_BONUS);
    bf16_t* brw = (bf16_t*)(a.ws + WS_BB) + (size_t)2 * M * W;
    const int c0 = lane * 16, h = lane >> 2;
    const float* gp = a.rw_lnx_g + layer * W + c0; const float* bp = a.rw_lnx_b + layer * W + c0; const float* mp = a.rw_mu + (layer * 3 + 2) * W + c0;
    const int nrows = layer ? NB * T : M;
    for (int ri = gw; ri < nrows; ri += NGW) {
        const int row = layer ? ((ri >> 12) * TT + LC + (ri & 4095)) : ri;
        const int t = row % TT;
        int tl, slen; if (t < LC) { tl = t; slen = LC; } else { tl = t - LC; slen = T; }
        const float* y0 = ybuf + (size_t)row * W + c0; const float* y1 = ybuf + ((size_t)M + row) * W + c0;
        f32x4 y[4];
#pragma unroll
        for (int j = 0; j < 4; ++j) y[j] = *(const f32x4*)(y0 + 4 * j) + *(const f32x4*)(y1 + 4 * j);
        const bf16_t* pr = P + (size_t)row * NP;
        const int dp = (tl > 0) ? -NP : 0, dn = (tl < slen - 1) ? NP : 0;
        const float mpv = (tl > 0) ? 1.f : 0.f, mnv = (tl < slen - 1) ? 1.f : 0.f;
        u32x4 vc[2], vp[2], vn[2], gt[2];
#pragma unroll
        for (int j = 0; j < 2; ++j) { vc[j] = *(const u32x4*)(pr + C_RV + c0 + 8 * j); vp[j] = *(const u32x4*)(pr + dp + C_RV + c0 + 8 * j); vn[j] = *(const u32x4*)(pr + dn + C_RV + c0 + 8 * j); gt[j] = *(const u32x4*)(pr + C_RG + c0 + 8 * j); }
        const float bs = bonus[(size_t)row * 16 + h] + bonus[((size_t)M + row) * 16 + h];
        float sm = 0.f;
#pragma unroll
        for (int j = 0; j < 4; ++j) sm += (y[j][0] + y[j][1]) + (y[j][2] + y[j][3]);
        sm += dppmov<0xB1>(sm); sm += dppmov<0x4E>(sm);
        const float mean = sm * (1.f / 64.f);
        float sq = 0.f;
#pragma unroll
        for (int j = 0; j < 4; ++j) { y[j] = y[j] - mean; sq += (y[j][0] * y[j][0] + y[j][1] * y[j][1]) + (y[j][2] * y[j][2] + y[j][3] * y[j][3]); }
        sq += dppmov<0xB1>(sq); sq += dppmov<0x4E>(sq);
        const float rstd = rsqrtf(sq * (1.f / 64.f) + 64e-5f);
        u32x4 ov[2];
#pragma unroll
        for (int j = 0; j < 2; ++j) {
            float o8[8];
#pragma unroll
            for (int e = 0; e < 4; ++e) {
                const unsigned uc = vc[j][e], up = vp[j][e], un = vn[j][e], ug = gt[j][e];
                const int cc = 8 * j + 2 * e;
                const float g0 = gp[cc], g1 = gp[cc + 1], b0 = bp[cc], b1 = bp[cc + 1], m0 = mp[cc], m1 = mp[cc + 1];
                const float v0c = bflo(uc), v1c = bfhi(uc);
                const float v0 = v0c + m0 * (0.5f * (mpv * bflo(up) + mnv * bflo(un)) - v0c), v1 = v1c + m1 * (0.5f * (mpv * bfhi(up) + mnv * bfhi(un)) - v1c);
                const float ya = y[(cc >> 2)][cc & 3] * rstd * g0 + b0, yb = y[((cc + 1) >> 2)][(cc + 1) & 3] * rstd * g1 + b1;
                o8[2 * e] = (ya + bs * v0) * siluf(bflo(ug)); o8[2 * e + 1] = (yb + bs * v1) * siluf(bfhi(ug));
            }
            ov[j].x = pk2(o8[0], o8[1]); ov[j].y = pk2(o8[2], o8[3]); ov[j].z = pk2(o8[4], o8[5]); ov[j].w = pk2(o8[6], o8[7]);
        }
        *(u32x4*)(brw + (size_t)row * W + c0) = ov[0]; *(u32x4*)(brw + (size_t)row * W + c0 + 8) = ov[1];
    }
}

__device__ __forceinline__ void phase_final(const Args& a) {
    const int tid = otid(), lane = tid & 63, wv = tid >> 6;
    const int gw = blockIdx.x * 8 + wv, NGW = gridDim.x * 8;
    for (int row = gw; row < NB * T; row += NGW) {
        float* xr = a.out + (size_t)row * D;
        f32x4 v[8]; float ss = 0.f;
#pragma unroll
        for (int j = 0; j < 8; ++j) { v[j] = *(const f32x4*)(xr + 4 * lane + 256 * j); ss += (v[j][0] * v[j][0] + v[j][1] * v[j][1]) + (v[j][2] * v[j][2] + v[j][3] * v[j][3]); }
        ss = wave_sum(ss); const float rstd = rsqrtf(ss * (1.f / D) + 1e-6f);
#pragma unroll
        for (int j = 0; j < 8; ++j) { const int col = 4 * lane + 256 * j; const f32x4 g4 = *(const f32x4*)(a.final_g + col); *(f32x4*)(xr + col) = (v[j] * rstd) * g4; }
    }
}

__global__ void __launch_bounds__(512, 2) fwd_kernel(Args a) {
    extern __shared__ __attribute__((aligned(16))) unsigned char smem[];
    LAS unsigned char* lds = (LAS unsigned char*)smem;
    cg::grid_group grid = cg::this_grid();
    const int G = gridDim.x, c = blockIdx.x;
    for (int ph = a.ph_lo; ph < a.ph_hi; ++ph) {
        if (ph > a.ph_lo) grid.sync();
        if (ph == 0) { if (PH_MASK & 1) phase_mod(a, lds); continue; }
        if (ph == 13) { if (PH_MASK & 128) phase_final(a); continue; }
        const int layer = (ph - 1) / 6, sub = (ph - 1) % 6;
        int nrep = 1;
#ifdef REP_SUB
        if (sub == REP_SUB && ((REP_LAYERS >> layer) & 1)) nrep = 2;
#endif
        for (int rep = 0; rep < nrep; ++rep) {
        if (rep) grid.sync();
        bf16_t* P = (bf16_t*)(a.ws + WS_P);
        if (sub == 0) { if (PH_MASK & 2) phase_norm_convert(a, layer, lds); }
        else if (sub == 1) {
            Gemm g; g.A = (const bf16_t*)(a.ws + WS_H); g.Bt = (const bf16_t*)(a.ws + WS_WTIN); g.lda = D; g.ldb = D; g.K = D; g.a_z = 0; g.b_z = 0;
            g.nM = 68; g.nN = 65; g.nz = 1; g.latent_only = 0; g.G = G; g.c = c; g.zmul = 1; g.zadd = 0; g.chain = 0; g.chain_pm = 0; g.chain_n = 0; g.chain_zvar = 0;
            EpiP e; e.P = P; if (PH_MASK & 4) gemm_phase(lds, g, e);
        } else if (sub == 2) { if (PH_MASK & 8) phase_mixers(a, layer, lds); }
        else if (sub == 3) {
            if (PH_MASK & 256) phase_readout(a, layer);
        } else if (sub == 4) {
            Gemm g; g.A = (const bf16_t*)(a.ws + WS_BB); g.Bt = (const bf16_t*)(a.ws + WS_WTBR); g.lda = W; g.ldb = W; g.K = W; g.a_z = (size_t)M * W; g.b_z = (size_t)D * W;
            g.nM = layer ? 64 : 68; g.nN = 8; g.nz = 2; g.latent_only = layer; g.G = G; g.c = c; g.zmul = 1; g.zadd = 0; g.chain = 0; g.chain_pm = 0; g.chain_n = 0; g.chain_zvar = 0;
            g.zmul = 2; EpiMerge e; e.P = P; e.mf = (float*)(a.ws + WS_Y); e.mb = (bf16_t*)(a.ws + WS_H); if (PH_MASK & 32) gemm_phase(lds, g, e);
        } else {
            Gemm g; g.A = (const bf16_t*)(a.ws + WS_H); g.Bt = (const bf16_t*)(a.ws + WS_WTOUT); g.lda = D; g.ldb = D; g.K = D; g.a_z = 0; g.b_z = 0;
            g.nM = layer ? 64 : 68; g.nN = 8; g.nz = 1; g.latent_only = layer; g.G = G; g.c = c; g.zmul = 1; g.zadd = 0; g.chain = 0; g.chain_pm = 0; g.chain_n = 0; g.chain_zvar = 0;
            EpiOut e; e.xl_old = layer ? (const float*)a.out : a.x; e.xc_old = layer ? (const float*)(a.ws + WS_XCTX) : a.ctx; e.xl_new = a.out; e.xc_new = (float*)(a.ws + WS_XCTX);
            e.mod = (const float*)(a.ws + WS_MOD) + layer * 5 * 6144; if (PH_MASK & 64) gemm_phase(lds, g, e);
        }
        }
    }
}

extern "C" void kernel_launch(void* const* d_in, const int* in_sizes, int n_in, void* d_out, int out_size, void* d_ws, size_t ws_size, hipStream_t stream) {
    static int grid = 0;
    if (grid == 0) {
        if (n_in != 24 || ws_size < WS_END) { fprintf(stderr, "kernel_launch: unexpected n_in %d or ws_size %zu (< %zu)\n", n_in, ws_size, (size_t)WS_END); grid = -1; return; }
        int dev = 0, cus = 0, per_cu = 0;
        hipGetDevice(&dev); hipDeviceGetAttribute(&cus, hipDeviceAttributeMultiprocessorCount, dev);
        if (hipFuncSetAttribute((const void*)fwd_kernel, hipFuncAttributeMaxDynamicSharedMemorySize, LDS_BYTES) != hipSuccess) { fprintf(stderr, "kernel_launch: hipFuncSetAttribute failed\n"); grid = -1; return; }
        hipOccupancyMaxActiveBlocksPerMultiprocessor(&per_cu, (const void*)fwd_kernel, 512, LDS_BYTES);
        if (per_cu < 1) { fprintf(stderr, "kernel_launch: occupancy query says %d\n", per_cu); per_cu = 1; }
        (void)hipGetLastError();
        grid = cus;
    }
    if (grid < 0) return;
    hipMemsetAsync((char*)d_ws + WS_MOD, 0, WS_MOD_BYTES, stream);
    Args a{};
    const float** pp = (const float**)&a;
    for (int i = 0; i < 24; ++i) pp[i] = (const float*)d_in[i];
    a.out = (float*)d_out; a.ws = (unsigned char*)d_ws;
#if N_LAUNCH_PER_PHASE
    for (int ph = 0; ph < NPHASE; ++ph) {
        a.ph_lo = ph; a.ph_hi = ph + 1;
        void* args[] = {&a};
        hipError_t e = hipLaunchCooperativeKernel((const void*)fwd_kernel, dim3(grid), dim3(512), args, LDS_BYTES, stream);
        if (e != hipSuccess) { fprintf(stderr, "cooperative launch failed: %s\n", hipGetErrorString(e)); break; }
    }
#else
    a.ph_lo = 0; a.ph_hi = NPHASE;
    void* args[] = {&a};
    hipError_t e = hipLaunchCooperativeKernel((const void*)fwd_kernel, dim3(grid), dim3(512), args, LDS_BYTES, stream);
    if (e != hipSuccess) fprintf(stderr, "cooperative launch failed: %s (grid %d)\n", hipGetErrorString(e), grid);
#endif
}
```
